# Optimizing an MI355X kernel written in HIP

```python
import math
import jax, jax.numpy as jnp
from jax import lax
import numpy as np

D_MODEL = 1024
BATCH = 1
SEQ = 16384
DEPTH = 2

GRID_W = 64
CTX_LEN = 256
HEAD_DIM = 64
ROPE_THETA = 10000.0
ROPE_FREQS = HEAD_DIM // 4
Q_BLOCK = 128
RMS_EPS = 1e-6

CONV_W = D_MODEL // 2
GQA_HEADS = 8
KV_HEADS = 2
GQA_W = GQA_HEADS * HEAD_DIM
KV_W = KV_HEADS * HEAD_DIM
EV_IN = 3 * CONV_W + GQA_W + 2 * KV_W
EV_SPLITS = [CONV_W, 2 * CONV_W, 3 * CONV_W, 3 * CONV_W + GQA_W, 3 * CONV_W + GQA_W + KV_W]
EV_KV_OFF = 3 * CONV_W + GQA_W
EV_OUT = CONV_W + GQA_W

S5_W = D_MODEL // 2
S5_GROUP_CH = 16
S5_GROUPS = S5_W // S5_GROUP_CH
S5_STATE = 64
S5_DT_MIN = 1e-3
S5_DT_MAX = 1e-1
DIFF_HEADS = 4
DIFF_W = DIFF_HEADS * 2 * HEAD_DIM
OD_IN = S5_W + 3 * DIFF_W
OD_SPLITS = [S5_W, S5_W + DIFF_W, S5_W + 2 * DIFF_W]
OD_K_OFF = S5_W + DIFF_W
OD_OUT = S5_W + DIFF_W

D_FF = 2816

N_EVEN = (DEPTH + 1) // 2
N_ODD = DEPTH // 2
F32 = jnp.float32

kernel_name = 'hybrid_conv_gqa_s5_diffattn_prefix_block'


def rmsnorm(x, g, eps=RMS_EPS):
    xf = x.astype(F32)
    y = xf * lax.rsqrt(jnp.mean(xf * xf, axis=-1, keepdims=True) + eps)
    return (y * g.astype(F32)).astype(x.dtype)


def modulate(x, g, shift, scale):
    return rmsnorm(x, g) * (1 + scale) + shift


def dwconv3(x, w):
    xp = jnp.pad(x, ((0, 0), (1, 1), (0, 0)))
    return xp[:, :-2] * w[0] + xp[:, 1:-1] * w[1] + xp[:, 2:] * w[2]


def rope_tables(rows):
    row = jnp.repeat(jnp.arange(rows, dtype=F32), GRID_W)
    col = jnp.tile(jnp.arange(GRID_W, dtype=F32), rows)
    inv = ROPE_THETA ** (-jnp.arange(ROPE_FREQS, dtype=F32) / ROPE_FREQS)
    ang = jnp.concatenate([row[:, None] * inv, col[:, None] * inv], axis=-1)
    return jnp.cos(ang), jnp.sin(ang)


def apply_rope(x, cos, sin):
    half = x.shape[-1] // 2
    bshape = (1, x.shape[1]) + (1,) * (x.ndim - 3) + (half,)
    cs = cos.reshape(bshape)
    sn = sin.reshape(bshape)
    xf = x.astype(F32).reshape(x.shape[:-1] + (half, 2))
    xe, xo = xf[..., 0], xf[..., 1]
    out = jnp.stack([xe * cs - xo * sn, xe * sn + xo * cs], axis=-1)
    return out.reshape(x.shape).astype(x.dtype)


def _blocks(x):
    b, l = x.shape[:2]
    return jnp.moveaxis(x.reshape((b, l // Q_BLOCK, Q_BLOCK) + x.shape[2:]), 1, 0)


def _unblocks(y):
    nb, b, qb = y.shape[:3]
    return jnp.moveaxis(y, 0, 1).reshape((b, nb * qb) + y.shape[3:])


def gqa_attention(q, k, v):
    b, l, h, d = q.shape
    kvh = k.shape[2]
    qg = q.reshape(b, l, kvh, h // kvh, d)
    scale = d ** -0.5

    def one_block(qb):
        s = jnp.einsum('bqkgd,bskd->bkgqs', qb, k).astype(F32) * scale
        p = jax.nn.softmax(s, axis=-1).astype(v.dtype)
        return jnp.einsum('bkgqs,bskd->bqkgd', p, v)

    o = _unblocks(lax.map(one_block, _blocks(qg)))
    return o.reshape(b, l, h * d)


def diff_attention(q, k, v, lam):
    scale = q.shape[-1] ** -0.5

    def one_block(qb):
        s = jnp.einsum('bqhcd,bshcd->bhcqs', qb, k).astype(F32) * scale
        p = jax.nn.softmax(s, axis=-1)
        a = (p[:, :, 0] - lam * p[:, :, 1]).astype(v.dtype)
        return jnp.einsum('bhqs,bshe->bqhe', a, v)

    return _unblocks(lax.map(one_block, _blocks(q)))


def s5_discretise(a_re, a_im, log_dt, b_re, b_im):
    dt = jnp.exp(log_dt)[:, None]
    mag = jnp.exp(a_re * dt)
    ab_re = mag * jnp.cos(a_im * dt)
    ab_im = mag * jnp.sin(a_im * dt)
    nr, ni = ab_re - 1.0, ab_im
    den = a_re * a_re + a_im * a_im
    cr = ((nr * a_re + ni * a_im) / den)[..., None]
    ci = ((ni * a_re - nr * a_im) / den)[..., None]
    bb_re = cr * b_re - ci * b_im
    bb_im = cr * b_im + ci * b_re
    return ab_re, ab_im, bb_re, bb_im


def _complex_affine_combine(e1, e2):
    a1r, a1i, b1r, b1i = e1
    a2r, a2i, b2r, b2i = e2
    return (a2r * a1r - a2i * a1i,
            a2r * a1i + a2i * a1r,
            a2r * b1r - a2i * b1i + b2r,
            a2r * b1i + a2i * b1r + b2i)


def s5_scan(bu_re, bu_im, ab_re, ab_im, h0, reverse):
    if h0 is not None:
        h0r, h0i = h0
        edge = -1 if reverse else 0
        bu_re = bu_re.at[:, edge].add(ab_re * h0r - ab_im * h0i)
        bu_im = bu_im.at[:, edge].add(ab_re * h0i + ab_im * h0r)
    a_re = jnp.broadcast_to(ab_re, bu_re.shape)
    a_im = jnp.broadcast_to(ab_im, bu_im.shape)
    _, _, hr, hi = lax.associative_scan(_complex_affine_combine, (a_re, a_im, bu_re, bu_im),
                                        reverse=reverse, axis=1)
    return hr, hi


def s5_input(ug, bb_re, bb_im):
    return (jnp.einsum('blgh,gph->blgp', ug, bb_re), jnp.einsum('blgh,gph->blgp', ug, bb_im))


def s5_readout(hr, hi, c_re, c_im):
    b, l, g, _ = hr.shape
    y = jnp.einsum('gcp,blgp->blgc', c_re, hr) - jnp.einsum('gcp,blgp->blgc', c_im, hi)
    return y.reshape(b, l, g * c_re.shape[1])


def s5_glu(y, u, d_skip, glu_w):
    z = jax.nn.gelu(y + d_skip.astype(F32) * u.astype(F32)).astype(u.dtype)
    val, gate = jnp.split(z @ glu_w, 2, axis=-1)
    return val * jax.nn.sigmoid(gate)


def s5_bidirectional(u, uc, a_re, a_im, log_dt, b_re, b_im, c_re, c_im, d_skip, glu_w, ctx_out):
    b, l, _ = u.shape
    ug = u.astype(F32).reshape(b, l, S5_GROUPS, S5_GROUP_CH)
    ucg = uc.astype(F32).reshape(b, uc.shape[1], S5_GROUPS, S5_GROUP_CH)
    ys, ycs = [], []
    for direction in range(2):
        rev = direction == 1
        ab_re, ab_im, bb_re, bb_im = s5_discretise(
            a_re[direction].astype(F32), a_im[direction].astype(F32), log_dt[direction].astype(F32),
            b_re[direction].astype(F32), b_im[direction].astype(F32))
        cr, ci = c_re[direction].astype(F32), c_im[direction].astype(F32)
        hcr, hci = s5_scan(*s5_input(ucg, bb_re, bb_im), ab_re, ab_im, None, rev)
        edge = 0 if rev else -1
        hr, hi = s5_scan(*s5_input(ug, bb_re, bb_im), ab_re, ab_im, (hcr[:, edge], hci[:, edge]), rev)
        ys.append(s5_readout(hr, hi, cr, ci))
        if ctx_out:
            ycs.append(s5_readout(hcr, hci, cr, ci))
    y = s5_glu(ys[0] + ys[1], u, d_skip, glu_w)
    yc = s5_glu(ycs[0] + ycs[1], uc, d_skip, glu_w) if ctx_out else None
    return y, yc


def conv_ffn(h, w_up, conv_w, conv_b, w_down):
    u = dwconv3(h @ w_up, conv_w) + conv_b
    a, g = jnp.split(u, 2, axis=-1)
    return (a * jax.nn.silu(g)) @ w_down


def mixer_conv_gqa(h, hc, w_in, conv_w, q_g, k_g, w_out, cos, sin, ctx_out):
    b, l, _ = h.shape
    cl = hc.shape[1]
    gb, gc, hv, q, k, v = jnp.split(h @ w_in, EV_SPLITS, axis=-1)
    y_conv = gb * dwconv3(gc * hv, conv_w)
    q = apply_rope(rmsnorm(q.reshape(b, l, GQA_HEADS, HEAD_DIM), q_g), cos, sin)
    k = apply_rope(rmsnorm(k.reshape(b, l, KV_HEADS, HEAD_DIM), k_g), cos, sin)
    v = v.reshape(b, l, KV_HEADS, HEAD_DIM)
    if ctx_out:
        cgb, cgc, chv, cq, ck, cv = jnp.split(hc @ w_in, EV_SPLITS, axis=-1)
    else:
        ck, cv = jnp.split(hc @ w_in[:, EV_KV_OFF:], [KV_W], axis=-1)
    kc = rmsnorm(ck.reshape(b, cl, KV_HEADS, HEAD_DIM), k_g)
    vc = cv.reshape(b, cl, KV_HEADS, HEAD_DIM)
    y_att = gqa_attention(q, jnp.concatenate([kc, k], axis=1), jnp.concatenate([vc, v], axis=1))
    y = jnp.concatenate([y_conv, y_att], axis=-1) @ w_out
    if not ctx_out:
        return y, None
    yc_conv = cgb * dwconv3(cgc * chv, conv_w)
    qc = rmsnorm(cq.reshape(b, cl, GQA_HEADS, HEAD_DIM), q_g)
    yc_att = gqa_attention(qc, kc, vc)
    yc = jnp.concatenate([yc_conv, yc_att], axis=-1) @ w_out
    return y, yc


def mixer_s5_diff(h, hc, w_in, a_re, a_im, log_dt, b_re, b_im, c_re, c_im, d_skip, glu_w,
                  lam_q1, lam_k1, lam_q2, lam_k2, subln_g, w_out, cos, sin, lam_init, ctx_out):
    b, l, _ = h.shape
    cl = hc.shape[1]
    u, q, k, v = jnp.split(h @ w_in, OD_SPLITS, axis=-1)
    if ctx_out:
        uc, qc, kc, vc = jnp.split(hc @ w_in, OD_SPLITS, axis=-1)
    else:
        uc = hc @ w_in[:, :S5_W]
        kc, vc = jnp.split(hc @ w_in[:, OD_K_OFF:], 2, axis=-1)
    y_s5, yc_s5 = s5_bidirectional(u, uc, a_re, a_im, log_dt, b_re, b_im, c_re, c_im, d_skip, glu_w, ctx_out)

    lam = (jnp.exp(jnp.sum(lam_q1.astype(F32) * lam_k1.astype(F32)))
           - jnp.exp(jnp.sum(lam_q2.astype(F32) * lam_k2.astype(F32))) + lam_init)
    q = apply_rope(q.reshape(b, l, DIFF_HEADS, 2, HEAD_DIM), cos, sin)
    k = apply_rope(k.reshape(b, l, DIFF_HEADS, 2, HEAD_DIM), cos, sin)
    v = v.reshape(b, l, DIFF_HEADS, 2 * HEAD_DIM)
    kc = kc.reshape(b, cl, DIFF_HEADS, 2, HEAD_DIM)
    vc = vc.reshape(b, cl, DIFF_HEADS, 2 * HEAD_DIM)
    o = diff_attention(q, jnp.concatenate([kc, k], axis=1), jnp.concatenate([vc, v], axis=1), lam)
    y_att = (rmsnorm(o, subln_g) * (1.0 - lam_init)).reshape(b, l, DIFF_W)
    y = jnp.concatenate([y_s5, y_att], axis=-1) @ w_out
    if not ctx_out:
        return y, None
    oc = diff_attention(qc.reshape(b, cl, DIFF_HEADS, 2, HEAD_DIM), kc, vc, lam)
    yc_att = (rmsnorm(oc, subln_g) * (1.0 - lam_init)).reshape(b, cl, DIFF_W)
    yc = jnp.concatenate([yc_s5, yc_att], axis=-1) @ w_out
    return y, yc


def setup_inputs(seed: int = 0) -> dict:
    key = jax.random.key(seed)
    ks = iter(jax.random.split(key, 40))

    def nrm(shape, std):
        return std * jax.random.normal(next(ks), shape, F32)

    def gain(shape):
        return 1.0 + nrm(shape, 0.02)

    d, ne, no = D_MODEL, N_EVEN, N_ODD
    p = {}
    p['x'] = nrm((BATCH, SEQ, d), 1.0)
    p['c'] = nrm((BATCH, d), 1.0)
    p['ctx'] = nrm((BATCH, CTX_LEN, d), 1.0)
    p['c_ctx'] = nrm((d,), 1.0)
    p['mod_w'] = nrm((DEPTH, d, 6 * d), 0.5 * d ** -0.5)
    p['mod_b'] = nrm((DEPTH, 6 * d), 0.02)
    p['norm_pre'] = gain((DEPTH, 2, d))
    p['norm_post'] = gain((DEPTH, 2, d))
    p['ffn_w_up'] = nrm((DEPTH, d, 2 * D_FF), d ** -0.5)
    p['ffn_conv_w'] = nrm((DEPTH, 3, 2 * D_FF), 3 ** -0.5)
    p['ffn_conv_b'] = nrm((DEPTH, 2 * D_FF), 0.02)
    p['ffn_w_down'] = nrm((DEPTH, D_FF, d), D_FF ** -0.5)
    p['ev_w_in'] = nrm((ne, d, EV_IN), d ** -0.5)
    p['ev_conv_w'] = nrm((ne, 3, CONV_W), 3 ** -0.5)
    p['ev_q_norm'] = gain((ne, HEAD_DIM))
    p['ev_k_norm'] = gain((ne, HEAD_DIM))
    p['ev_w_out'] = nrm((ne, EV_OUT, d), EV_OUT ** -0.5)
    p['od_w_in'] = nrm((no, d, OD_IN), d ** -0.5)
    p['od_s5_a_re'] = -0.5 * jnp.exp(nrm((no, 2, S5_GROUPS, S5_STATE), 0.05))
    p['od_s5_a_im'] = jnp.pi * jnp.arange(S5_STATE, dtype=F32) + nrm((no, 2, S5_GROUPS, S5_STATE), 0.01)
    p['od_s5_log_dt'] = jax.random.uniform(next(ks), (no, 2, S5_GROUPS), F32,
                                           math.log(S5_DT_MIN), math.log(S5_DT_MAX))
    p['od_s5_b_re'] = nrm((no, 2, S5_GROUPS, S5_STATE, S5_GROUP_CH), (2 * S5_GROUP_CH) ** -0.5)
    p['od_s5_b_im'] = nrm((no, 2, S5_GROUPS, S5_STATE, S5_GROUP_CH), (2 * S5_GROUP_CH) ** -0.5)
    p['od_s5_c_re'] = nrm((no, 2, S5_GROUPS, S5_GROUP_CH, S5_STATE), (2 * S5_STATE) ** -0.5)
    p['od_s5_c_im'] = nrm((no, 2, S5_GROUPS, S5_GROUP_CH, S5_STATE), (2 * S5_STATE) ** -0.5)
    p['od_s5_d'] = nrm((no, S5_W), 1.0)
    p['od_glu_w'] = nrm((no, S5_W, 2 * S5_W), S5_W ** -0.5)
    p['od_lam_q1'] = nrm((no, HEAD_DIM), 0.1)
    p['od_lam_k1'] = nrm((no, HEAD_DIM), 0.1)
    p['od_lam_q2'] = nrm((no, HEAD_DIM), 0.1)
    p['od_lam_k2'] = nrm((no, HEAD_DIM), 0.1)
    p['od_subln'] = gain((no, 2 * HEAD_DIM))
    p['od_w_out'] = nrm((no, OD_OUT, d), OD_OUT ** -0.5)
    return p


def reference(x, c, ctx, c_ctx, mod_w, mod_b, norm_pre, norm_post,
              ffn_w_up, ffn_conv_w, ffn_conv_b, ffn_w_down,
              ev_w_in, ev_conv_w, ev_q_norm, ev_k_norm, ev_w_out,
              od_w_in, od_s5_a_re, od_s5_a_im, od_s5_log_dt, od_s5_b_re, od_s5_b_im,
              od_s5_c_re, od_s5_c_im, od_s5_d, od_glu_w,
              od_lam_q1, od_lam_k1, od_lam_q2, od_lam_k2, od_subln, od_w_out):
    b, l, d = x.shape
    ROWS = l // GRID_W
    cos, sin = rope_tables(ROWS)
    xc = ctx
    s_c = jax.nn.silu(c)
    s_cc = jax.nn.silu(c_ctx)
    for i in range(DEPTH):
        ctx_out = i < DEPTH - 1
        j = i // 2
        m = (s_c @ mod_w[i] + mod_b[i]).reshape(b, 6, 1, d)
        mc = (s_cc @ mod_w[i] + mod_b[i]).reshape(6, 1, 1, d)
        h = modulate(x, norm_pre[i, 0], m[:, 0], m[:, 1])
        hc = modulate(xc, norm_pre[i, 0], mc[0], mc[1])
        if i % 2 == 0:
            y, yc = mixer_conv_gqa(h, hc, ev_w_in[j], ev_conv_w[j], ev_q_norm[j], ev_k_norm[j], ev_w_out[j],
                                   cos, sin, ctx_out)
        else:
            y, yc = mixer_s5_diff(h, hc, od_w_in[j], od_s5_a_re[j], od_s5_a_im[j], od_s5_log_dt[j],
                                  od_s5_b_re[j], od_s5_b_im[j], od_s5_c_re[j], od_s5_c_im[j], od_s5_d[j],
                                  od_glu_w[j], od_lam_q1[j], od_lam_k1[j], od_lam_q2[j], od_lam_k2[j],
                                  od_subln[j], od_w_out[j], cos, sin,
                                  0.8 - 0.6 * math.exp(-0.3 * i), ctx_out)
        x = x + m[:, 2] * rmsnorm(y, norm_post[i, 0])
        h = modulate(x, norm_pre[i, 1], m[:, 3], m[:, 4])
        x = x + m[:, 5] * rmsnorm(conv_ffn(h, ffn_w_up[i], ffn_conv_w[i], ffn_conv_b[i], ffn_w_down[i]),
                                  norm_post[i, 1])
        if ctx_out:
            xc = xc + mc[2] * rmsnorm(yc, norm_post[i, 0])
            hc = modulate(xc, norm_pre[i, 1], mc[3], mc[4])
            xc = xc + mc[5] * rmsnorm(conv_ffn(hc, ffn_w_up[i], ffn_conv_w[i], ffn_conv_b[i], ffn_w_down[i]),
                                      norm_post[i, 1])
    return x
```

```cpp
#include <hip/hip_runtime.h>
#include <hip/hip_cooperative_groups.h>
#include <stdint.h>
#include <stdio.h>
namespace cg = cooperative_groups;

#define DI __device__ __forceinline__
typedef unsigned short u16;
typedef short bf16x8 __attribute__((ext_vector_type(8)));
typedef float f32x16 __attribute__((ext_vector_type(16)));
typedef float f32x4 __attribute__((ext_vector_type(4)));
typedef __bf16 bf2_t __attribute__((ext_vector_type(2)));
typedef float f2_t __attribute__((ext_vector_type(2)));

constexpr int DM = 1024;
constexpr int LSEQ = 16384;
constexpr int CTXN = 256;
constexpr int MT = LSEQ + CTXN;
constexpr int DFF = 2816;
constexpr int NCHUNK = MT / 64;
constexpr int LDS_BYTES = 77824;
constexpr float LOG2E = 1.4426950408889634f;

DI unsigned pk2(float a, float b) { f2_t v = {a, b}; bf2_t r = __builtin_convertvector(v, bf2_t); return __builtin_bit_cast(unsigned, r); }
DI u16 f2bf(float a) { return (u16)(pk2(a, 0.f) & 0xffffu); }
DI float bflo(unsigned v) { return __uint_as_float(v << 16); }
DI float bfhi(unsigned v) { return __uint_as_float(v & 0xffff0000u); }
DI float bf2f(u16 v) { return __uint_as_float(((unsigned)v) << 16); }
DI int crow(int i, int h) { return (i & 3) + 8 * (i >> 2) + 4 * h; }
DI float wsum(float v) {
  v += __shfl_xor(v, 32); v += __shfl_xor(v, 16); v += __shfl_xor(v, 8);
  v += __shfl_xor(v, 4); v += __shfl_xor(v, 2); v += __shfl_xor(v, 1); return v;
}
DI float hsum32(float v) {
  v += __shfl_xor(v, 16); v += __shfl_xor(v, 8); v += __shfl_xor(v, 4); v += __shfl_xor(v, 2); v += __shfl_xor(v, 1); return v;
}
DI float silu_f(float x) { return x / (1.f + __expf(-x)); }
DI float sigmoid_f(float x) { return 1.f / (1.f + __expf(-x)); }
DI float gelu_tanh(float x) {
  float a = 0.7978845608028654f * (x + 0.044715f * x * x * x);
  float t = 1.f - 2.f / (__expf(2.f * a) + 1.f);
  return 0.5f * x * (1.f + t);
}
#define MFMA32(a, b, c) __builtin_amdgcn_mfma_f32_32x32x16_bf16((a), (b), (c), 0, 0, 0)
#define MFMA16(a, b, c) __builtin_amdgcn_mfma_f32_16x16x32_bf16((a), (b), (c), 0, 0, 0)

struct Params {
  const float *x, *c, *ctx, *c_ctx, *mod_w, *mod_b, *norm_pre, *norm_post, *ffn_w_up, *ffn_conv_w, *ffn_conv_b, *ffn_w_down;
  const float *ev_w_in, *ev_conv_w, *ev_q_norm, *ev_k_norm, *ev_w_out;
  const float *od_w_in, *a_re, *a_im, *log_dt, *b_re, *b_im, *c_re, *c_im, *d_skip, *glu_w;
  const float *lam_q1, *lam_k1, *lam_q2, *lam_k2, *subln, *od_w_out;
  float* out;
  u16 *wt_in0, *wt_out0, *wt_up0, *wt_dn0, *wt_in1, *wt_glu, *wt_out1, *wt_up1, *wt_dn1;
  float* mod;
  float* xctx;
  float* s5s;
  u16* H;
  float* Y;
  u16* big;
  int ph_lo, ph_hi;
};

DI int perm_row(int kind, int n) {
  if (kind == 1) {
    if (n < DFF) return (n >> 6) * 128 + (n & 63);
    int m = n - DFF; return (m >> 6) * 128 + 64 + (m & 63);
  } else if (kind == 2) {
    if (n < 512) return (n >> 5) * 64 + (n & 31);
    int m = n - 512; return (m >> 5) * 64 + 32 + (m & 31);
  }
  return n;
}

DI void transpose_tile(const float* __restrict__ W, int K, int N, u16* __restrict__ Wt, int kind, int tile, float* sm) {
  const int nN = N >> 6;
  const int k0 = (tile / nN) * 64, n0 = (tile % nN) * 64;
  const int tid = threadIdx.x;
  for (int r = tid >> 6; r < 64; r += 4) sm[r * 65 + (tid & 63)] = W[(size_t)(k0 + r) * N + n0 + (tid & 63)];
  __syncthreads();
  const int kk = (tid & 31) * 2;
  for (int n = tid >> 5; n < 64; n += 8) {
    unsigned v = pk2(sm[kk * 65 + n], sm[(kk + 1) * 65 + n]);
    *(unsigned*)(Wt + (size_t)perm_row(kind, n0 + n) * K + k0 + kk) = v;
  }
  __syncthreads();
}

DI void phase_prep_weights(const Params& p, char* smem) {
  float* sm = (float*)smem;
  const float* srcs[9] = {p.ev_w_in, p.ev_w_out, p.ffn_w_up, p.ffn_w_down, p.od_w_in, p.glu_w, p.od_w_out,
                          p.ffn_w_up + (size_t)DM * 2 * DFF, p.ffn_w_down + (size_t)DFF * DM};
  u16* dsts[9] = {p.wt_in0, p.wt_out0, p.wt_up0, p.wt_dn0, p.wt_in1, p.wt_glu, p.wt_out1, p.wt_up1, p.wt_dn1};
  const int Ks[9] = {1024, 1024, 1024, DFF, 1024, 512, 1024, 1024, DFF};
  const int Ns[9] = {2304, 1024, 2 * DFF, 1024, 2048, 1024, 1024, 2 * DFF, 1024};
  const int kinds[9] = {0, 0, 1, 0, 0, 2, 0, 1, 0};
  int total = 0;
#pragma unroll
  for (int i = 0; i < 9; ++i) total += (Ks[i] >> 6) * (Ns[i] >> 6);
  const int NMOD = 192;
  for (int t = blockIdx.x; t < NMOD + total; t += gridDim.x) {
    if (t < NMOD) {
      const int layer = t / 96, cgp = t % 96;
      const int tid = threadIdx.x, col = cgp * 64 + (tid & 63), kq = tid >> 6;
      const float* W = p.mod_w + (size_t)layer * DM * 6 * DM;
      float a0 = 0.f, a1 = 0.f;
      for (int k = kq * 256; k < kq * 256 + 256; ++k) {
        float w = W[(size_t)k * (6 * DM) + col];
        a0 += silu_f(p.c[k]) * w;
        a1 += silu_f(p.c_ctx[k]) * w;
      }
      sm[(kq * 64 + (tid & 63)) * 2] = a0;
      sm[(kq * 64 + (tid & 63)) * 2 + 1] = a1;
      __syncthreads();
      if (tid < 128) {
        int cc = tid & 63, which = tid >> 6;
        float s = 0.f;
        for (int q = 0; q < 4; ++q) s += sm[(q * 64 + cc) * 2 + which];
        int colo = cgp * 64 + cc;
        p.mod[(size_t)(layer * 2 + which) * 6 * DM + colo] = s + p.mod_b[layer * 6 * DM + colo];
      }
      __syncthreads();
    } else {
      int tt = t - NMOD;
#pragma unroll
      for (int i = 0; i < 9; ++i) {
        int cnt = (Ks[i] >> 6) * (Ns[i] >> 6);
        if (tt >= 0 && tt < cnt) transpose_tile(srcs[i], Ks[i], Ns[i], dsts[i], kinds[i], tt, sm);
        tt -= cnt;
      }
    }
  }
}

template <bool HAS_Y, bool HAS_H>
DI void phase_rows(const Params& p, int row0, int row1, const float* xin_ctx, const float* xin_lat,
                   float* xout_ctx, float* xout_lat, const float* Y, const float* modl  ,
                   int gate_idx, const float* gpost, const float* modh  , int shift_idx,
                   const float* gpre, u16* Hout) {
  const int lane = threadIdx.x & 63;
  const int wid = blockIdx.x * 4 + (threadIdx.x >> 6), nw = gridDim.x * 4;
  for (int row = row0 + wid; row < row1; row += nw) {
    const bool isc = row < CTXN;
    const float* xr = isc ? xin_ctx + (size_t)row * DM : xin_lat + (size_t)(row - CTXN) * DM;
    float4 xv[4];
#pragma unroll
    for (int j = 0; j < 4; ++j) xv[j] = *(const float4*)(xr + j * 256 + lane * 4);
    if (HAS_Y) {
      const float* yr = Y + (size_t)row * DM;
      const float* gt = modl + (size_t)(isc ? 6 : 0) * DM + gate_idx * DM;
      float4 yv[4];
      float ss = 0.f;
#pragma unroll
      for (int j = 0; j < 4; ++j) {
        yv[j] = *(const float4*)(yr + j * 256 + lane * 4);
        ss += yv[j].x * yv[j].x + yv[j].y * yv[j].y + yv[j].z * yv[j].z + yv[j].w * yv[j].w;
      }
      ss = wsum(ss);
      const float rinv = rsqrtf(ss * (1.f / DM) + 1e-6f);
      float* xo = isc ? xout_ctx + (size_t)row * DM : xout_lat + (size_t)(row - CTXN) * DM;
#pragma unroll
      for (int j = 0; j < 4; ++j) {
        float4 g = *(const float4*)(gpost + j * 256 + lane * 4);
        float4 gg = *(const float4*)(gt + j * 256 + lane * 4);
        xv[j].x += gg.x * (yv[j].x * rinv * g.x);
        xv[j].y += gg.y * (yv[j].y * rinv * g.y);
        xv[j].z += gg.z * (yv[j].z * rinv * g.z);
        xv[j].w += gg.w * (yv[j].w * rinv * g.w);
        *(float4*)(xo + j * 256 + lane * 4) = xv[j];
      }
    }
    if (HAS_H) {
      float ss = 0.f;
#pragma unroll
      for (int j = 0; j < 4; ++j) ss += xv[j].x * xv[j].x + xv[j].y * xv[j].y + xv[j].z * xv[j].z + xv[j].w * xv[j].w;
      ss = wsum(ss);
      const float rinv = rsqrtf(ss * (1.f / DM) + 1e-6f);
      const float* sh = modh + (size_t)(isc ? 6 : 0) * DM + shift_idx * DM;
      const float* sc = sh + DM;
#pragma unroll
      for (int j = 0; j < 4; ++j) {
        float4 g = *(const float4*)(gpre + j * 256 + lane * 4);
        float4 s1 = *(const float4*)(sh + j * 256 + lane * 4);
        float4 s2 = *(const float4*)(sc + j * 256 + lane * 4);
        float h0 = xv[j].x * rinv * g.x * (1.f + s2.x) + s1.x;
        float h1 = xv[j].y * rinv * g.y * (1.f + s2.y) + s1.y;
        float h2 = xv[j].z * rinv * g.z * (1.f + s2.z) + s1.z;
        float h3 = xv[j].w * rinv * g.w * (1.f + s2.w) + s1.w;
        uint2 o; o.x = pk2(h0, h1); o.y = pk2(h2, h3);
        *(uint2*)(Hout + (size_t)row * DM + j * 256 + lane * 4) = o;
      }
    }
  }
}

enum { EPI_SPLIT = 0, EPI_F32 = 1, EPI_GLU = 2, EPI_FFNUP = 3 };
struct GemmDesc {
  const u16* A; const u16* Bt; int lda; int K; int nN; int tm0; int nM;
  void* d0; void* d1; int ld0; int ld1; int split;
  const float* cw; const float* cb;
};

template <int MODE>
DI void gemm_tile(const GemmDesc& g, char* smem, int tmi, int tn) {
  const int tid = threadIdx.x, lane = tid & 63, w = tid >> 6, h = lane >> 5, l31 = lane & 31;
  const int wm = w >> 1, wn = w & 1;
  constexpr int ASZ = 256 * 80, BSZ = 128 * 80, STG = ASZ + BSZ;
  const u16* arow[4];
  int seq_base = 0, seq_len = MT, vrow0 = tmi * 256;
  if (MODE == EPI_FFNUP) {
    if (tmi < 2) { seq_base = 0; seq_len = CTXN; vrow0 = 254 * tmi - 1; }
    else { seq_base = CTXN; seq_len = LSEQ; vrow0 = 254 * (tmi - 2) - 1; }
  }
#pragma unroll
  for (int j = 0; j < 4; ++j) {
    int r = (tid + 256 * j) >> 2;
    int kc = (tid + 256 * j) & 3;
    if (MODE == EPI_FFNUP) {
      int v = vrow0 + r;
      arow[j] = (v >= 0 && v < seq_len) ? g.A + (size_t)(seq_base + v) * g.lda + kc * 8 : nullptr;
    } else {
      arow[j] = g.A + (size_t)(vrow0 + r) * g.lda + kc * 8;
    }
  }
  const u16* brow[2];
#pragma unroll
  for (int j = 0; j < 2; ++j) {
    int n = (tid + 256 * j) >> 2, kc = (tid + 256 * j) & 3;
    brow[j] = g.Bt + (size_t)(tn * 128 + n) * g.K + kc * 8;
  }
  f32x16 acc[4][2];
#pragma unroll
  for (int a = 0; a < 4; ++a)
#pragma unroll
    for (int b = 0; b < 2; ++b)
#pragma unroll
      for (int i = 0; i < 16; ++i) acc[a][b][i] = 0.f;

  uint4 ra[4], rb[2];
  const int nk = g.K >> 5;
  auto gload = [&](int kt) {
#pragma unroll
    for (int j = 0; j < 4; ++j) {
      if (MODE == EPI_FFNUP) {
        if (arow[j]) ra[j] = *(const uint4*)(arow[j] + kt * 32); else ra[j] = make_uint4(0, 0, 0, 0);
      } else ra[j] = *(const uint4*)(arow[j] + kt * 32);
    }
#pragma unroll
    for (int j = 0; j < 2; ++j) rb[j] = *(const uint4*)(brow[j] + kt * 32);
  };
  auto swrite = [&](int buf) {
    char* sa = smem + buf * STG;
#pragma unroll
    for (int j = 0; j < 4; ++j) { int c = tid + 256 * j; *(uint4*)(sa + (c >> 2) * 80 + (c & 3) * 16) = ra[j]; }
#pragma unroll
    for (int j = 0; j < 2; ++j) { int c = tid + 256 * j; *(uint4*)(sa + ASZ + (c >> 2) * 80 + (c & 3) * 16) = rb[j]; }
  };
  gload(0); swrite(0); __syncthreads();
  for (int kt = 0; kt < nk; ++kt) {
    if (kt + 1 < nk) gload(kt + 1);
    const char* sa = smem + (kt & 1) * STG + (wm * 128 + l31) * 80 + h * 16;
    const char* sb = smem + (kt & 1) * STG + ASZ + (wn * 64 + l31) * 80 + h * 16;
#pragma unroll
    for (int ks = 0; ks < 2; ++ks) {
      bf16x8 af[4], bf[2];
#pragma unroll
      for (int mi = 0; mi < 4; ++mi) af[mi] = *(const bf16x8*)(sa + mi * 32 * 80 + ks * 32);
#pragma unroll
      for (int ni = 0; ni < 2; ++ni) bf[ni] = *(const bf16x8*)(sb + ni * 32 * 80 + ks * 32);
#pragma unroll
      for (int mi = 0; mi < 4; ++mi)
#pragma unroll
        for (int ni = 0; ni < 2; ++ni) acc[mi][ni] = MFMA32(af[mi], bf[ni], acc[mi][ni]);
    }
    if (kt + 1 < nk) swrite((kt + 1) & 1);
    __syncthreads();
  }
  const int rbase = tmi * 256 + wm * 128;
  const int cbase = tn * 128 + wn * 64;
  if (MODE == EPI_SPLIT) {
#pragma unroll
    for (int mi = 0; mi < 4; ++mi)
#pragma unroll
      for (int ni = 0; ni < 2; ++ni) {
        const int col = cbase + ni * 32 + l31;
        u16* dst; int ld, cc;
        if (col < g.split) { dst = (u16*)g.d0; ld = g.ld0; cc = col; } else { dst = (u16*)g.d1; ld = g.ld1; cc = col - g.split; }
#pragma unroll
        for (int i = 0; i < 16; ++i) {
          const int row = rbase + mi * 32 + crow(i, h);
          dst[(size_t)row * ld + cc] = f2bf(acc[mi][ni][i]);
        }
      }
  } else if (MODE == EPI_F32) {
    float* dst = (float*)g.d0;
#pragma unroll
    for (int mi = 0; mi < 4; ++mi)
#pragma unroll
      for (int ni = 0; ni < 2; ++ni) {
        const int col = cbase + ni * 32 + l31;
#pragma unroll
        for (int i = 0; i < 16; ++i) {
          const int row = rbase + mi * 32 + crow(i, h);
          dst[(size_t)row * g.ld0 + col] = acc[mi][ni][i];
        }
      }
  } else if (MODE == EPI_GLU) {
    u16* dst = (u16*)g.d0;
    const int col = (tn * 2 + wn) * 32 + l31;
#pragma unroll
    for (int mi = 0; mi < 4; ++mi)
#pragma unroll
      for (int i = 0; i < 16; ++i) {
        const int row = rbase + mi * 32 + crow(i, h);
        float v = acc[mi][0][i] * sigmoid_f(acc[mi][1][i]);
        dst[(size_t)row * g.ld0 + col] = f2bf(v);
      }
  } else {
    constexpr int TS = 536;
#pragma unroll
    for (int mi = 0; mi < 4; ++mi)
#pragma unroll
      for (int ni = 0; ni < 2; ++ni) {
        const int c = wn * 64 + ni * 32 + l31;
#pragma unroll
        for (int q = 0; q < 4; ++q) {
          const int r = wm * 128 + mi * 32 + 8 * q + 4 * h;
          uint2 v; v.x = pk2(acc[mi][ni][4 * q], acc[mi][ni][4 * q + 1]); v.y = pk2(acc[mi][ni][4 * q + 2], acc[mi][ni][4 * q + 3]);
          *(uint2*)(smem + c * TS + r * 2) = v;
        }
      }
    __syncthreads();
    {
      const int c = tid & 63, rq = tid >> 6;
      const int fa = tn * 64 + c, fg = DFF + fa;
      const float wa0 = g.cw[fa], wa1 = g.cw[2 * DFF + fa], wa2 = g.cw[4 * DFF + fa], ba = g.cb[fa];
      const float wg0 = g.cw[fg], wg1 = g.cw[2 * DFF + fg], wg2 = g.cw[4 * DFF + fg], bg = g.cb[fg];
      const u16* ta = (const u16*)(smem + c * TS);
      const u16* tg = (const u16*)(smem + (64 + c) * TS);
      int rs = rq * 64, re = rs + 64;
      if (rs < 1) rs = 1;
      if (re > 255) re = 255;
      float ap = bf2f(ta[rs - 1]), ac = bf2f(ta[rs]);
      float gp = bf2f(tg[rs - 1]), gc = bf2f(tg[rs]);
      u16* dst = (u16*)g.d0;
      for (int r = rs; r < re; ++r) {
        float an = bf2f(ta[r + 1]), gn = bf2f(tg[r + 1]);
        int v = vrow0 + r;
        if (v < seq_len) {
          float av = wa0 * ap + wa1 * ac + wa2 * an + ba;
          float gv = wg0 * gp + wg1 * gc + wg2 * gn + bg;
          dst[(size_t)(seq_base + v) * DFF + fa] = f2bf(av * silu_f(gv));
        }
        ap = ac; ac = an; gp = gc; gc = gn;
      }
    }
    __syncthreads();
  }
}

template <int MODE>
DI void phase_gemm(const GemmDesc& g, char* smem) {
  const int ntiles = g.nM * g.nN;
  for (int t = blockIdx.x; t < ntiles; t += gridDim.x) {
    const int tm = g.tm0 + t / g.nN, tn = t % g.nN;
    gemm_tile<MODE>(g, smem, tm, tn);
  }
}

DI void rope_angles(int row, int i, float& cs, float& sn) {
  const int pos = row - CTXN;
  const int rr = pos >> 6, cc = pos & 63;
  const int fi = i & 15;
  const float inv = exp2f(-(float)fi * (13.287712379549449f / 16.f));
  const float ang = (float)((i < 16) ? rr : cc) * inv;
  sincosf(ang, &sn, &cs);
}

DI void qk_prep(const u16* __restrict__ src, int lds, int coff, int nheads, u16* __restrict__ dst, const float* gnorm  ,
                float oscale, int row0) {
  const int lane = threadIdx.x & 63, hh = lane >> 5, i = lane & 31;
  const int wid = blockIdx.x * 4 + (threadIdx.x >> 6), nw = gridDim.x * 4;
  const int npair = nheads >> 1;
  const int nitems = (MT - row0) * npair;
  for (int it = wid; it < nitems; it += nw) {
    const int row = row0 + it / npair, head = (it % npair) * 2 + hh;
    unsigned v = *(const unsigned*)(src + (size_t)row * lds + coff + head * 64 + 2 * i);
    float e = bflo(v), o = bfhi(v);
    if (gnorm) {
      float ss = hsum32(e * e + o * o);
      float rinv = rsqrtf(ss * (1.f / 64.f) + 1e-6f);
      e = e * rinv * gnorm[2 * i]; o = o * rinv * gnorm[2 * i + 1];
    }
    if (row >= CTXN) {
      float cs, sn; rope_angles(row, i, cs, sn);
      float e2 = e * cs - o * sn, o2 = e * sn + o * cs;
      e = e2; o = o2;
    }
    *(unsigned*)(dst + ((size_t)head * MT + row) * 64 + 2 * i) = pk2(e * oscale, o * oscale);
  }
}

DI void v_transpose(const u16* __restrict__ src, int lds, int coff, int ncols, u16* __restrict__ dst, char* smem) {
  u16* sm = (u16*)smem;
  const int tid = threadIdx.x;
  const int ndt = ncols >> 6;
  const int ntasks = NCHUNK * ndt;
  for (int t = blockIdx.x; t < ntasks; t += gridDim.x) {
    const int tt = t / ndt, dt = t % ndt;
    {
      const int tok = tid >> 2, part = tid & 3;
      const u16* sp = src + (size_t)(tt * 64 + tok) * lds + coff + dt * 64 + part * 16;
      uint4 a = *(const uint4*)sp, b = *(const uint4*)(sp + 8);
      unsigned* d = (unsigned*)(sm + tok * 66 + part * 16);
      d[0] = a.x; d[1] = a.y; d[2] = a.z; d[3] = a.w; d[4] = b.x; d[5] = b.y; d[6] = b.z; d[7] = b.w;
    }
    __syncthreads();
    {
      const int d = tid >> 2, part = tid & 3;
      unsigned o[8];
#pragma unroll
      for (int j = 0; j < 8; ++j) {
        unsigned lo = sm[(part * 16 + 2 * j) * 66 + d], hi = sm[(part * 16 + 2 * j + 1) * 66 + d];
        o[j] = lo | (hi << 16);
      }
      u16* dp = dst + (size_t)(dt * 64 + d) * MT + tt * 64 + part * 16;
      *(uint4*)dp = make_uint4(o[0], o[1], o[2], o[3]);
      *(uint4*)(dp + 8) = make_uint4(o[4], o[5], o[6], o[7]);
    }
    __syncthreads();
  }
}

DI void gated_conv(const Params& p, const u16* __restrict__ G, u16* __restrict__ A2) {
  const int lane = threadIdx.x & 63;
  const int wid = blockIdx.x * 4 + (threadIdx.x >> 6), nw = gridDim.x * 4;
  const int nitems = MT * 4;
  for (int it = wid; it < nitems; it += nw) {
    const int row = it >> 2, c = ((it & 3) * 64 + lane) * 2;
    const bool first = (row == 0) || (row == CTXN), last = (row == CTXN - 1) || (row == MT - 1);
    const u16* gr = G + (size_t)row * 1536;
    unsigned gb = *(const unsigned*)(gr + c);
    unsigned c1 = *(const unsigned*)(gr + 512 + c), v1 = *(const unsigned*)(gr + 1024 + c);
    float m1a = bflo(c1) * bflo(v1), m1b = bfhi(c1) * bfhi(v1);
    float m0a = 0.f, m0b = 0.f, m2a = 0.f, m2b = 0.f;
    if (!first) {
      unsigned c0 = *(const unsigned*)(gr - 1536 + 512 + c), v0 = *(const unsigned*)(gr - 1536 + 1024 + c);
      m0a = bflo(c0) * bflo(v0); m0b = bfhi(c0) * bfhi(v0);
    }
    if (!last) {
      unsigned c2 = *(const unsigned*)(gr + 1536 + 512 + c), v2 = *(const unsigned*)(gr + 1536 + 1024 + c);
      m2a = bflo(c2) * bflo(v2); m2b = bfhi(c2) * bfhi(v2);
    }
    const float* cw = p.ev_conv_w;
    float ya = bflo(gb) * (cw[c] * m0a + cw[512 + c] * m1a + cw[1024 + c] * m2a);
    float yb = bfhi(gb) * (cw[c + 1] * m0b + cw[512 + c + 1] * m1b + cw[1024 + c + 1] * m2b);
    *(unsigned*)(A2 + (size_t)row * DM + c) = pk2(ya, yb);
  }
}

DI int kperm(int r) { return (r & 0x13) | ((r & 4) << 1) | ((r & 8) >> 1); }

template <int DV, int NCOMP>
DI void attn_task(char* smem, const u16* __restrict__ Qb, const u16* __restrict__ Kb, const u16* __restrict__ Vt,
                  int qh, int kslot, int q0w, int kh0, int vhead, int nkt, u16* __restrict__ A2, int ocol,
                  float lam, float lam_init, const float* __restrict__ subln) {
  const int tid = threadIdx.x, lane = tid & 63, w = tid >> 6, h = lane >> 5, l31 = lane & 31;
  constexpr int KT = 64 * 144;
  constexpr int STG = NCOMP * KT + DV * 144;
  constexpr int NKC = NCOMP * 2, NVC = DV / 32;
  constexpr int NDB = DV / 32;
  bf16x8 qf[4];
  {
    const u16* qp = Qb + ((size_t)qh * MT + q0w + l31) * 64 + h * 8;
#pragma unroll
    for (int ks = 0; ks < 4; ++ks) qf[ks] = *(const bf16x8*)(qp + ks * 16);
  }
  f32x16 O[NDB];
#pragma unroll
  for (int d = 0; d < NDB; ++d)
#pragma unroll
    for (int i = 0; i < 16; ++i) O[d][i] = 0.f;
  float m = -1e30f, lsum = 0.f;
  uint4 kreg[NKC], vreg[NVC];
  auto gload = [&](int kt) {
#pragma unroll
    for (int j = 0; j < NKC; ++j) {
      const int c = tid + 256 * j, comp = c >> 9, key = (c & 511) >> 3, part = c & 7;
      kreg[j] = *(const uint4*)(Kb + ((size_t)(kh0 + comp) * MT + kt * 64 + key) * 64 + part * 8);
    }
#pragma unroll
    for (int j = 0; j < NVC; ++j) {
      const int c = tid + 256 * j, d = c >> 3, part = c & 7;
      vreg[j] = *(const uint4*)(Vt + ((size_t)vhead * DV + d) * MT + kt * 64 + part * 8);
    }
  };
  auto swrite = [&](int buf) {
    char* sb = smem + buf * STG;
#pragma unroll
    for (int j = 0; j < NKC; ++j) {
      const int c = tid + 256 * j, comp = c >> 9, key = (c & 511) >> 3, part = c & 7;
      *(uint4*)(sb + comp * KT + key * 144 + part * 16) = kreg[j];
    }
#pragma unroll
    for (int j = 0; j < NVC; ++j) {
      const int c = tid + 256 * j, d = c >> 3, part = c & 7;
      *(uint4*)(sb + NCOMP * KT + d * 144 + part * 16) = vreg[j];
    }
  };
  gload(0); swrite(0); __syncthreads();
  for (int kt = 0; kt < nkt; ++kt) {
    if (kt + 1 < nkt) gload(kt + 1);
    const char* sb = smem + (kt & 1) * STG;
    const char* kp = sb + kslot * KT + kperm(l31) * 144 + h * 16;
    f32x16 S0, S1;
#pragma unroll
    for (int i = 0; i < 16; ++i) { S0[i] = 0.f; S1[i] = 0.f; }
#pragma unroll
    for (int ks = 0; ks < 4; ++ks) {
      bf16x8 a0 = *(const bf16x8*)(kp + ks * 32);
      bf16x8 a1 = *(const bf16x8*)(kp + 32 * 144 + ks * 32);
      S0 = MFMA32(a0, qf[ks], S0);
      S1 = MFMA32(a1, qf[ks], S1);
    }
    float mx = S0[0];
#pragma unroll
    for (int i = 1; i < 16; ++i) mx = fmaxf(mx, S0[i]);
#pragma unroll
    for (int i = 0; i < 16; ++i) mx = fmaxf(mx, S1[i]);
    mx = fmaxf(mx, __shfl_xor(mx, 32));
    const float mnew = fmaxf(m, mx);
    if (__any(mnew > m)) {
      const float alpha = __builtin_amdgcn_exp2f(m - mnew);
      lsum *= alpha;
#pragma unroll
      for (int d = 0; d < NDB; ++d)
#pragma unroll
        for (int i = 0; i < 16; ++i) O[d][i] *= alpha;
      m = mnew;
    }
    float ps = 0.f;
#pragma unroll
    for (int i = 0; i < 16; ++i) { S0[i] = __builtin_amdgcn_exp2f(S0[i] - m); ps += S0[i]; }
#pragma unroll
    for (int i = 0; i < 16; ++i) { S1[i] = __builtin_amdgcn_exp2f(S1[i] - m); ps += S1[i]; }
    lsum += ps;
    bf16x8 pf[4];
#pragma unroll
    for (int s = 0; s < 2; ++s) {
      uint4 a, b;
      a.x = pk2(S0[8 * s], S0[8 * s + 1]); a.y = pk2(S0[8 * s + 2], S0[8 * s + 3]);
      a.z = pk2(S0[8 * s + 4], S0[8 * s + 5]); a.w = pk2(S0[8 * s + 6], S0[8 * s + 7]);
      b.x = pk2(S1[8 * s], S1[8 * s + 1]); b.y = pk2(S1[8 * s + 2], S1[8 * s + 3]);
      b.z = pk2(S1[8 * s + 4], S1[8 * s + 5]); b.w = pk2(S1[8 * s + 6], S1[8 * s + 7]);
      pf[s] = __builtin_bit_cast(bf16x8, a);
      pf[2 + s] = __builtin_bit_cast(bf16x8, b);
    }
    const char* vp = sb + NCOMP * KT + l31 * 144 + h * 16;
#pragma unroll
    for (int kk = 0; kk < 4; ++kk)
#pragma unroll
      for (int d = 0; d < NDB; ++d) {
        bf16x8 vf = *(const bf16x8*)(vp + d * 32 * 144 + kk * 32);
        O[d] = MFMA32(vf, pf[kk], O[d]);
      }
    if (kt + 1 < nkt) swrite((kt + 1) & 1);
    __syncthreads();
  }
  const float ltot = lsum + __shfl_xor(lsum, 32);
  const float inv = 1.f / ltot;
  const int row = q0w + l31;
  if (NCOMP == 1) {
#pragma unroll
    for (int d = 0; d < NDB; ++d)
#pragma unroll
      for (int q = 0; q < 4; ++q) {
        const int dd = d * 32 + 8 * q + 4 * h;
        uint2 v; v.x = pk2(O[d][4 * q] * inv, O[d][4 * q + 1] * inv); v.y = pk2(O[d][4 * q + 2] * inv, O[d][4 * q + 3] * inv);
        *(uint2*)(A2 + (size_t)row * DM + ocol + dd) = v;
      }
  } else {
    float* ox = (float*)smem;
    const int ql = (w >> 1) * 32 + l31;
    if (w & 1) {
#pragma unroll
      for (int d = 0; d < NDB; ++d)
#pragma unroll
        for (int q = 0; q < 4; ++q) {
          const int dd = d * 32 + 8 * q + 4 * h;
          float4 v = make_float4(O[d][4 * q] * inv, O[d][4 * q + 1] * inv, O[d][4 * q + 2] * inv, O[d][4 * q + 3] * inv);
          *(float4*)(ox + ql * 132 + dd) = v;
        }
    }
    __syncthreads();
    if (!(w & 1)) {
      float ss = 0.f;
#pragma unroll
      for (int d = 0; d < NDB; ++d)
#pragma unroll
        for (int q = 0; q < 4; ++q) {
          const int dd = d * 32 + 8 * q + 4 * h;
          float4 o2 = *(const float4*)(ox + ql * 132 + dd);
          O[d][4 * q] = O[d][4 * q] * inv - lam * o2.x;
          O[d][4 * q + 1] = O[d][4 * q + 1] * inv - lam * o2.y;
          O[d][4 * q + 2] = O[d][4 * q + 2] * inv - lam * o2.z;
          O[d][4 * q + 3] = O[d][4 * q + 3] * inv - lam * o2.w;
          ss += O[d][4 * q] * O[d][4 * q] + O[d][4 * q + 1] * O[d][4 * q + 1] + O[d][4 * q + 2] * O[d][4 * q + 2] + O[d][4 * q + 3] * O[d][4 * q + 3];
        }
      ss += __shfl_xor(ss, 32);
      const float r = rsqrtf(ss * (1.f / 128.f) + 1e-6f) * (1.f - lam_init);
#pragma unroll
      for (int d = 0; d < NDB; ++d)
#pragma unroll
        for (int q = 0; q < 4; ++q) {
          const int dd = d * 32 + 8 * q + 4 * h;
          float4 gs = *(const float4*)(subln + dd);
          uint2 v; v.x = pk2(O[d][4 * q] * r * gs.x, O[d][4 * q + 1] * r * gs.y); v.y = pk2(O[d][4 * q + 2] * r * gs.z, O[d][4 * q + 3] * r * gs.w);
          *(uint2*)(A2 + (size_t)row * DM + ocol + dd) = v;
        }
    }
    __syncthreads();
  }
}

DI void s5_coeffs(const Params& p, int dir, int g, int pp, float& abr, float& abi, float& cr, float& ci) {
  const int idx = (dir * 32 + g) * 64 + pp;
  const float dt = expf(p.log_dt[dir * 32 + g]);
  const float are = p.a_re[idx], aim = p.a_im[idx];
  const float mag = expf(are * dt);
  float sn, cs; sincosf(aim * dt, &sn, &cs);
  abr = mag * cs; abi = mag * sn;
  const float nr = abr - 1.f, ni = abi;
  const float den = are * are + aim * aim;
  cr = (nr * are + ni * aim) / den;
  ci = (ni * are - nr * aim) / den;
}

template <bool OUT>
DI void s5_task(const Params& p, char* smem, int gp, int c, const u16* __restrict__ U1, u16* __restrict__ Z) {
  float* su = (float*)smem;
  u16* hm = (u16*)(smem + 8192);
  const int tid = threadIdx.x, lane = tid & 63, w = tid >> 6;
  const int gl = w >> 1, dir = w & 1, g = 2 * gp + gl;
  {
    const int t = tid >> 2, part = tid & 3;
    uint4 v = *(const uint4*)(U1 + (size_t)(c * 64 + t) * 512 + gp * 32 + part * 8);
    float* d = su + t * 32 + part * 8;
    d[0] = bflo(v.x); d[1] = bfhi(v.x); d[2] = bflo(v.y); d[3] = bfhi(v.y);
    d[4] = bflo(v.z); d[5] = bfhi(v.z); d[6] = bflo(v.w); d[7] = bfhi(v.w);
  }
  float abr, abi, cr, ci;
  s5_coeffs(p, dir, g, lane, abr, abi, cr, ci);
  float bbr[16], bbi[16];
  {
    const size_t bidx = ((size_t)(dir * 32 + g) * 64 + lane) * 16;
#pragma unroll
    for (int q = 0; q < 4; ++q) {
      float4 br = *(const float4*)(p.b_re + bidx + q * 4), bi = *(const float4*)(p.b_im + bidx + q * 4);
      bbr[4 * q] = cr * br.x - ci * bi.x; bbi[4 * q] = cr * bi.x + ci * br.x;
      bbr[4 * q + 1] = cr * br.y - ci * bi.y; bbi[4 * q + 1] = cr * bi.y + ci * br.y;
      bbr[4 * q + 2] = cr * br.z - ci * bi.z; bbi[4 * q + 2] = cr * bi.z + ci * br.z;
      bbr[4 * q + 3] = cr * br.w - ci * bi.w; bbi[4 * q + 3] = cr * bi.w + ci * br.w;
    }
  }
  float2* sp = (float2*)p.s5s + ((size_t)(dir * 32 + g) * NCHUNK + c) * 64 + lane;
  float hr = 0.f, hi = 0.f;
  if (OUT) { float2 h0 = *sp; hr = h0.x; hi = h0.y; }
  __syncthreads();
  for (int step = 0; step < 64; ++step) {
    const int t = dir ? 63 - step : step;
    const float* ur = su + t * 32 + gl * 16;
    float bur = 0.f, bui = 0.f;
#pragma unroll
    for (int q = 0; q < 4; ++q) {
      float4 u = *(const float4*)(ur + 4 * q);
      bur += bbr[4 * q] * u.x + bbr[4 * q + 1] * u.y + bbr[4 * q + 2] * u.z + bbr[4 * q + 3] * u.w;
      bui += bbi[4 * q] * u.x + bbi[4 * q + 1] * u.y + bbi[4 * q + 2] * u.z + bbi[4 * q + 3] * u.w;
    }
    const float nhr = abr * hr - abi * hi + bur;
    const float nhi = abr * hi + abi * hr + bui;
    hr = nhr; hi = nhi;
    if (OUT) {
      u16* hrow = hm + (gl * 64 + t) * 264 + dir * 128 + lane;
      hrow[0] = f2bf(hr); hrow[64] = f2bf(hi);
    }
  }
  if (!OUT) {
    *sp = make_float2(hr, hi);
    __syncthreads();
  } else {
    __syncthreads();
    const int l15 = lane & 15, lq = lane >> 4;
    f32x4 acc0 = {0.f, 0.f, 0.f, 0.f}, acc1 = {0.f, 0.f, 0.f, 0.f};
    const int tb0 = 2 * (w & 1);
#pragma unroll
    for (int kb = 0; kb < 8; ++kb) {
      const int k0 = kb * 32 + lq * 8;
      const int dk = k0 >> 7, rem = k0 & 127, isim = rem >> 6, pp = rem & 63;
      const float* cs = (isim ? p.c_im : p.c_re) + ((size_t)((dk * 32 + g) * 16 + l15)) * 64 + pp;
      const float sg = isim ? -1.f : 1.f;
      float4 c0 = *(const float4*)cs, c1 = *(const float4*)(cs + 4);
      uint4 bb; bb.x = pk2(sg * c0.x, sg * c0.y); bb.y = pk2(sg * c0.z, sg * c0.w); bb.z = pk2(sg * c1.x, sg * c1.y); bb.w = pk2(sg * c1.z, sg * c1.w);
      bf16x8 bfr = __builtin_bit_cast(bf16x8, bb);
      bf16x8 a0 = *(const bf16x8*)(hm + (gl * 64 + tb0 * 16 + l15) * 264 + k0);
      bf16x8 a1 = *(const bf16x8*)(hm + (gl * 64 + (tb0 + 1) * 16 + l15) * 264 + k0);
      acc0 = MFMA16(a0, bfr, acc0);
      acc1 = MFMA16(a1, bfr, acc1);
    }
    const float dsk = p.d_skip[g * 16 + l15];
#pragma unroll
    for (int j = 0; j < 4; ++j) {
      int t = tb0 * 16 + lq * 4 + j;
      float y = acc0[j] + dsk * su[t * 32 + gl * 16 + l15];
      Z[(size_t)(c * 64 + t) * 512 + g * 16 + l15] = f2bf(gelu_tanh(y));
      t += 16;
      y = acc1[j] + dsk * su[t * 32 + gl * 16 + l15];
      Z[(size_t)(c * 64 + t) * 512 + g * 16 + l15] = f2bf(gelu_tanh(y));
    }
    __syncthreads();
  }
}

DI void s5_carry(const Params& p) {
  if (blockIdx.x >= 16) return;
  const int s = blockIdx.x * 256 + threadIdx.x;
  const int dir = s >> 11, g = (s >> 6) & 31, pp = s & 63;
  float abr, abi, cr, ci;
  s5_coeffs(p, dir, g, pp, abr, abi, cr, ci);
#pragma unroll
  for (int q = 0; q < 6; ++q) { float nr = abr * abr - abi * abi, ni = 2.f * abr * abi; abr = nr; abi = ni; }
  float2* base = (float2*)p.s5s + ((size_t)(dir * 32 + g) * NCHUNK) * 64 + pp;
  float hr = 0.f, hi = 0.f;
  for (int b = 0; b < 10; ++b) {
    float2 tmp[26];
#pragma unroll
    for (int j = 0; j < 26; ++j) {
      const int step = b * 26 + j;
      const int c = dir == 0 ? step : (step < 4 ? 3 - step : 263 - step);
      tmp[j] = base[(size_t)c * 64];
    }
#pragma unroll
    for (int j = 0; j < 26; ++j) {
      const int step = b * 26 + j;
      const int c = dir == 0 ? step : (step < 4 ? 3 - step : 263 - step);
      base[(size_t)c * 64] = make_float2(hr, hi);
      const float nr = abr * hr - abi * hi + tmp[j].x;
      const float ni = abr * hi + abi * hr + tmp[j].y;
      hr = nr; hi = ni;
    }
  }
}

__global__ void __launch_bounds__(256, 2) fwd_megakernel(Params p) {
  extern __shared__ __attribute__((aligned(16))) char smem[];
  cg::grid_group grid = cg::this_grid();
  const size_t RW = (size_t)MT * DM;
  u16* A2 = p.H;
  u16* Qb = (u16*)p.Y;
  u16* Kb = Qb + RW / 2;
  u16* Vt = Kb + RW / 2;
  const float* mod0 = p.mod;
  const float* mod1 = p.mod + 2 * 6 * DM;

#define PHASE_BEGIN(k) if ((k) >= p.ph_lo && (k) < p.ph_hi) { if ((k) > p.ph_lo) grid.sync();
#define PHASE_END }

  PHASE_BEGIN(0) phase_prep_weights(p, smem); PHASE_END

  PHASE_BEGIN(1)
    phase_rows<false, true>(p, 0, MT, p.ctx, p.x, nullptr, nullptr, nullptr, nullptr, 0, nullptr, mod0, 0, p.norm_pre, p.H);
  PHASE_END

  PHASE_BEGIN(2) {
    GemmDesc g{}; g.A = p.H; g.Bt = p.wt_in0; g.lda = DM; g.K = DM; g.nN = 18; g.tm0 = 0; g.nM = 65;
    g.d0 = p.big; g.ld0 = 1536; g.d1 = p.big + (size_t)MT * 1536; g.ld1 = 768; g.split = 1536;
    phase_gemm<EPI_SPLIT>(g, smem);
  } PHASE_END

  PHASE_BEGIN(3) {
    const u16* G = p.big; const u16* QKV = p.big + (size_t)MT * 1536;
    qk_prep(QKV, 768, 0, 8, Qb, p.ev_q_norm, 0.125f * LOG2E, 0);
    qk_prep(QKV, 768, 512, 2, Kb, p.ev_k_norm, 1.f, 0);
    v_transpose(QKV, 768, 640, 128, Vt, smem);
    gated_conv(p, G, A2);
  } PHASE_END

  PHASE_BEGIN(4) {
    const int w = threadIdx.x >> 6;
    const int nlat = 8 * 128, nctx = 8 * 2;
    for (int t = blockIdx.x; t < nlat + nctx; t += gridDim.x) {
      int head, q0, nkt;
      if (t < nlat) { head = t & 7; q0 = CTXN + (t >> 3) * 128; nkt = NCHUNK; }
      else { int tt = t - nlat; head = tt & 7; q0 = (tt >> 3) * 128; nkt = CTXN / 64; }
      attn_task<64, 1>(smem, Qb, Kb, Vt, head, 0, q0 + 32 * w, head >> 2, head >> 2, nkt, A2, 512 + head * 64, 0.f, 0.f, nullptr);
    }
  } PHASE_END

  PHASE_BEGIN(5) {
    GemmDesc g{}; g.A = A2; g.Bt = p.wt_out0; g.lda = DM; g.K = DM; g.nN = 8; g.tm0 = 0; g.nM = 65;
    g.d0 = p.Y; g.ld0 = DM;
    phase_gemm<EPI_F32>(g, smem);
  } PHASE_END

  PHASE_BEGIN(6)
    phase_rows<true, true>(p, 0, MT, p.ctx, p.x, p.xctx, p.out, p.Y, mod0, 2, p.norm_post, mod0, 3, p.norm_pre + DM, p.H);
  PHASE_END

  PHASE_BEGIN(7) {
    GemmDesc g{}; g.A = p.H; g.Bt = p.wt_up0; g.lda = DM; g.K = DM; g.nN = 44; g.tm0 = 0; g.nM = 67;
    g.d0 = p.big; g.cw = p.ffn_conv_w; g.cb = p.ffn_conv_b;
    phase_gemm<EPI_FFNUP>(g, smem);
  } PHASE_END

  PHASE_BEGIN(8) {
    GemmDesc g{}; g.A = p.big; g.Bt = p.wt_dn0; g.lda = DFF; g.K = DFF; g.nN = 8; g.tm0 = 0; g.nM = 65;
    g.d0 = p.Y; g.ld0 = DM;
    phase_gemm<EPI_F32>(g, smem);
  } PHASE_END

  PHASE_BEGIN(9)
    phase_rows<true, true>(p, 0, MT, p.xctx, p.out, p.xctx, p.out, p.Y, mod0, 5, p.norm_post + DM, mod1, 0, p.norm_pre + 2 * DM, p.H);
  PHASE_END

  u16* U1 = p.big;
  u16* QKV1 = p.big + (size_t)MT * 512;
  u16* Z = p.big + (size_t)MT * 2048;

  PHASE_BEGIN(10) {
    GemmDesc g{}; g.A = p.H; g.Bt = p.wt_in1; g.lda = DM; g.K = DM; g.nN = 16; g.tm0 = 0; g.nM = 65;
    g.d0 = U1; g.ld0 = 512; g.d1 = QKV1; g.ld1 = 1536; g.split = 512;
    phase_gemm<EPI_SPLIT>(g, smem);
  } PHASE_END

  PHASE_BEGIN(11) {
    qk_prep(QKV1, 1536, 0, 8, Qb, nullptr, 0.125f * LOG2E, CTXN);
    qk_prep(QKV1, 1536, 512, 8, Kb, nullptr, 1.f, 0);
    v_transpose(QKV1, 1536, 1024, 512, Vt, smem);
    for (int t = blockIdx.x; t < 16 * NCHUNK; t += gridDim.x) s5_task<false>(p, smem, t & 15, t >> 4, U1, Z);
  } PHASE_END

  PHASE_BEGIN(12) {
    s5_carry(p);
    float lam;
    {
      const int lane = threadIdx.x & 63;
      float s1 = wsum(p.lam_q1[lane] * p.lam_k1[lane]);
      float s2 = wsum(p.lam_q2[lane] * p.lam_k2[lane]);
      lam = expf(s1) - expf(s2) + 0.35550906759f;
    }
    const int w = threadIdx.x >> 6;
    for (int t = blockIdx.x; t < 4 * 256; t += gridDim.x) {
      const int head = t & 3, q0 = CTXN + (t >> 2) * 64;
      attn_task<128, 2>(smem, Qb, Kb, Vt, head * 2 + (w & 1), w & 1, q0 + 32 * (w >> 1), head * 2, head, NCHUNK, A2, 512 + head * 128,
                        lam, 0.35550906759f, p.subln);
    }
  } PHASE_END

  PHASE_BEGIN(13) {
    for (int t = blockIdx.x; t < 16 * (NCHUNK - 4); t += gridDim.x) s5_task<true>(p, smem, t & 15, 4 + (t >> 4), U1, Z);
  } PHASE_END

  PHASE_BEGIN(14) {
    GemmDesc g{}; g.A = Z; g.Bt = p.wt_glu; g.lda = 512; g.K = 512; g.nN = 8; g.tm0 = 1; g.nM = 64;
    g.d0 = A2; g.ld0 = DM;
    phase_gemm<EPI_GLU>(g, smem);
  } PHASE_END

  PHASE_BEGIN(15) {
    GemmDesc g{}; g.A = A2; g.Bt = p.wt_out1; g.lda = DM; g.K = DM; g.nN = 8; g.tm0 = 1; g.nM = 64;
    g.d0 = p.Y; g.ld0 = DM;
    phase_gemm<EPI_F32>(g, smem);
  } PHASE_END

  PHASE_BEGIN(16)
    phase_rows<true, true>(p, CTXN, MT, p.xctx, p.out, p.xctx, p.out, p.Y, mod1, 2, p.norm_post + 2 * DM, mod1, 3, p.norm_pre + 3 * DM, p.H);
  PHASE_END

  PHASE_BEGIN(17) {
    GemmDesc g{}; g.A = p.H; g.Bt = p.wt_up1; g.lda = DM; g.K = DM; g.nN = 44; g.tm0 = 2; g.nM = 65;
    g.d0 = p.big; g.cw = p.ffn_conv_w + 3 * 2 * DFF; g.cb = p.ffn_conv_b + 2 * DFF;
    phase_gemm<EPI_FFNUP>(g, smem);
  } PHASE_END

  PHASE_BEGIN(18) {
    GemmDesc g{}; g.A = p.big; g.Bt = p.wt_dn1; g.lda = DFF; g.K = DFF; g.nN = 8; g.tm0 = 1; g.nM = 64;
    g.d0 = p.Y; g.ld0 = DM;
    phase_gemm<EPI_F32>(g, smem);
  } PHASE_END

  PHASE_BEGIN(19)
    phase_rows<true, false>(p, CTXN, MT, p.xctx, p.out, p.xctx, p.out, p.Y, mod1, 5, p.norm_post + 3 * DM, nullptr, 0, nullptr, nullptr);
  PHASE_END
}

extern "C" void kernel_launch(void* const* d_in, const int* in_sizes, int n_in, void* d_out, int out_size, void* d_ws,
                              size_t ws_size, hipStream_t stream) {
  static int grid_blocks = 0;
  if (!grid_blocks) {
    hipFuncSetAttribute((const void*)fwd_megakernel, hipFuncAttributeMaxDynamicSharedMemorySize, LDS_BYTES);
    int dev = 0, cus = 0, per_cu = 0;
    hipGetDevice(&dev);
    hipDeviceGetAttribute(&cus, hipDeviceAttributeMultiprocessorCount, dev);
    hipOccupancyMaxActiveBlocksPerMultiprocessor(&per_cu, fwd_megakernel, 256, LDS_BYTES);
    if (per_cu > 2) per_cu = 2;
    grid_blocks = cus * per_cu;
  }
  Params p{};
  const float* const* in = (const float* const*)d_in;
  p.x = in[0]; p.c = in[1]; p.ctx = in[2]; p.c_ctx = in[3]; p.mod_w = in[4]; p.mod_b = in[5]; p.norm_pre = in[6]; p.norm_post = in[7];
  p.ffn_w_up = in[8]; p.ffn_conv_w = in[9]; p.ffn_conv_b = in[10]; p.ffn_w_down = in[11];
  p.ev_w_in = in[12]; p.ev_conv_w = in[13]; p.ev_q_norm = in[14]; p.ev_k_norm = in[15]; p.ev_w_out = in[16];
  p.od_w_in = in[17]; p.a_re = in[18]; p.a_im = in[19]; p.log_dt = in[20]; p.b_re = in[21]; p.b_im = in[22]; p.c_re = in[23]; p.c_im = in[24];
  p.d_skip = in[25]; p.glu_w = in[26]; p.lam_q1 = in[27]; p.lam_k1 = in[28]; p.lam_q2 = in[29]; p.lam_k2 = in[30]; p.subln = in[31]; p.od_w_out = in[32];
  p.out = (float*)d_out;
  char* ws = (char*)d_ws;
  size_t off = 0;
  auto take = [&](size_t bytes) { char* r = ws + off; off += (bytes + 255) & ~(size_t)255; return r; };
  p.wt_in0 = (u16*)take((size_t)2304 * 1024 * 2);
  p.wt_out0 = (u16*)take((size_t)1024 * 1024 * 2);
  p.wt_up0 = (u16*)take((size_t)2 * DFF * 1024 * 2);
  p.wt_dn0 = (u16*)take((size_t)1024 * DFF * 2);
  p.wt_in1 = (u16*)take((size_t)2048 * 1024 * 2);
  p.wt_glu = (u16*)take((size_t)1024 * 512 * 2);
  p.wt_out1 = (u16*)take((size_t)1024 * 1024 * 2);
  p.wt_up1 = (u16*)take((size_t)2 * DFF * 1024 * 2);
  p.wt_dn1 = (u16*)take((size_t)1024 * DFF * 2);
  p.mod = (float*)take((size_t)2 * 2 * 6 * DM * 4);
  p.xctx = (float*)take((size_t)CTXN * DM * 4);
  p.s5s = (float*)take((size_t)2 * 32 * NCHUNK * 64 * 8);
  p.H = (u16*)take((size_t)MT * DM * 2);
  p.Y = (float*)take((size_t)MT * DM * 4);
  p.big = (u16*)take((size_t)MT * DFF * 2);
  p.ph_lo = 0; p.ph_hi = 20;
  if (off > ws_size) { fprintf(stderr, "workspace too small: need %zu have %zu\n", off, ws_size); }
  void* args[] = {&p};
  hipError_t e = hipLaunchCooperativeKernel((const void*)fwd_megakernel, dim3(grid_blocks), dim3(256), args, LDS_BYTES, stream);
  if (e != hipSuccess) fprintf(stderr, "cooperative launch failed: %s (grid %d)\n", hipGetErrorString(e), grid_blocks);
}
```

```cpp
#include <hip/hip_runtime.h>
#include <hip/hip_cooperative_groups.h>
#include <stdint.h>
#include <stdio.h>
namespace cg = cooperative_groups;

#define DI __device__ __forceinline__
typedef unsigned short u16;
typedef short bf16x8 __attribute__((ext_vector_type(8)));
typedef float f32x16 __attribute__((ext_vector_type(16)));
typedef float f32x4 __attribute__((ext_vector_type(4)));
typedef __bf16 bf2_t __attribute__((ext_vector_type(2)));
typedef float f2_t __attribute__((ext_vector_type(2)));

constexpr int DM = 1024;
constexpr int LSEQ = 16384;
constexpr int CTXN = 256;
constexpr int MT = LSEQ + CTXN;
constexpr int DFF = 2816;
constexpr int NCHUNK = MT / 64;
constexpr int LDS_BYTES = 77824;
#ifndef REP_A
#define REP_A 1
#endif
#ifndef REP_G
#define REP_G 1
#endif
#ifndef REP_O
#define REP_O 1
#endif
#ifndef REP_P
#define REP_P 1
#endif
#ifndef REP_S
#define REP_S 1
#endif
constexpr float LOG2E = 1.4426950408889634f;

DI unsigned pk2(float a, float b) { f2_t v = {a, b}; bf2_t r = __builtin_convertvector(v, bf2_t); return __builtin_bit_cast(unsigned, r); }
DI u16 f2bf(float a) { return (u16)(pk2(a, 0.f) & 0xffffu); }
DI float bflo(unsigned v) { return __uint_as_float(v << 16); }
DI float bfhi(unsigned v) { return __uint_as_float(v & 0xffff0000u); }
DI float bf2f(u16 v) { return __uint_as_float(((unsigned)v) << 16); }
DI int crow(int i, int h) { return (i & 3) + 8 * (i >> 2) + 4 * h; }
DI float wsum(float v) {
  v += __shfl_xor(v, 32); v += __shfl_xor(v, 16); v += __shfl_xor(v, 8);
  v += __shfl_xor(v, 4); v += __shfl_xor(v, 2); v += __shfl_xor(v, 1); return v;
}
DI float hsum32(float v) {
  v += __shfl_xor(v, 16); v += __shfl_xor(v, 8); v += __shfl_xor(v, 4); v += __shfl_xor(v, 2); v += __shfl_xor(v, 1); return v;
}
DI float silu_f(float x) { return x / (1.f + __expf(-x)); }
DI float sigmoid_f(float x) { return 1.f / (1.f + __expf(-x)); }
DI float gelu_tanh(float x) {
  float a = 0.7978845608028654f * (x + 0.044715f * x * x * x);
  float t = 1.f - 2.f / (__expf(2.f * a) + 1.f);
  return 0.5f * x * (1.f + t);
}
#define MFMA32(a, b, c) __builtin_amdgcn_mfma_f32_32x32x16_bf16((a), (b), (c), 0, 0, 0)
#define MFMA16(a, b, c) __builtin_amdgcn_mfma_f32_16x16x32_bf16((a), (b), (c), 0, 0, 0)

struct Params {
  const float *x, *c, *ctx, *c_ctx, *mod_w, *mod_b, *norm_pre, *norm_post, *ffn_w_up, *ffn_conv_w, *ffn_conv_b, *ffn_w_down;
  const float *ev_w_in, *ev_conv_w, *ev_q_norm, *ev_k_norm, *ev_w_out;
  const float *od_w_in, *a_re, *a_im, *log_dt, *b_re, *b_im, *c_re, *c_im, *d_skip, *glu_w;
  const float *lam_q1, *lam_k1, *lam_q2, *lam_k2, *subln, *od_w_out;
  float* out;
  u16 *wt_in0, *wt_out0, *wt_up0, *wt_dn0, *wt_in1, *wt_glu, *wt_out1, *wt_up1, *wt_dn1;
  float* mod;
  float* xctx;
  float* s5s;
  u16* H;
  float* Y;
  u16* big;
  unsigned* bar;
  int ph_lo, ph_hi;
};

DI int perm_row(int kind, int n) {
  if (kind == 1) {
    if (n < DFF) return (n >> 6) * 128 + (n & 63);
    int m = n - DFF; return (m >> 6) * 128 + 64 + (m & 63);
  } else if (kind == 2) {
    if (n < 512) return (n >> 5) * 64 + (n & 31);
    int m = n - 512; return (m >> 5) * 64 + 32 + (m & 31);
  }
  return n;
}

DI void transpose_tile(const float* __restrict__ W, int K, int N, u16* __restrict__ Wt, int kind, int tile, float* sm) {
  const int nN = N >> 6;
  const int k0 = (tile / nN) * 64, n0 = (tile % nN) * 64;
  const int tid = threadIdx.x;
  for (int r = tid >> 6; r < 64; r += 4) sm[r * 65 + (tid & 63)] = W[(size_t)(k0 + r) * N + n0 + (tid & 63)];
  __syncthreads();
  const int kk = (tid & 31) * 2;
  for (int n = tid >> 5; n < 64; n += 8) {
    unsigned v = pk2(sm[kk * 65 + n], sm[(kk + 1) * 65 + n]);
    *(unsigned*)(Wt + (size_t)perm_row(kind, n0 + n) * K + k0 + kk) = v;
  }
  __syncthreads();
}

DI void phase_prep_weights(const Params& p, char* smem) {
  float* sm = (float*)smem;
  const float* srcs[9] = {p.ev_w_in, p.ev_w_out, p.ffn_w_up, p.ffn_w_down, p.od_w_in, p.glu_w, p.od_w_out,
                          p.ffn_w_up + (size_t)DM * 2 * DFF, p.ffn_w_down + (size_t)DFF * DM};
  u16* dsts[9] = {p.wt_in0, p.wt_out0, p.wt_up0, p.wt_dn0, p.wt_in1, p.wt_glu, p.wt_out1, p.wt_up1, p.wt_dn1};
  const int Ks[9] = {1024, 1024, 1024, DFF, 1024, 512, 1024, 1024, DFF};
  const int Ns[9] = {2304, 1024, 2 * DFF, 1024, 2048, 1024, 1024, 2 * DFF, 1024};
  const int kinds[9] = {0, 0, 1, 0, 0, 2, 0, 1, 0};
  int total = 0;
#pragma unroll
  for (int i = 0; i < 9; ++i) total += (Ks[i] >> 6) * (Ns[i] >> 6);
  const int NMOD = 192;
  for (int t = blockIdx.x; t < NMOD + total; t += gridDim.x) {
    if (t < NMOD) {
      const int layer = t / 96, cgp = t % 96;
      const int tid = threadIdx.x, col = cgp * 64 + (tid & 63), kq = tid >> 6;
      const float* W = p.mod_w + (size_t)layer * DM * 6 * DM;
      float a0 = 0.f, a1 = 0.f;
      for (int k = kq * 256; k < kq * 256 + 256; ++k) {
        float w = W[(size_t)k * (6 * DM) + col];
        a0 += silu_f(p.c[k]) * w;
        a1 += silu_f(p.c_ctx[k]) * w;
      }
      sm[(kq * 64 + (tid & 63)) * 2] = a0;
      sm[(kq * 64 + (tid & 63)) * 2 + 1] = a1;
      __syncthreads();
      if (tid < 128) {
        int cc = tid & 63, which = tid >> 6;
        float s = 0.f;
        for (int q = 0; q < 4; ++q) s += sm[(q * 64 + cc) * 2 + which];
        int colo = cgp * 64 + cc;
        p.mod[(size_t)(layer * 2 + which) * 6 * DM + colo] = s + p.mod_b[layer * 6 * DM + colo];
      }
      __syncthreads();
    } else {
      int tt = t - NMOD;
#pragma unroll
      for (int i = 0; i < 9; ++i) {
        int cnt = (Ks[i] >> 6) * (Ns[i] >> 6);
        if (tt >= 0 && tt < cnt) transpose_tile(srcs[i], Ks[i], Ns[i], dsts[i], kinds[i], tt, sm);
        tt -= cnt;
      }
    }
  }
}

template <bool HAS_Y, bool HAS_H>
DI void phase_rows(const Params& p, int row0, int row1, const float* xin_ctx, const float* xin_lat,
                   float* xout_ctx, float* xout_lat, const float* Y, const float* modl  ,
                   int gate_idx, const float* gpost, const float* modh  , int shift_idx,
                   const float* gpre, u16* Hout) {
  const int lane = threadIdx.x & 63;
  const int wid = blockIdx.x * 4 + (threadIdx.x >> 6), nw = gridDim.x * 4;
  for (int row = row0 + wid; row < row1; row += nw) {
    const bool isc = row < CTXN;
    const float* xr = isc ? xin_ctx + (size_t)row * DM : xin_lat + (size_t)(row - CTXN) * DM;
    float4 xv[4];
#pragma unroll
    for (int j = 0; j < 4; ++j) xv[j] = *(const float4*)(xr + j * 256 + lane * 4);
    if (HAS_Y) {
      const float* yr = Y + (size_t)row * DM;
      const float* gt = modl + (size_t)(isc ? 6 : 0) * DM + gate_idx * DM;
      float4 yv[4];
      float ss = 0.f;
#pragma unroll
      for (int j = 0; j < 4; ++j) {
        yv[j] = *(const float4*)(yr + j * 256 + lane * 4);
        ss += yv[j].x * yv[j].x + yv[j].y * yv[j].y + yv[j].z * yv[j].z + yv[j].w * yv[j].w;
      }
      ss = wsum(ss);
      const float rinv = rsqrtf(ss * (1.f / DM) + 1e-6f);
      float* xo = isc ? xout_ctx + (size_t)row * DM : xout_lat + (size_t)(row - CTXN) * DM;
#pragma unroll
      for (int j = 0; j < 4; ++j) {
        float4 g = *(const float4*)(gpost + j * 256 + lane * 4);
        float4 gg = *(const float4*)(gt + j * 256 + lane * 4);
        xv[j].x += gg.x * (yv[j].x * rinv * g.x);
        xv[j].y += gg.y * (yv[j].y * rinv * g.y);
        xv[j].z += gg.z * (yv[j].z * rinv * g.z);
        xv[j].w += gg.w * (yv[j].w * rinv * g.w);
        *(float4*)(xo + j * 256 + lane * 4) = xv[j];
      }
    }
    if (HAS_H) {
      float ss = 0.f;
#pragma unroll
      for (int j = 0; j < 4; ++j) ss += xv[j].x * xv[j].x + xv[j].y * xv[j].y + xv[j].z * xv[j].z + xv[j].w * xv[j].w;
      ss = wsum(ss);
      const float rinv = rsqrtf(ss * (1.f / DM) + 1e-6f);
      const float* sh = modh + (size_t)(isc ? 6 : 0) * DM + shift_idx * DM;
      const float* sc = sh + DM;
#pragma unroll
      for (int j = 0; j < 4; ++j) {
        float4 g = *(const float4*)(gpre + j * 256 + lane * 4);
        float4 s1 = *(const float4*)(sh + j * 256 + lane * 4);
        float4 s2 = *(const float4*)(sc + j * 256 + lane * 4);
        float h0 = xv[j].x * rinv * g.x * (1.f + s2.x) + s1.x;
        float h1 = xv[j].y * rinv * g.y * (1.f + s2.y) + s1.y;
        float h2 = xv[j].z * rinv * g.z * (1.f + s2.z) + s1.z;
        float h3 = xv[j].w * rinv * g.w * (1.f + s2.w) + s1.w;
        uint2 o; o.x = pk2(h0, h1); o.y = pk2(h2, h3);
        *(uint2*)(Hout + (size_t)row * DM + j * 256 + lane * 4) = o;
      }
    }
  }
}

enum { EPI_SPLIT = 0, EPI_F32 = 1, EPI_GLU = 2, EPI_FFNUP = 3 };
struct GemmDesc {
  const u16* A; const u16* Bt; int lda; int K; int nN; int tm0; int nM;
  void* d0; void* d1; int ld0; int ld1; int split;
  const float* cw; const float* cb;
};

template <int MODE>
DI void gemm_tile(const GemmDesc& g, char* smem, int tmi, int tn) {
  const int tid = threadIdx.x, lane = tid & 63, w = tid >> 6, h = lane >> 5, l31 = lane & 31;
  const int wm = w >> 1, wn = w & 1;
  constexpr int ASZ = 256 * 80, BSZ = 128 * 80, STG = ASZ + BSZ;
  const u16* arow[4];
  int seq_base = 0, seq_len = MT, vrow0 = tmi * 256;
  if (MODE == EPI_FFNUP) {
    if (tmi < 2) { seq_base = 0; seq_len = CTXN; vrow0 = 254 * tmi - 1; }
    else { seq_base = CTXN; seq_len = LSEQ; vrow0 = 254 * (tmi - 2) - 1; }
  }
#pragma unroll
  for (int j = 0; j < 4; ++j) {
    int r = (tid + 256 * j) >> 2;
    int kc = (tid + 256 * j) & 3;
    if (MODE == EPI_FFNUP) {
      int v = vrow0 + r;
      arow[j] = (v >= 0 && v < seq_len) ? g.A + (size_t)(seq_base + v) * g.lda + kc * 8 : nullptr;
    } else {
      arow[j] = g.A + (size_t)(vrow0 + r) * g.lda + kc * 8;
    }
  }
  const u16* brow[2];
#pragma unroll
  for (int j = 0; j < 2; ++j) {
    int n = (tid + 256 * j) >> 2, kc = (tid + 256 * j) & 3;
    brow[j] = g.Bt + (size_t)(tn * 128 + n) * g.K + kc * 8;
  }
  f32x16 acc[4][2];
#pragma unroll
  for (int a = 0; a < 4; ++a)
#pragma unroll
    for (int b = 0; b < 2; ++b)
#pragma unroll
      for (int i = 0; i < 16; ++i) acc[a][b][i] = 0.f;

  uint4 ra[4], rb[2];
  const int nk = g.K >> 5;
  auto gload = [&](int kt) {
#pragma unroll
    for (int j = 0; j < 4; ++j) {
      if (MODE == EPI_FFNUP) {
        if (arow[j]) ra[j] = *(const uint4*)(arow[j] + kt * 32); else ra[j] = make_uint4(0, 0, 0, 0);
      } else ra[j] = *(const uint4*)(arow[j] + kt * 32);
    }
#pragma unroll
    for (int j = 0; j < 2; ++j) rb[j] = *(const uint4*)(brow[j] + kt * 32);
  };
  auto swrite = [&](int buf) {
    char* sa = smem + buf * STG;
#pragma unroll
    for (int j = 0; j < 4; ++j) { int c = tid + 256 * j; *(uint4*)(sa + (c >> 2) * 80 + (c & 3) * 16) = ra[j]; }
#pragma unroll
    for (int j = 0; j < 2; ++j) { int c = tid + 256 * j; *(uint4*)(sa + ASZ + (c >> 2) * 80 + (c & 3) * 16) = rb[j]; }
  };
  gload(0); swrite(0); __syncthreads();
  for (int kt = 0; kt < nk; ++kt) {
    if (kt + 1 < nk) gload(kt + 1);
    const char* sa = smem + (kt & 1) * STG + (wm * 128 + l31) * 80 + h * 16;
    const char* sb = smem + (kt & 1) * STG + ASZ + (wn * 64 + l31) * 80 + h * 16;
#pragma unroll
    for (int ks = 0; ks < 2; ++ks) {
      bf16x8 af[4], bf[2];
#pragma unroll
      for (int mi = 0; mi < 4; ++mi) af[mi] = *(const bf16x8*)(sa + mi * 32 * 80 + ks * 32);
#pragma unroll
      for (int ni = 0; ni < 2; ++ni) bf[ni] = *(const bf16x8*)(sb + ni * 32 * 80 + ks * 32);
#pragma unroll
      for (int mi = 0; mi < 4; ++mi)
#pragma unroll
        for (int ni = 0; ni < 2; ++ni) acc[mi][ni] = MFMA32(af[mi], bf[ni], acc[mi][ni]);
    }
    if (kt + 1 < nk) swrite((kt + 1) & 1);
    __syncthreads();
  }
  const int rbase = tmi * 256 + wm * 128;
  const int cbase = tn * 128 + wn * 64;
  if (MODE == EPI_SPLIT) {
#pragma unroll
    for (int mi = 0; mi < 4; ++mi)
#pragma unroll
      for (int ni = 0; ni < 2; ++ni) {
        const int col = cbase + ni * 32 + l31;
        u16* dst; int ld, cc;
        if (col < g.split) { dst = (u16*)g.d0; ld = g.ld0; cc = col; } else { dst = (u16*)g.d1; ld = g.ld1; cc = col - g.split; }
#pragma unroll
        for (int i = 0; i < 16; ++i) {
          const int row = rbase + mi * 32 + crow(i, h);
          dst[(size_t)row * ld + cc] = f2bf(acc[mi][ni][i]);
        }
      }
  } else if (MODE == EPI_F32) {
    float* dst = (float*)g.d0;
#pragma unroll
    for (int mi = 0; mi < 4; ++mi)
#pragma unroll
      for (int ni = 0; ni < 2; ++ni) {
        const int col = cbase + ni * 32 + l31;
#pragma unroll
        for (int i = 0; i < 16; ++i) {
          const int row = rbase + mi * 32 + crow(i, h);
          dst[(size_t)row * g.ld0 + col] = acc[mi][ni][i];
        }
      }
  } else if (MODE == EPI_GLU) {
    u16* dst = (u16*)g.d0;
    const int col = (tn * 2 + wn) * 32 + l31;
#pragma unroll
    for (int mi = 0; mi < 4; ++mi)
#pragma unroll
      for (int i = 0; i < 16; ++i) {
        const int row = rbase + mi * 32 + crow(i, h);
        float v = acc[mi][0][i] * sigmoid_f(acc[mi][1][i]);
        dst[(size_t)row * g.ld0 + col] = f2bf(v);
      }
  } else {
    constexpr int TS = 536;
#pragma unroll
    for (int mi = 0; mi < 4; ++mi)
#pragma unroll
      for (int ni = 0; ni < 2; ++ni) {
        const int c = wn * 64 + ni * 32 + l31;
#pragma unroll
        for (int q = 0; q < 4; ++q) {
          const int r = wm * 128 + mi * 32 + 8 * q + 4 * h;
          uint2 v; v.x = pk2(acc[mi][ni][4 * q], acc[mi][ni][4 * q + 1]); v.y = pk2(acc[mi][ni][4 * q + 2], acc[mi][ni][4 * q + 3]);
          *(uint2*)(smem + c * TS + r * 2) = v;
        }
      }
    __syncthreads();
    {
      const int c = tid & 63, rq = tid >> 6;
      const int fa = tn * 64 + c, fg = DFF + fa;
      const float wa0 = g.cw[fa], wa1 = g.cw[2 * DFF + fa], wa2 = g.cw[4 * DFF + fa], ba = g.cb[fa];
      const float wg0 = g.cw[fg], wg1 = g.cw[2 * DFF + fg], wg2 = g.cw[4 * DFF + fg], bg = g.cb[fg];
      const u16* ta = (const u16*)(smem + c * TS);
      const u16* tg = (const u16*)(smem + (64 + c) * TS);
      int rs = rq * 64, re = rs + 64;
      if (rs < 1) rs = 1;
      if (re > 255) re = 255;
      float ap = bf2f(ta[rs - 1]), ac = bf2f(ta[rs]);
      float gp = bf2f(tg[rs - 1]), gc = bf2f(tg[rs]);
      u16* dst = (u16*)g.d0;
      for (int r = rs; r < re; ++r) {
        float an = bf2f(ta[r + 1]), gn = bf2f(tg[r + 1]);
        int v = vrow0 + r;
        if (v < seq_len) {
          float av = wa0 * ap + wa1 * ac + wa2 * an + ba;
          float gv = wg0 * gp + wg1 * gc + wg2 * gn + bg;
          dst[(size_t)(seq_base + v) * DFF + fa] = f2bf(av * silu_f(gv));
        }
        ap = ac; ac = an; gp = gc; gc = gn;
      }
    }
    __syncthreads();
  }
}

template <int MODE>
DI void phase_gemm(const GemmDesc& g, char* smem) {
  const int ntiles = g.nM * g.nN;
  for (int t0 = blockIdx.x; t0 < ntiles * REP_G; t0 += gridDim.x) {
    const int t = t0 % ntiles;
    const int tm = g.tm0 + t / g.nN, tn = t % g.nN;
    gemm_tile<MODE>(g, smem, tm, tn);
  }
}

DI void rope_angles(int row, int i, float& cs, float& sn) {
  const int pos = row - CTXN;
  const int rr = pos >> 6, cc = pos & 63;
  const int fi = i & 15;
  const float inv = exp2f(-(float)fi * (13.287712379549449f / 16.f));
  const float ang = (float)((i < 16) ? rr : cc) * inv;
  sincosf(ang, &sn, &cs);
}

DI void qk_prep(const u16* __restrict__ src, int lds, int coff, int nheads, u16* __restrict__ dst, const float* gnorm  ,
                float oscale, int row0) {
  const int lane = threadIdx.x & 63, hh = lane >> 5, i = lane & 31;
  const int wid = blockIdx.x * 4 + (threadIdx.x >> 6), nw = gridDim.x * 4;
  const int npair = nheads >> 1;
  const int nitems = (MT - row0) * npair;
  for (int it = wid; it < nitems; it += nw) {
    const int row = row0 + it / npair, head = (it % npair) * 2 + hh;
    unsigned v = *(const unsigned*)(src + (size_t)row * lds + coff + head * 64 + 2 * i);
    float e = bflo(v), o = bfhi(v);
    if (gnorm) {
      float ss = hsum32(e * e + o * o);
      float rinv = rsqrtf(ss * (1.f / 64.f) + 1e-6f);
      e = e * rinv * gnorm[2 * i]; o = o * rinv * gnorm[2 * i + 1];
    }
    if (row >= CTXN) {
      float cs, sn; rope_angles(row, i, cs, sn);
      float e2 = e * cs - o * sn, o2 = e * sn + o * cs;
      e = e2; o = o2;
    }
    *(unsigned*)(dst + ((size_t)head * MT + row) * 64 + 2 * i) = pk2(e * oscale, o * oscale);
  }
}

DI void v_transpose(const u16* __restrict__ src, int lds, int coff, int ncols, u16* __restrict__ dst, char* smem) {
  u16* sm = (u16*)smem;
  const int tid = threadIdx.x;
  const int ndt = ncols >> 6;
  const int ntasks = NCHUNK * ndt;
  for (int t = blockIdx.x; t < ntasks; t += gridDim.x) {
    const int tt = t / ndt, dt = t % ndt;
    {
      const int tok = tid >> 2, part = tid & 3;
      const u16* sp = src + (size_t)(tt * 64 + tok) * lds + coff + dt * 64 + part * 16;
      uint4 a = *(const uint4*)sp, b = *(const uint4*)(sp + 8);
      unsigned* d = (unsigned*)(sm + tok * 66 + part * 16);
      d[0] = a.x; d[1] = a.y; d[2] = a.z; d[3] = a.w; d[4] = b.x; d[5] = b.y; d[6] = b.z; d[7] = b.w;
    }
    __syncthreads();
    {
      const int d = tid >> 2, part = tid & 3;
      unsigned o[8];
#pragma unroll
      for (int j = 0; j < 8; ++j) {
        unsigned lo = sm[(part * 16 + 2 * j) * 66 + d], hi = sm[(part * 16 + 2 * j + 1) * 66 + d];
        o[j] = lo | (hi << 16);
      }
      u16* dp = dst + (size_t)(dt * 64 + d) * MT + tt * 64 + part * 16;
      *(uint4*)dp = make_uint4(o[0], o[1], o[2], o[3]);
      *(uint4*)(dp + 8) = make_uint4(o[4], o[5], o[6], o[7]);
    }
    __syncthreads();
  }
}

DI void gated_conv(const Params& p, const u16* __restrict__ G, u16* __restrict__ A2) {
  const int lane = threadIdx.x & 63;
  const int wid = blockIdx.x * 4 + (threadIdx.x >> 6), nw = gridDim.x * 4;
  const int nitems = MT * 4;
  for (int it = wid; it < nitems; it += nw) {
    const int row = it >> 2, c = ((it & 3) * 64 + lane) * 2;
    const bool first = (row == 0) || (row == CTXN), last = (row == CTXN - 1) || (row == MT - 1);
    const u16* gr = G + (size_t)row * 1536;
    unsigned gb = *(const unsigned*)(gr + c);
    unsigned c1 = *(const unsigned*)(gr + 512 + c), v1 = *(const unsigned*)(gr + 1024 + c);
    float m1a = bflo(c1) * bflo(v1), m1b = bfhi(c1) * bfhi(v1);
    float m0a = 0.f, m0b = 0.f, m2a = 0.f, m2b = 0.f;
    if (!first) {
      unsigned c0 = *(const unsigned*)(gr - 1536 + 512 + c), v0 = *(const unsigned*)(gr - 1536 + 1024 + c);
      m0a = bflo(c0) * bflo(v0); m0b = bfhi(c0) * bfhi(v0);
    }
    if (!last) {
      unsigned c2 = *(const unsigned*)(gr + 1536 + 512 + c), v2 = *(const unsigned*)(gr + 1536 + 1024 + c);
      m2a = bflo(c2) * bflo(v2); m2b = bfhi(c2) * bfhi(v2);
    }
    const float* cw = p.ev_conv_w;
    float ya = bflo(gb) * (cw[c] * m0a + cw[512 + c] * m1a + cw[1024 + c] * m2a);
    float yb = bfhi(gb) * (cw[c + 1] * m0b + cw[512 + c + 1] * m1b + cw[1024 + c + 1] * m2b);
    *(unsigned*)(A2 + (size_t)row * DM + c) = pk2(ya, yb);
  }
}

DI int kperm(int r) { return (r & 0x13) | ((r & 4) << 1) | ((r & 8) >> 1); }

template <int DV, int NCOMP>
DI void attn_task(char* smem, const u16* __restrict__ Qb, const u16* __restrict__ Kb, const u16* __restrict__ Vt,
                  int qh, int kslot, int q0w, int kh0, int vhead, int nkt, u16* __restrict__ A2, int ocol,
                  float lam, float lam_init, const float* __restrict__ subln) {
  const int tid = threadIdx.x, lane = tid & 63, w = tid >> 6, h = lane >> 5, l31 = lane & 31;
  constexpr int KT = 64 * 144;
  constexpr int STG = NCOMP * KT + DV * 144;
  constexpr int NKC = NCOMP * 2, NVC = DV / 32;
  constexpr int NDB = DV / 32;
  bf16x8 qf[4];
  {
    const u16* qp = Qb + ((size_t)qh * MT + q0w + l31) * 64 + h * 8;
#pragma unroll
    for (int ks = 0; ks < 4; ++ks) qf[ks] = *(const bf16x8*)(qp + ks * 16);
  }
  f32x16 O[NDB];
#pragma unroll
  for (int d = 0; d < NDB; ++d)
#pragma unroll
    for (int i = 0; i < 16; ++i) O[d][i] = 0.f;
  float m = -1e30f, lsum = 0.f;
  uint4 kreg[NKC], vreg[NVC];
  auto gload = [&](int kt) {
#pragma unroll
    for (int j = 0; j < NKC; ++j) {
      const int c = tid + 256 * j, comp = c >> 9, key = (c & 511) >> 3, part = c & 7;
      kreg[j] = *(const uint4*)(Kb + ((size_t)(kh0 + comp) * MT + kt * 64 + key) * 64 + part * 8);
    }
#pragma unroll
    for (int j = 0; j < NVC; ++j) {
      const int c = tid + 256 * j, d = c >> 3, part = c & 7;
      vreg[j] = *(const uint4*)(Vt + ((size_t)vhead * DV + d) * MT + kt * 64 + part * 8);
    }
  };
  auto swrite = [&](int buf) {
    char* sb = smem + buf * STG;
#pragma unroll
    for (int j = 0; j < NKC; ++j) {
      const int c = tid + 256 * j, comp = c >> 9, key = (c & 511) >> 3, part = c & 7;
      *(uint4*)(sb + comp * KT + key * 144 + part * 16) = kreg[j];
    }
#pragma unroll
    for (int j = 0; j < NVC; ++j) {
      const int c = tid + 256 * j, d = c >> 3, part = c & 7;
      *(uint4*)(sb + NCOMP * KT + d * 144 + part * 16) = vreg[j];
    }
  };
  gload(0); swrite(0); __syncthreads();
  for (int kt = 0; kt < nkt; ++kt) {
    if (kt + 1 < nkt) gload(kt + 1);
    const char* sb = smem + (kt & 1) * STG;
    const char* kp = sb + kslot * KT + kperm(l31) * 144 + h * 16;
    f32x16 S0, S1;
#pragma unroll
    for (int i = 0; i < 16; ++i) { S0[i] = 0.f; S1[i] = 0.f; }
#pragma unroll
    for (int ks = 0; ks < 4; ++ks) {
      bf16x8 a0 = *(const bf16x8*)(kp + ks * 32);
      bf16x8 a1 = *(const bf16x8*)(kp + 32 * 144 + ks * 32);
      S0 = MFMA32(a0, qf[ks], S0);
      S1 = MFMA32(a1, qf[ks], S1);
    }
    float mx = S0[0];
#pragma unroll
    for (int i = 1; i < 16; ++i) mx = fmaxf(mx, S0[i]);
#pragma unroll
    for (int i = 0; i < 16; ++i) mx = fmaxf(mx, S1[i]);
    mx = fmaxf(mx, __shfl_xor(mx, 32));
    const float mnew = fmaxf(m, mx);
    if (__any(mnew > m)) {
      const float alpha = __builtin_amdgcn_exp2f(m - mnew);
      lsum *= alpha;
#pragma unroll
      for (int d = 0; d < NDB; ++d)
#pragma unroll
        for (int i = 0; i < 16; ++i) O[d][i] *= alpha;
      m = mnew;
    }
    float ps = 0.f;
#pragma unroll
    for (int i = 0; i < 16; ++i) { S0[i] = __builtin_amdgcn_exp2f(S0[i] - m); ps += S0[i]; }
#pragma unroll
    for (int i = 0; i < 16; ++i) { S1[i] = __builtin_amdgcn_exp2f(S1[i] - m); ps += S1[i]; }
    lsum += ps;
    bf16x8 pf[4];
#pragma unroll
    for (int s = 0; s < 2; ++s) {
      uint4 a, b;
      a.x = pk2(S0[8 * s], S0[8 * s + 1]); a.y = pk2(S0[8 * s + 2], S0[8 * s + 3]);
      a.z = pk2(S0[8 * s + 4], S0[8 * s + 5]); a.w = pk2(S0[8 * s + 6], S0[8 * s + 7]);
      b.x = pk2(S1[8 * s], S1[8 * s + 1]); b.y = pk2(S1[8 * s + 2], S1[8 * s + 3]);
      b.z = pk2(S1[8 * s + 4], S1[8 * s + 5]); b.w = pk2(S1[8 * s + 6], S1[8 * s + 7]);
      pf[s] = __builtin_bit_cast(bf16x8, a);
      pf[2 + s] = __builtin_bit_cast(bf16x8, b);
    }
    const char* vp = sb + NCOMP * KT + l31 * 144 + h * 16;
#pragma unroll
    for (int kk = 0; kk < 4; ++kk)
#pragma unroll
      for (int d = 0; d < NDB; ++d) {
        bf16x8 vf = *(const bf16x8*)(vp + d * 32 * 144 + kk * 32);
        O[d] = MFMA32(vf, pf[kk], O[d]);
      }
    if (kt + 1 < nkt) swrite((kt + 1) & 1);
    __syncthreads();
  }
  const float ltot = lsum + __shfl_xor(lsum, 32);
  const float inv = 1.f / ltot;
  const int row = q0w + l31;
  if (NCOMP == 1) {
#pragma unroll
    for (int d = 0; d < NDB; ++d)
#pragma unroll
      for (int q = 0; q < 4; ++q) {
        const int dd = d * 32 + 8 * q + 4 * h;
        uint2 v; v.x = pk2(O[d][4 * q] * inv, O[d][4 * q + 1] * inv); v.y = pk2(O[d][4 * q + 2] * inv, O[d][4 * q + 3] * inv);
        *(uint2*)(A2 + (size_t)row * DM + ocol + dd) = v;
      }
  } else {
    float* ox = (float*)smem;
    const int ql = (w >> 1) * 32 + l31;
    if (w & 1) {
#pragma unroll
      for (int d = 0; d < NDB; ++d)
#pragma unroll
        for (int q = 0; q < 4; ++q) {
          const int dd = d * 32 + 8 * q + 4 * h;
          float4 v = make_float4(O[d][4 * q] * inv, O[d][4 * q + 1] * inv, O[d][4 * q + 2] * inv, O[d][4 * q + 3] * inv);
          *(float4*)(ox + ql * 132 + dd) = v;
        }
    }
    __syncthreads();
    if (!(w & 1)) {
      float ss = 0.f;
#pragma unroll
      for (int d = 0; d < NDB; ++d)
#pragma unroll
        for (int q = 0; q < 4; ++q) {
          const int dd = d * 32 + 8 * q + 4 * h;
          float4 o2 = *(const float4*)(ox + ql * 132 + dd);
          O[d][4 * q] = O[d][4 * q] * inv - lam * o2.x;
          O[d][4 * q + 1] = O[d][4 * q + 1] * inv - lam * o2.y;
          O[d][4 * q + 2] = O[d][4 * q + 2] * inv - lam * o2.z;
          O[d][4 * q + 3] = O[d][4 * q + 3] * inv - lam * o2.w;
          ss += O[d][4 * q] * O[d][4 * q] + O[d][4 * q + 1] * O[d][4 * q + 1] + O[d][4 * q + 2] * O[d][4 * q + 2] + O[d][4 * q + 3] * O[d][4 * q + 3];
        }
      ss += __shfl_xor(ss, 32);
      const float r = rsqrtf(ss * (1.f / 128.f) + 1e-6f) * (1.f - lam_init);
#pragma unroll
      for (int d = 0; d < NDB; ++d)
#pragma unroll
        for (int q = 0; q < 4; ++q) {
          const int dd = d * 32 + 8 * q + 4 * h;
          float4 gs = *(const float4*)(subln + dd);
          uint2 v; v.x = pk2(O[d][4 * q] * r * gs.x, O[d][4 * q + 1] * r * gs.y); v.y = pk2(O[d][4 * q + 2] * r * gs.z, O[d][4 * q + 3] * r * gs.w);
          *(uint2*)(A2 + (size_t)row * DM + ocol + dd) = v;
        }
    }
    __syncthreads();
  }
}

DI void s5_coeffs(const Params& p, int dir, int g, int pp, float& abr, float& abi, float& cr, float& ci) {
  const int idx = (dir * 32 + g) * 64 + pp;
  const float dt = expf(p.log_dt[dir * 32 + g]);
  const float are = p.a_re[idx], aim = p.a_im[idx];
  const float mag = expf(are * dt);
  float sn, cs; sincosf(aim * dt, &sn, &cs);
  abr = mag * cs; abi = mag * sn;
  const float nr = abr - 1.f, ni = abi;
  const float den = are * are + aim * aim;
  cr = (nr * are + ni * aim) / den;
  ci = (ni * are - nr * aim) / den;
}

template <bool OUT>
DI void s5_task(const Params& p, char* smem, int gp, int c, const u16* __restrict__ U1, u16* __restrict__ Z) {
  float* su = (float*)smem;
  u16* hm = (u16*)(smem + 8192);
  const int tid = threadIdx.x, lane = tid & 63, w = tid >> 6;
  const int gl = w >> 1, dir = w & 1, g = 2 * gp + gl;
  {
    const int t = tid >> 2, part = tid & 3;
    uint4 v = *(const uint4*)(U1 + (size_t)(c * 64 + t) * 512 + gp * 32 + part * 8);
    float* d = su + t * 32 + part * 8;
    d[0] = bflo(v.x); d[1] = bfhi(v.x); d[2] = bflo(v.y); d[3] = bfhi(v.y);
    d[4] = bflo(v.z); d[5] = bfhi(v.z); d[6] = bflo(v.w); d[7] = bfhi(v.w);
  }
  float abr, abi, cr, ci;
  s5_coeffs(p, dir, g, lane, abr, abi, cr, ci);
  float bbr[16], bbi[16];
  {
    const size_t bidx = ((size_t)(dir * 32 + g) * 64 + lane) * 16;
#pragma unroll
    for (int q = 0; q < 4; ++q) {
      float4 br = *(const float4*)(p.b_re + bidx + q * 4), bi = *(const float4*)(p.b_im + bidx + q * 4);
      bbr[4 * q] = cr * br.x - ci * bi.x; bbi[4 * q] = cr * bi.x + ci * br.x;
      bbr[4 * q + 1] = cr * br.y - ci * bi.y; bbi[4 * q + 1] = cr * bi.y + ci * br.y;
      bbr[4 * q + 2] = cr * br.z - ci * bi.z; bbi[4 * q + 2] = cr * bi.z + ci * br.z;
      bbr[4 * q + 3] = cr * br.w - ci * bi.w; bbi[4 * q + 3] = cr * bi.w + ci * br.w;
    }
  }
  float2* sp = (float2*)p.s5s + ((size_t)(dir * 32 + g) * NCHUNK + c) * 64 + lane;
  float hr = 0.f, hi = 0.f;
  if (OUT) { float2 h0 = *sp; hr = h0.x; hi = h0.y; }
  __syncthreads();
  for (int step = 0; step < 64; ++step) {
    const int t = dir ? 63 - step : step;
    const float* ur = su + t * 32 + gl * 16;
    float bur = 0.f, bui = 0.f;
#pragma unroll
    for (int q = 0; q < 4; ++q) {
      float4 u = *(const float4*)(ur + 4 * q);
      bur += bbr[4 * q] * u.x + bbr[4 * q + 1] * u.y + bbr[4 * q + 2] * u.z + bbr[4 * q + 3] * u.w;
      bui += bbi[4 * q] * u.x + bbi[4 * q + 1] * u.y + bbi[4 * q + 2] * u.z + bbi[4 * q + 3] * u.w;
    }
    const float nhr = abr * hr - abi * hi + bur;
    const float nhi = abr * hi + abi * hr + bui;
    hr = nhr; hi = nhi;
    if (OUT) {
      u16* hrow = hm + (gl * 64 + t) * 264 + dir * 128 + lane;
      hrow[0] = f2bf(hr); hrow[64] = f2bf(hi);
    }
  }
  if (!OUT) {
    *sp = make_float2(hr, hi);
    __syncthreads();
  } else {
    __syncthreads();
    const int l15 = lane & 15, lq = lane >> 4;
    f32x4 acc0 = {0.f, 0.f, 0.f, 0.f}, acc1 = {0.f, 0.f, 0.f, 0.f};
    const int tb0 = 2 * (w & 1);
#pragma unroll
    for (int kb = 0; kb < 8; ++kb) {
      const int k0 = kb * 32 + lq * 8;
      const int dk = k0 >> 7, rem = k0 & 127, isim = rem >> 6, pp = rem & 63;
      const float* cs = (isim ? p.c_im : p.c_re) + ((size_t)((dk * 32 + g) * 16 + l15)) * 64 + pp;
      const float sg = isim ? -1.f : 1.f;
      float4 c0 = *(const float4*)cs, c1 = *(const float4*)(cs + 4);
      uint4 bb; bb.x = pk2(sg * c0.x, sg * c0.y); bb.y = pk2(sg * c0.z, sg * c0.w); bb.z = pk2(sg * c1.x, sg * c1.y); bb.w = pk2(sg * c1.z, sg * c1.w);
      bf16x8 bfr = __builtin_bit_cast(bf16x8, bb);
      bf16x8 a0 = *(const bf16x8*)(hm + (gl * 64 + tb0 * 16 + l15) * 264 + k0);
      bf16x8 a1 = *(const bf16x8*)(hm + (gl * 64 + (tb0 + 1) * 16 + l15) * 264 + k0);
      acc0 = MFMA16(a0, bfr, acc0);
      acc1 = MFMA16(a1, bfr, acc1);
    }
    const float dsk = p.d_skip[g * 16 + l15];
#pragma unroll
    for (int j = 0; j < 4; ++j) {
      int t = tb0 * 16 + lq * 4 + j;
      float y = acc0[j] + dsk * su[t * 32 + gl * 16 + l15];
      Z[(size_t)(c * 64 + t) * 512 + g * 16 + l15] = f2bf(gelu_tanh(y));
      t += 16;
      y = acc1[j] + dsk * su[t * 32 + gl * 16 + l15];
      Z[(size_t)(c * 64 + t) * 512 + g * 16 + l15] = f2bf(gelu_tanh(y));
    }
    __syncthreads();
  }
}

DI void s5_carry(const Params& p) {
  if (blockIdx.x >= 16) return;
  const int s = blockIdx.x * 256 + threadIdx.x;
  const int dir = s >> 11, g = (s >> 6) & 31, pp = s & 63;
  float abr, abi, cr, ci;
  s5_coeffs(p, dir, g, pp, abr, abi, cr, ci);
#pragma unroll
  for (int q = 0; q < 6; ++q) { float nr = abr * abr - abi * abi, ni = 2.f * abr * abi; abr = nr; abi = ni; }
  float2* base = (float2*)p.s5s + ((size_t)(dir * 32 + g) * NCHUNK) * 64 + pp;
  float hr = 0.f, hi = 0.f;
  for (int b = 0; b < 10; ++b) {
    float2 tmp[26];
#pragma unroll
    for (int j = 0; j < 26; ++j) {
      const int step = b * 26 + j;
      const int c = dir == 0 ? step : (step < 4 ? 3 - step : 263 - step);
      tmp[j] = base[(size_t)c * 64];
    }
#pragma unroll
    for (int j = 0; j < 26; ++j) {
      const int step = b * 26 + j;
      const int c = dir == 0 ? step : (step < 4 ? 3 - step : 263 - step);
      base[(size_t)c * 64] = make_float2(hr, hi);
      const float nr = abr * hr - abi * hi + tmp[j].x;
      const float ni = abr * hi + abi * hr + tmp[j].y;
      hr = nr; hi = ni;
    }
  }
}

DI unsigned gb_ld(unsigned* p) { return __hip_atomic_load(p, __ATOMIC_RELAXED, __HIP_MEMORY_SCOPE_AGENT); }
DI unsigned gb_add(unsigned* p, unsigned v) { return __hip_atomic_fetch_add(p, v, __ATOMIC_RELAXED, __HIP_MEMORY_SCOPE_AGENT); }
DI void grid_barrier(unsigned* bar, unsigned& epoch) {
  asm volatile("s_waitcnt vmcnt(0)" ::: "memory");
  __syncthreads();
  if (threadIdx.x == 0) {
    __builtin_amdgcn_fence(__ATOMIC_RELEASE, "agent");
    asm volatile("s_waitcnt vmcnt(0)" ::: "memory");
    const unsigned grp = blockIdx.x & 15u;
    const unsigned ngb = (gridDim.x + 15u - grp) >> 4;
    const unsigned old = gb_add(&bar[64 * (1 + grp)], 1u);
    if (old + 1u == (epoch + 1u) * ngb) {
      const unsigned ot = gb_add(&bar[64 * 17], 1u);
      if (ot + 1u == (epoch + 1u) * 16u) __hip_atomic_store(&bar[0], epoch + 1u, __ATOMIC_RELAXED, __HIP_MEMORY_SCOPE_AGENT);
    }
    while (gb_ld(&bar[0]) < epoch + 1u) __builtin_amdgcn_s_sleep(1);
    __builtin_amdgcn_fence(__ATOMIC_ACQUIRE, "agent");
    asm volatile("s_waitcnt vmcnt(0)" ::: "memory");
  }
  epoch++;
  __syncthreads();
}

__global__ void __launch_bounds__(256, 2) fwd_megakernel(Params p) {
  extern __shared__ __attribute__((aligned(16))) char smem[];
  cg::grid_group grid = cg::this_grid();
  const size_t RW = (size_t)MT * DM;
  u16* A2 = p.H;
  u16* Qb = (u16*)p.Y;
  u16* Kb = Qb + RW / 2;
  u16* Vt = Kb + RW / 2;
  const float* mod0 = p.mod;
  const float* mod1 = p.mod + 2 * 6 * DM;

  unsigned epoch = 0;
  if (p.ph_lo < 0) grid.sync();
#define PHASE_BEGIN(k) if ((k) >= p.ph_lo && (k) < p.ph_hi) { if ((k) > p.ph_lo) grid_barrier(p.bar, epoch);
#define PHASE_END }

  PHASE_BEGIN(0) for (int rep = 0; rep < REP_P; ++rep) phase_prep_weights(p, smem); PHASE_END

  PHASE_BEGIN(1)
    for (int rep = 0; rep < REP_O; ++rep) phase_rows<false, true>(p, 0, MT, p.ctx, p.x, nullptr, nullptr, nullptr, nullptr, 0, nullptr, mod0, 0, p.norm_pre, p.H);
  PHASE_END

  PHASE_BEGIN(2) {
    GemmDesc g{}; g.A = p.H; g.Bt = p.wt_in0; g.lda = DM; g.K = DM; g.nN = 18; g.tm0 = 0; g.nM = 65;
    g.d0 = p.big; g.ld0 = 1536; g.d1 = p.big + (size_t)MT * 1536; g.ld1 = 768; g.split = 1536;
    phase_gemm<EPI_SPLIT>(g, smem);
  } PHASE_END

  PHASE_BEGIN(3) {
    const u16* G = p.big; const u16* QKV = p.big + (size_t)MT * 1536;
    for (int rep = 0; rep < REP_O; ++rep) {
    qk_prep(QKV, 768, 0, 8, Qb, p.ev_q_norm, 0.125f * LOG2E, 0);
    qk_prep(QKV, 768, 512, 2, Kb, p.ev_k_norm, 1.f, 0);
    v_transpose(QKV, 768, 640, 128, Vt, smem);
    gated_conv(p, G, A2);
    }
  } PHASE_END

  PHASE_BEGIN(4) {
    const int w = threadIdx.x >> 6;
    const int nlat = 8 * 128, nctx = 8 * 2;
    for (int t0 = blockIdx.x; t0 < (nlat + nctx) * REP_A; t0 += gridDim.x) {
      const int t = t0 % (nlat + nctx);
      int head, q0, nkt;
      if (t < nlat) { head = t & 7; q0 = CTXN + (t >> 3) * 128; nkt = NCHUNK; }
      else { int tt = t - nlat; head = tt & 7; q0 = (tt >> 3) * 128; nkt = CTXN / 64; }
      attn_task<64, 1>(smem, Qb, Kb, Vt, head, 0, q0 + 32 * w, head >> 2, head >> 2, nkt, A2, 512 + head * 64, 0.f, 0.f, nullptr);
    }
  } PHASE_END

  PHASE_BEGIN(5) {
    GemmDesc g{}; g.A = A2; g.Bt = p.wt_out0; g.lda = DM; g.K = DM; g.nN = 8; g.tm0 = 0; g.nM = 65;
    g.d0 = p.Y; g.ld0 = DM;
    phase_gemm<EPI_F32>(g, smem);
  } PHASE_END

  PHASE_BEGIN(6)
    for (int rep = 0; rep < REP_O; ++rep) phase_rows<true, true>(p, 0, MT, p.ctx, p.x, p.xctx, p.out, p.Y, mod0, 2, p.norm_post, mod0, 3, p.norm_pre + DM, p.H);
  PHASE_END

  PHASE_BEGIN(7) {
    GemmDesc g{}; g.A = p.H; g.Bt = p.wt_up0; g.lda = DM; g.K = DM; g.nN = 44; g.tm0 = 0; g.nM = 67;
    g.d0 = p.big; g.cw = p.ffn_conv_w; g.cb = p.ffn_conv_b;
    phase_gemm<EPI_FFNUP>(g, smem);
  } PHASE_END

  PHASE_BEGIN(8) {
    GemmDesc g{}; g.A = p.big; g.Bt = p.wt_dn0; g.lda = DFF; g.K = DFF; g.nN = 8; g.tm0 = 0; g.nM = 65;
    g.d0 = p.Y; g.ld0 = DM;
    phase_gemm<EPI_F32>(g, smem);
  } PHASE_END

  PHASE_BEGIN(9)
    phase_rows<true, true>(p, 0, MT, p.xctx, p.out, p.xctx, p.out, p.Y, mod0, 5, p.norm_post + DM, mod1, 0, p.norm_pre + 2 * DM, p.H);
  PHASE_END

  u16* U1 = p.big;
  u16* QKV1 = p.big + (size_t)MT * 512;
  u16* Z = p.big + (size_t)MT * 2048;

  PHASE_BEGIN(10) {
    GemmDesc g{}; g.A = p.H; g.Bt = p.wt_in1; g.lda = DM; g.K = DM; g.nN = 16; g.tm0 = 0; g.nM = 65;
    g.d0 = U1; g.ld0 = 512; g.d1 = QKV1; g.ld1 = 1536; g.split = 512;
    phase_gemm<EPI_SPLIT>(g, smem);
  } PHASE_END

  PHASE_BEGIN(11) {
    for (int rep = 0; rep < REP_O; ++rep) {
    qk_prep(QKV1, 1536, 0, 8, Qb, nullptr, 0.125f * LOG2E, CTXN);
    qk_prep(QKV1, 1536, 512, 8, Kb, nullptr, 1.f, 0);
    v_transpose(QKV1, 1536, 1024, 512, Vt, smem);
    }
    for (int t0 = blockIdx.x; t0 < 16 * NCHUNK * REP_S; t0 += gridDim.x) { const int t = t0 % (16 * NCHUNK); s5_task<false>(p, smem, t & 15, t >> 4, U1, Z); }
  } PHASE_END

  PHASE_BEGIN(12) {
    s5_carry(p);
    float lam;
    {
      const int lane = threadIdx.x & 63;
      float s1 = wsum(p.lam_q1[lane] * p.lam_k1[lane]);
      float s2 = wsum(p.lam_q2[lane] * p.lam_k2[lane]);
      lam = expf(s1) - expf(s2) + 0.35550906759f;
    }
    const int w = threadIdx.x >> 6;
    for (int t0 = blockIdx.x; t0 < 4 * 256 * REP_A; t0 += gridDim.x) {
      const int t = t0 & 1023;
      const int head = t & 3, q0 = CTXN + (t >> 2) * 64;
      attn_task<128, 2>(smem, Qb, Kb, Vt, head * 2 + (w & 1), w & 1, q0 + 32 * (w >> 1), head * 2, head, NCHUNK, A2, 512 + head * 128,
                        lam, 0.35550906759f, p.subln);
    }
  } PHASE_END

  PHASE_BEGIN(13) {
    for (int t0 = blockIdx.x; t0 < 16 * (NCHUNK - 4) * REP_S; t0 += gridDim.x) { const int t = t0 % (16 * (NCHUNK - 4)); s5_task<true>(p, smem, t & 15, 4 + (t >> 4), U1, Z); }
  } PHASE_END

  PHASE_BEGIN(14) {
    GemmDesc g{}; g.A = Z; g.Bt = p.wt_glu; g.lda = 512; g.K = 512; g.nN = 8; g.tm0 = 1; g.nM = 64;
    g.d0 = A2; g.ld0 = DM;
    phase_gemm<EPI_GLU>(g, smem);
  } PHASE_END

  PHASE_BEGIN(15) {
    GemmDesc g{}; g.A = A2; g.Bt = p.wt_out1; g.lda = DM; g.K = DM; g.nN = 8; g.tm0 = 1; g.nM = 64;
    g.d0 = p.Y; g.ld0 = DM;
    phase_gemm<EPI_F32>(g, smem);
  } PHASE_END

  PHASE_BEGIN(16)
    phase_rows<true, true>(p, CTXN, MT, p.xctx, p.out, p.xctx, p.out, p.Y, mod1, 2, p.norm_post + 2 * DM, mod1, 3, p.norm_pre + 3 * DM, p.H);
  PHASE_END

  PHASE_BEGIN(17) {
    GemmDesc g{}; g.A = p.H; g.Bt = p.wt_up1; g.lda = DM; g.K = DM; g.nN = 44; g.tm0 = 2; g.nM = 65;
    g.d0 = p.big; g.cw = p.ffn_conv_w + 3 * 2 * DFF; g.cb = p.ffn_conv_b + 2 * DFF;
    phase_gemm<EPI_FFNUP>(g, smem);
  } PHASE_END

  PHASE_BEGIN(18) {
    GemmDesc g{}; g.A = p.big; g.Bt = p.wt_dn1; g.lda = DFF; g.K = DFF; g.nN = 8; g.tm0 = 1; g.nM = 64;
    g.d0 = p.Y; g.ld0 = DM;
    phase_gemm<EPI_F32>(g, smem);
  } PHASE_END

  PHASE_BEGIN(19)
    phase_rows<true, false>(p, CTXN, MT, p.xctx, p.out, p.xctx, p.out, p.Y, mod1, 5, p.norm_post + 3 * DM, nullptr, 0, nullptr, nullptr);
  PHASE_END
}

extern "C" void kernel_launch(void* const* d_in, const int* in_sizes, int n_in, void* d_out, int out_size, void* d_ws,
                              size_t ws_size, hipStream_t stream) {
  static int grid_blocks = 0;
  if (!grid_blocks) {
    hipFuncSetAttribute((const void*)fwd_megakernel, hipFuncAttributeMaxDynamicSharedMemorySize, LDS_BYTES);
    int dev = 0, cus = 0, per_cu = 0;
    hipGetDevice(&dev);
    hipDeviceGetAttribute(&cus, hipDeviceAttributeMultiprocessorCount, dev);
    hipOccupancyMaxActiveBlocksPerMultiprocessor(&per_cu, fwd_megakernel, 256, LDS_BYTES);
    if (per_cu > 2) per_cu = 2;
    grid_blocks = cus * per_cu;
  }
  Params p{};
  const float* const* in = (const float* const*)d_in;
  p.x = in[0]; p.c = in[1]; p.ctx = in[2]; p.c_ctx = in[3]; p.mod_w = in[4]; p.mod_b = in[5]; p.norm_pre = in[6]; p.norm_post = in[7];
  p.ffn_w_up = in[8]; p.ffn_conv_w = in[9]; p.ffn_conv_b = in[10]; p.ffn_w_down = in[11];
  p.ev_w_in = in[12]; p.ev_conv_w = in[13]; p.ev_q_norm = in[14]; p.ev_k_norm = in[15]; p.ev_w_out = in[16];
  p.od_w_in = in[17]; p.a_re = in[18]; p.a_im = in[19]; p.log_dt = in[20]; p.b_re = in[21]; p.b_im = in[22]; p.c_re = in[23]; p.c_im = in[24];
  p.d_skip = in[25]; p.glu_w = in[26]; p.lam_q1 = in[27]; p.lam_k1 = in[28]; p.lam_q2 = in[29]; p.lam_k2 = in[30]; p.subln = in[31]; p.od_w_out = in[32];
  p.out = (float*)d_out;
  char* ws = (char*)d_ws;
  size_t off = 0;
  auto take = [&](size_t bytes) { char* r = ws + off; off += (bytes + 255) & ~(size_t)255; return r; };
  p.wt_in0 = (u16*)take((size_t)2304 * 1024 * 2);
  p.wt_out0 = (u16*)take((size_t)1024 * 1024 * 2);
  p.wt_up0 = (u16*)take((size_t)2 * DFF * 1024 * 2);
  p.wt_dn0 = (u16*)take((size_t)1024 * DFF * 2);
  p.wt_in1 = (u16*)take((size_t)2048 * 1024 * 2);
  p.wt_glu = (u16*)take((size_t)1024 * 512 * 2);
  p.wt_out1 = (u16*)take((size_t)1024 * 1024 * 2);
  p.wt_up1 = (u16*)take((size_t)2 * DFF * 1024 * 2);
  p.wt_dn1 = (u16*)take((size_t)1024 * DFF * 2);
  p.mod = (float*)take((size_t)2 * 2 * 6 * DM * 4);
  p.xctx = (float*)take((size_t)CTXN * DM * 4);
  p.s5s = (float*)take((size_t)2 * 32 * NCHUNK * 64 * 8);
  p.H = (u16*)take((size_t)MT * DM * 2);
  p.Y = (float*)take((size_t)MT * DM * 4);
  p.big = (u16*)take((size_t)MT * DFF * 2);
  p.bar = (unsigned*)take(8192);
  p.ph_lo = 0; p.ph_hi = 20;
  if (off > ws_size) { fprintf(stderr, "workspace too small: need %zu have %zu\n", off, ws_size); }
  (void)hipMemsetAsync(p.bar, 0, 8192, stream);
  void* args[] = {&p};
  hipError_t e = hipLaunchCooperativeKernel((const void*)fwd_megakernel, dim3(grid_blocks), dim3(256), args, LDS_BYTES, stream);
  if (e != hipSuccess) fprintf(stderr, "cooperative launch failed: %s (grid %d)\n", hipGetErrorString(e), grid_blocks);
}
```

```cpp
#include <hip/hip_runtime.h>
#include <hip/hip_cooperative_groups.h>
#include <stdint.h>
#include <stdio.h>
namespace cg = cooperative_groups;

#define DI __device__ __forceinline__
typedef unsigned short u16;
typedef short bf16x8 __attribute__((ext_vector_type(8)));
typedef float f32x16 __attribute__((ext_vector_type(16)));
typedef float f32x4 __attribute__((ext_vector_type(4)));
typedef __bf16 bf2_t __attribute__((ext_vector_type(2)));
typedef float f2_t __attribute__((ext_vector_type(2)));

constexpr int DM = 1024;
constexpr int LSEQ = 16384;
constexpr int CTXN = 256;
constexpr int MT = LSEQ + CTXN;
constexpr int DFF = 2816;
constexpr int NCHUNK = MT / 64;
constexpr int LDS_BYTES = 77824;
#ifndef REP_A
#define REP_A 1
#endif
#ifndef REP_G
#define REP_G 1
#endif
#ifndef REP_O
#define REP_O 1
#endif
#ifndef REP_P
#define REP_P 1
#endif
#ifndef REP_S
#define REP_S 1
#endif
constexpr float LOG2E = 1.4426950408889634f;

DI unsigned pk2(float a, float b) { f2_t v = {a, b}; bf2_t r = __builtin_convertvector(v, bf2_t); return __builtin_bit_cast(unsigned, r); }
DI u16 f2bf(float a) { return (u16)(pk2(a, 0.f) & 0xffffu); }
DI float bflo(unsigned v) { return __uint_as_float(v << 16); }
DI float bfhi(unsigned v) { return __uint_as_float(v & 0xffff0000u); }
DI float bf2f(u16 v) { return __uint_as_float(((unsigned)v) << 16); }
DI int crow(int i, int h) { return (i & 3) + 8 * (i >> 2) + 4 * h; }
DI float wsum(float v) {
  v += __shfl_xor(v, 32); v += __shfl_xor(v, 16); v += __shfl_xor(v, 8);
  v += __shfl_xor(v, 4); v += __shfl_xor(v, 2); v += __shfl_xor(v, 1); return v;
}
DI float hsum32(float v) {
  v += __shfl_xor(v, 16); v += __shfl_xor(v, 8); v += __shfl_xor(v, 4); v += __shfl_xor(v, 2); v += __shfl_xor(v, 1); return v;
}
DI float silu_f(float x) { return x / (1.f + __expf(-x)); }
DI float sigmoid_f(float x) { return 1.f / (1.f + __expf(-x)); }
DI float gelu_tanh(float x) {
  float a = 0.7978845608028654f * (x + 0.044715f * x * x * x);
  float t = 1.f - 2.f / (__expf(2.f * a) + 1.f);
  return 0.5f * x * (1.f + t);
}
#define MFMA32(a, b, c) __builtin_amdgcn_mfma_f32_32x32x16_bf16((a), (b), (c), 0, 0, 0)
#define MFMA16(a, b, c) __builtin_amdgcn_mfma_f32_16x16x32_bf16((a), (b), (c), 0, 0, 0)

struct Params {
  const float *x, *c, *ctx, *c_ctx, *mod_w, *mod_b, *norm_pre, *norm_post, *ffn_w_up, *ffn_conv_w, *ffn_conv_b, *ffn_w_down;
  const float *ev_w_in, *ev_conv_w, *ev_q_norm, *ev_k_norm, *ev_w_out;
  const float *od_w_in, *a_re, *a_im, *log_dt, *b_re, *b_im, *c_re, *c_im, *d_skip, *glu_w;
  const float *lam_q1, *lam_k1, *lam_q2, *lam_k2, *subln, *od_w_out;
  float* out;
  u16 *wt_in0, *wt_out0, *wt_up0, *wt_dn0, *wt_in1, *wt_glu, *wt_out1, *wt_up1, *wt_dn1;
  float* mod;
  float* xctx;
  float* s5s;
  u16* H;
  float* Y;
  u16* big;
  unsigned* bar;
  int ph_lo, ph_hi;
};

DI int perm_row(int kind, int n) {
  if (kind == 1) {
    if (n < DFF) return (n >> 6) * 128 + (n & 63);
    int m = n - DFF; return (m >> 6) * 128 + 64 + (m & 63);
  } else if (kind == 2) {
    if (n < 512) return (n >> 5) * 64 + (n & 31);
    int m = n - 512; return (m >> 5) * 64 + 32 + (m & 31);
  }
  return n;
}

DI void transpose_tile(const float* __restrict__ W, int K, int N, u16* __restrict__ Wt, int kind, int tile, float* sm) {
  const int nN = N >> 6;
  const int k0 = (tile / nN) * 64, n0 = (tile % nN) * 64;
  const int tid = threadIdx.x;
  for (int r = tid >> 6; r < 64; r += 4) sm[r * 65 + (tid & 63)] = W[(size_t)(k0 + r) * N + n0 + (tid & 63)];
  __syncthreads();
  const int kk = (tid & 31) * 2;
  for (int n = tid >> 5; n < 64; n += 8) {
    unsigned v = pk2(sm[kk * 65 + n], sm[(kk + 1) * 65 + n]);
    *(unsigned*)(Wt + (size_t)perm_row(kind, n0 + n) * K + k0 + kk) = v;
  }
  __syncthreads();
}

DI void phase_prep_weights(const Params& p, char* smem) {
  float* sm = (float*)smem;
  const float* srcs[9] = {p.ev_w_in, p.ev_w_out, p.ffn_w_up, p.ffn_w_down, p.od_w_in, p.glu_w, p.od_w_out,
                          p.ffn_w_up + (size_t)DM * 2 * DFF, p.ffn_w_down + (size_t)DFF * DM};
  u16* dsts[9] = {p.wt_in0, p.wt_out0, p.wt_up0, p.wt_dn0, p.wt_in1, p.wt_glu, p.wt_out1, p.wt_up1, p.wt_dn1};
  const int Ks[9] = {1024, 1024, 1024, DFF, 1024, 512, 1024, 1024, DFF};
  const int Ns[9] = {2304, 1024, 2 * DFF, 1024, 2048, 1024, 1024, 2 * DFF, 1024};
  const int kinds[9] = {0, 0, 1, 0, 0, 2, 0, 1, 0};
  int total = 0;
#pragma unroll
  for (int i = 0; i < 9; ++i) total += (Ks[i] >> 6) * (Ns[i] >> 6);
  const int NMOD = 192;
  for (int t = blockIdx.x; t < NMOD + total; t += gridDim.x) {
    if (t < NMOD) {
      const int layer = t / 96, cgp = t % 96;
      const int tid = threadIdx.x, col = cgp * 64 + (tid & 63), kq = tid >> 6;
      const float* W = p.mod_w + (size_t)layer * DM * 6 * DM;
      float a0 = 0.f, a1 = 0.f;
      for (int k = kq * 256; k < kq * 256 + 256; ++k) {
        float w = W[(size_t)k * (6 * DM) + col];
        a0 += silu_f(p.c[k]) * w;
        a1 += silu_f(p.c_ctx[k]) * w;
      }
      sm[(kq * 64 + (tid & 63)) * 2] = a0;
      sm[(kq * 64 + (tid & 63)) * 2 + 1] = a1;
      __syncthreads();
      if (tid < 128) {
        int cc = tid & 63, which = tid >> 6;
        float s = 0.f;
        for (int q = 0; q < 4; ++q) s += sm[(q * 64 + cc) * 2 + which];
        int colo = cgp * 64 + cc;
        p.mod[(size_t)(layer * 2 + which) * 6 * DM + colo] = s + p.mod_b[layer * 6 * DM + colo];
      }
      __syncthreads();
    } else {
      int tt = t - NMOD;
#pragma unroll
      for (int i = 0; i < 9; ++i) {
        int cnt = (Ks[i] >> 6) * (Ns[i] >> 6);
        if (tt >= 0 && tt < cnt) transpose_tile(srcs[i], Ks[i], Ns[i], dsts[i], kinds[i], tt, sm);
        tt -= cnt;
      }
    }
  }
}

template <bool HAS_Y, bool HAS_H>
DI void phase_rows(const Params& p, int row0, int row1, const float* xin_ctx, const float* xin_lat,
                   float* xout_ctx, float* xout_lat, const float* Y, const float* modl  ,
                   int gate_idx, const float* gpost, const float* modh  , int shift_idx,
                   const float* gpre, u16* Hout) {
  const int lane = threadIdx.x & 63;
  const int wid = blockIdx.x * 4 + (threadIdx.x >> 6), nw = gridDim.x * 4;
  for (int row = row0 + wid; row < row1; row += nw) {
    const bool isc = row < CTXN;
    const float* xr = isc ? xin_ctx + (size_t)row * DM : xin_lat + (size_t)(row - CTXN) * DM;
    float4 xv[4];
#pragma unroll
    for (int j = 0; j < 4; ++j) xv[j] = *(const float4*)(xr + j * 256 + lane * 4);
    if (HAS_Y) {
      const float* yr = Y + (size_t)row * DM;
      const float* gt = modl + (size_t)(isc ? 6 : 0) * DM + gate_idx * DM;
      float4 yv[4];
      float ss = 0.f;
#pragma unroll
      for (int j = 0; j < 4; ++j) {
        yv[j] = *(const float4*)(yr + j * 256 + lane * 4);
        ss += yv[j].x * yv[j].x + yv[j].y * yv[j].y + yv[j].z * yv[j].z + yv[j].w * yv[j].w;
      }
      ss = wsum(ss);
      const float rinv = rsqrtf(ss * (1.f / DM) + 1e-6f);
      float* xo = isc ? xout_ctx + (size_t)row * DM : xout_lat + (size_t)(row - CTXN) * DM;
#pragma unroll
      for (int j = 0; j < 4; ++j) {
        float4 g = *(const float4*)(gpost + j * 256 + lane * 4);
        float4 gg = *(const float4*)(gt + j * 256 + lane * 4);
        xv[j].x += gg.x * (yv[j].x * rinv * g.x);
        xv[j].y += gg.y * (yv[j].y * rinv * g.y);
        xv[j].z += gg.z * (yv[j].z * rinv * g.z);
        xv[j].w += gg.w * (yv[j].w * rinv * g.w);
        *(float4*)(xo + j * 256 + lane * 4) = xv[j];
      }
    }
    if (HAS_H) {
      float ss = 0.f;
#pragma unroll
      for (int j = 0; j < 4; ++j) ss += xv[j].x * xv[j].x + xv[j].y * xv[j].y + xv[j].z * xv[j].z + xv[j].w * xv[j].w;
      ss = wsum(ss);
      const float rinv = rsqrtf(ss * (1.f / DM) + 1e-6f);
      const float* sh = modh + (size_t)(isc ? 6 : 0) * DM + shift_idx * DM;
      const float* sc = sh + DM;
#pragma unroll
      for (int j = 0; j < 4; ++j) {
        float4 g = *(const float4*)(gpre + j * 256 + lane * 4);
        float4 s1 = *(const float4*)(sh + j * 256 + lane * 4);
        float4 s2 = *(const float4*)(sc + j * 256 + lane * 4);
        float h0 = xv[j].x * rinv * g.x * (1.f + s2.x) + s1.x;
        float h1 = xv[j].y * rinv * g.y * (1.f + s2.y) + s1.y;
        float h2 = xv[j].z * rinv * g.z * (1.f + s2.z) + s1.z;
        float h3 = xv[j].w * rinv * g.w * (1.f + s2.w) + s1.w;
        uint2 o; o.x = pk2(h0, h1); o.y = pk2(h2, h3);
        *(uint2*)(Hout + (size_t)row * DM + j * 256 + lane * 4) = o;
      }
    }
  }
}

enum { EPI_SPLIT = 0, EPI_F32 = 1, EPI_GLU = 2, EPI_FFNUP = 3 };
struct GemmDesc {
  const u16* A; const u16* Bt; int lda; int K; int nN; int tm0; int nM;
  void* d0; void* d1; int ld0; int ld1; int split;
  const float* cw; const float* cb;
  const u16* zrow;
};

template <int MODE>
DI void gemm_tile(const GemmDesc& g, char* smem, int tmi, int tn) {
  const int tid = threadIdx.x, lane = tid & 63, w = tid >> 6, h = lane >> 5, l31 = lane & 31;
  const int wm = w >> 1, wn = w & 1;
  constexpr int ASZ = 256 * 64, BSZ = 128 * 64, STG = ASZ + BSZ;
  int seq_base = 0, seq_len = MT, vrow0 = tmi * 256;
  if (MODE == EPI_FFNUP) {
    if (tmi < 2) { seq_base = 0; seq_len = CTXN; vrow0 = 254 * tmi - 1; }
    else { seq_base = CTXN; seq_len = LSEQ; vrow0 = 254 * (tmi - 2) - 1; }
  }
  const int gkc = ((tid & 3) ^ ((tid >> 4) & 3)) * 8;
  const u16* arow[4];
#pragma unroll
  for (int j = 0; j < 4; ++j) {
    const int r = (tid >> 2) + 64 * j;
    if (MODE == EPI_FFNUP) {
      const int v = vrow0 + r;
      arow[j] = (v >= 0 && v < seq_len) ? g.A + (size_t)(seq_base + v) * g.lda + gkc : g.zrow + gkc;
    } else {
      arow[j] = g.A + (size_t)(vrow0 + r) * g.lda + gkc;
    }
  }
  const u16* brow[2];
#pragma unroll
  for (int j = 0; j < 2; ++j) brow[j] = g.Bt + (size_t)(tn * 128 + (tid >> 2) + 64 * j) * g.K + gkc;
  f32x16 acc[4][2];
#pragma unroll
  for (int a = 0; a < 4; ++a)
#pragma unroll
    for (int b = 0; b < 2; ++b)
#pragma unroll
      for (int i = 0; i < 16; ++i) acc[a][b][i] = 0.f;

  const int nk = g.K >> 5;
  char* dma_dst = smem + (w * 64) * 16;
#define G_DMA(kt, stg) { char* d_ = dma_dst + (stg) * STG; \
    __builtin_amdgcn_global_load_lds((const unsigned*)(arow[0] + (kt) * 32), (unsigned*)(d_), 16, 0, 0); \
    __builtin_amdgcn_global_load_lds((const unsigned*)(arow[1] + (kt) * 32), (unsigned*)(d_ + 4096), 16, 0, 0); \
    __builtin_amdgcn_global_load_lds((const unsigned*)(arow[2] + (kt) * 32), (unsigned*)(d_ + 8192), 16, 0, 0); \
    __builtin_amdgcn_global_load_lds((const unsigned*)(arow[3] + (kt) * 32), (unsigned*)(d_ + 12288), 16, 0, 0); \
    __builtin_amdgcn_global_load_lds((const unsigned*)(brow[0] + (kt) * 32), (unsigned*)(d_ + ASZ), 16, 0, 0); \
    __builtin_amdgcn_global_load_lds((const unsigned*)(brow[1] + (kt) * 32), (unsigned*)(d_ + ASZ + 4096), 16, 0, 0); }
  const int sw = (l31 >> 2) & 3;
  const int aoff0 = (wm * 128 + l31) * 64 + ((h ^ sw) * 16);
  const int aoff1 = (wm * 128 + l31) * 64 + (((2 + h) ^ sw) * 16);
  const int boff0 = ASZ + (wn * 64 + l31) * 64 + ((h ^ sw) * 16);
  const int boff1 = ASZ + (wn * 64 + l31) * 64 + (((2 + h) ^ sw) * 16);
#define G_COMPUTE(stg) { const char* sb_ = smem + (stg) * STG; \
    _Pragma("unroll") for (int ks = 0; ks < 2; ++ks) { \
      bf16x8 af[4], bf[2]; \
      _Pragma("unroll") for (int mi = 0; mi < 4; ++mi) af[mi] = *(const bf16x8*)(sb_ + (ks ? aoff1 : aoff0) + mi * 32 * 64); \
      _Pragma("unroll") for (int ni = 0; ni < 2; ++ni) bf[ni] = *(const bf16x8*)(sb_ + (ks ? boff1 : boff0) + ni * 32 * 64); \
      _Pragma("unroll") for (int mi = 0; mi < 4; ++mi) \
        _Pragma("unroll") for (int ni = 0; ni < 2; ++ni) acc[mi][ni] = MFMA32(af[mi], bf[ni], acc[mi][ni]); \
    } }
#define RAW_BARRIER() { asm volatile("s_waitcnt lgkmcnt(0)" ::: "memory"); __builtin_amdgcn_s_barrier(); }
  G_DMA(0, 0);
  G_DMA(1, 1);
  int stg = 0;
  for (int kt = 0; kt < nk - 1; ++kt) {
    asm volatile("s_waitcnt vmcnt(6)" ::: "memory");
    RAW_BARRIER();
    if (kt + 2 < nk) { const int s2 = (stg == 0) ? 2 : stg - 1; G_DMA(kt + 2, s2); }
    G_COMPUTE(stg);
    stg = (stg == 2) ? 0 : stg + 1;
  }
  asm volatile("s_waitcnt vmcnt(0)" ::: "memory");
  RAW_BARRIER();
  G_COMPUTE(stg);
  __syncthreads();
  const int rbase = tmi * 256 + wm * 128;
  const int cbase = tn * 128 + wn * 64;
  char* wl = smem + w * 19456;
  if (MODE == EPI_F32) {
    float* dst = (float*)g.d0;
    float* lf = (float*)wl;
#pragma unroll
    for (int mi = 0; mi < 4; ++mi) {
#pragma unroll
      for (int ni = 0; ni < 2; ++ni)
#pragma unroll
        for (int i = 0; i < 16; ++i) lf[crow(i, h) * 68 + ni * 32 + l31] = acc[mi][ni][i];
#pragma unroll
      for (int it = 0; it < 8; ++it) {
        const int r = it * 4 + (lane >> 4), c4 = (lane & 15) * 4;
        float4 v = *(const float4*)(lf + r * 68 + c4);
        *(float4*)(dst + (size_t)(rbase + mi * 32 + r) * g.ld0 + cbase + c4) = v;
      }
    }
  } else if (MODE == EPI_SPLIT) {
    u16* dst; int ld, cc;
    if (cbase < g.split) { dst = (u16*)g.d0; ld = g.ld0; cc = cbase; } else { dst = (u16*)g.d1; ld = g.ld1; cc = cbase - g.split; }
    u16* lh = (u16*)wl;
#pragma unroll
    for (int mi = 0; mi < 4; ++mi) {
#pragma unroll
      for (int ni = 0; ni < 2; ++ni)
#pragma unroll
        for (int i = 0; i < 16; ++i) lh[crow(i, h) * 72 + ni * 32 + l31] = f2bf(acc[mi][ni][i]);
#pragma unroll
      for (int it = 0; it < 4; ++it) {
        const int r = it * 8 + (lane >> 3), c8 = (lane & 7) * 8;
        uint4 v = *(const uint4*)(lh + r * 72 + c8);
        *(uint4*)(dst + (size_t)(rbase + mi * 32 + r) * ld + cc + c8) = v;
      }
    }
  } else if (MODE == EPI_GLU) {
    u16* dst = (u16*)g.d0;
    const int col0 = (tn * 2 + wn) * 32;
    u16* lh = (u16*)wl;
#pragma unroll
    for (int mi = 0; mi < 4; ++mi) {
#pragma unroll
      for (int i = 0; i < 16; ++i) lh[crow(i, h) * 40 + l31] = f2bf(acc[mi][0][i] * sigmoid_f(acc[mi][1][i]));
#pragma unroll
      for (int it = 0; it < 2; ++it) {
        const int r = it * 16 + (lane >> 2), c8 = (lane & 3) * 8;
        uint4 v = *(const uint4*)(lh + r * 40 + c8);
        *(uint4*)(dst + (size_t)(rbase + mi * 32 + r) * g.ld0 + col0 + c8) = v;
      }
    }
  } else {
    u16* T = (u16*)smem;
#pragma unroll
    for (int mi = 0; mi < 4; ++mi)
#pragma unroll
      for (int ni = 0; ni < 2; ++ni)
#pragma unroll
        for (int i = 0; i < 16; ++i)
          T[(wm * 128 + mi * 32 + crow(i, h)) * 136 + wn * 64 + ni * 32 + l31] = f2bf(acc[mi][ni][i]);
    __syncthreads();
    {
      const int cg8 = (tid & 7) * 8, r0 = (tid >> 3) * 8;
      const int fa = tn * 64 + cg8, fg = DFF + fa;
      float wa[3][8], wg[3][8], ba[8], bg[8];
#pragma unroll
      for (int q = 0; q < 3; ++q)
#pragma unroll
        for (int e = 0; e < 8; e += 4) {
          float4 x = *(const float4*)(g.cw + q * 2 * DFF + fa + e); wa[q][e] = x.x; wa[q][e + 1] = x.y; wa[q][e + 2] = x.z; wa[q][e + 3] = x.w;
          float4 y = *(const float4*)(g.cw + q * 2 * DFF + fg + e); wg[q][e] = y.x; wg[q][e + 1] = y.y; wg[q][e + 2] = y.z; wg[q][e + 3] = y.w;
        }
#pragma unroll
      for (int e = 0; e < 8; e += 4) {
        float4 x = *(const float4*)(g.cb + fa + e); ba[e] = x.x; ba[e + 1] = x.y; ba[e + 2] = x.z; ba[e + 3] = x.w;
        float4 y = *(const float4*)(g.cb + fg + e); bg[e] = y.x; bg[e + 1] = y.y; bg[e + 2] = y.z; bg[e + 3] = y.w;
      }
      float ap[8], ac[8], an[8], gp[8], gc[8], gn[8];
      auto ld8 = [&](int r, int coff, float* o) {
        uint4 v = *(const uint4*)(T + r * 136 + coff);
        o[0] = bflo(v.x); o[1] = bfhi(v.x); o[2] = bflo(v.y); o[3] = bfhi(v.y); o[4] = bflo(v.z); o[5] = bfhi(v.z); o[6] = bflo(v.w); o[7] = bfhi(v.w);
      };
      const int rm1 = (r0 > 0) ? r0 - 1 : 0;
      ld8(rm1, cg8, ap); ld8(rm1, 64 + cg8, gp);
      ld8(r0, cg8, ac); ld8(r0, 64 + cg8, gc);
      u16* dst = (u16*)g.d0;
#pragma unroll
      for (int rr = 0; rr < 8; ++rr) {
        const int r = r0 + rr;
        const int rn = (r < 255) ? r + 1 : 255;
        ld8(rn, cg8, an); ld8(rn, 64 + cg8, gn);
        const int v = vrow0 + r;
        if (r >= 1 && r <= 254 && v < seq_len) {
          float o[8];
#pragma unroll
          for (int e = 0; e < 8; ++e) {
            const float av = wa[0][e] * ap[e] + wa[1][e] * ac[e] + wa[2][e] * an[e] + ba[e];
            const float gv = wg[0][e] * gp[e] + wg[1][e] * gc[e] + wg[2][e] * gn[e] + bg[e];
            o[e] = av * silu_f(gv);
          }
          uint4 ov; ov.x = pk2(o[0], o[1]); ov.y = pk2(o[2], o[3]); ov.z = pk2(o[4], o[5]); ov.w = pk2(o[6], o[7]);
          *(uint4*)(dst + (size_t)(seq_base + v) * DFF + fa) = ov;
        }
#pragma unroll
        for (int e = 0; e < 8; ++e) { ap[e] = ac[e]; ac[e] = an[e]; gp[e] = gc[e]; gc[e] = gn[e]; }
      }
    }
  }
  __syncthreads();
}

template <int MODE>
DI void phase_gemm(const GemmDesc& g, char* smem) {
  const int ntiles = g.nM * g.nN;
  const int per = gridDim.x >> 3;
  const int slot = (blockIdx.x & 7) * per + (blockIdx.x >> 3);
  for (int q0 = slot; q0 < ntiles * REP_G; q0 += gridDim.x) {
    const int q = q0 % ntiles;
    const int gm = q / (8 * g.nN);
    const int rows = min(8, g.nM - 8 * gm);
    const int ql = q - gm * 8 * g.nN;
    const int tn = ql / rows, tm = g.tm0 + gm * 8 + ql % rows;
    gemm_tile<MODE>(g, smem, tm, tn);
  }
}

DI void rope_angles(int row, int i, float& cs, float& sn) {
  const int pos = row - CTXN;
  const int rr = pos >> 6, cc = pos & 63;
  const int fi = i & 15;
  const float inv = exp2f(-(float)fi * (13.287712379549449f / 16.f));
  const float ang = (float)((i < 16) ? rr : cc) * inv;
  sincosf(ang, &sn, &cs);
}

DI void qk_prep(const u16* __restrict__ src, int lds, int coff, int nheads, u16* __restrict__ dst, const float* gnorm  ,
                float oscale, int row0) {
  const int lane = threadIdx.x & 63, hh = lane >> 5, i = lane & 31;
  const int wid = blockIdx.x * 4 + (threadIdx.x >> 6), nw = gridDim.x * 4;
  const int npair = nheads >> 1;
  const int nitems = (MT - row0) * npair;
  for (int it = wid; it < nitems; it += nw) {
    const int row = row0 + it / npair, head = (it % npair) * 2 + hh;
    unsigned v = *(const unsigned*)(src + (size_t)row * lds + coff + head * 64 + 2 * i);
    float e = bflo(v), o = bfhi(v);
    if (gnorm) {
      float ss = hsum32(e * e + o * o);
      float rinv = rsqrtf(ss * (1.f / 64.f) + 1e-6f);
      e = e * rinv * gnorm[2 * i]; o = o * rinv * gnorm[2 * i + 1];
    }
    if (row >= CTXN) {
      float cs, sn; rope_angles(row, i, cs, sn);
      float e2 = e * cs - o * sn, o2 = e * sn + o * cs;
      e = e2; o = o2;
    }
    *(unsigned*)(dst + ((size_t)head * MT + row) * 64 + 2 * i) = pk2(e * oscale, o * oscale);
  }
}

DI void v_transpose(const u16* __restrict__ src, int lds, int coff, int ncols, u16* __restrict__ dst, char* smem) {
  u16* sm = (u16*)smem;
  const int tid = threadIdx.x;
  const int ndt = ncols >> 6;
  const int ntasks = NCHUNK * ndt;
  for (int t = blockIdx.x; t < ntasks; t += gridDim.x) {
    const int tt = t / ndt, dt = t % ndt;
    {
      const int tok = tid >> 2, part = tid & 3;
      const u16* sp = src + (size_t)(tt * 64 + tok) * lds + coff + dt * 64 + part * 16;
      uint4 a = *(const uint4*)sp, b = *(const uint4*)(sp + 8);
      unsigned* d = (unsigned*)(sm + tok * 66 + part * 16);
      d[0] = a.x; d[1] = a.y; d[2] = a.z; d[3] = a.w; d[4] = b.x; d[5] = b.y; d[6] = b.z; d[7] = b.w;
    }
    __syncthreads();
    {
      const int d = tid >> 2, part = tid & 3;
      unsigned o[8];
#pragma unroll
      for (int j = 0; j < 8; ++j) {
        unsigned lo = sm[(part * 16 + 2 * j) * 66 + d], hi = sm[(part * 16 + 2 * j + 1) * 66 + d];
        o[j] = lo | (hi << 16);
      }
      u16* dp = dst + (size_t)(dt * 64 + d) * MT + tt * 64 + part * 16;
      *(uint4*)dp = make_uint4(o[0], o[1], o[2], o[3]);
      *(uint4*)(dp + 8) = make_uint4(o[4], o[5], o[6], o[7]);
    }
    __syncthreads();
  }
}

DI void gated_conv(const Params& p, const u16* __restrict__ G, u16* __restrict__ A2) {
  const int lane = threadIdx.x & 63;
  const int wid = blockIdx.x * 4 + (threadIdx.x >> 6), nw = gridDim.x * 4;
  const int nitems = MT * 4;
  for (int it = wid; it < nitems; it += nw) {
    const int row = it >> 2, c = ((it & 3) * 64 + lane) * 2;
    const bool first = (row == 0) || (row == CTXN), last = (row == CTXN - 1) || (row == MT - 1);
    const u16* gr = G + (size_t)row * 1536;
    unsigned gb = *(const unsigned*)(gr + c);
    unsigned c1 = *(const unsigned*)(gr + 512 + c), v1 = *(const unsigned*)(gr + 1024 + c);
    float m1a = bflo(c1) * bflo(v1), m1b = bfhi(c1) * bfhi(v1);
    float m0a = 0.f, m0b = 0.f, m2a = 0.f, m2b = 0.f;
    if (!first) {
      unsigned c0 = *(const unsigned*)(gr - 1536 + 512 + c), v0 = *(const unsigned*)(gr - 1536 + 1024 + c);
      m0a = bflo(c0) * bflo(v0); m0b = bfhi(c0) * bfhi(v0);
    }
    if (!last) {
      unsigned c2 = *(const unsigned*)(gr + 1536 + 512 + c), v2 = *(const unsigned*)(gr + 1536 + 1024 + c);
      m2a = bflo(c2) * bflo(v2); m2b = bfhi(c2) * bfhi(v2);
    }
    const float* cw = p.ev_conv_w;
    float ya = bflo(gb) * (cw[c] * m0a + cw[512 + c] * m1a + cw[1024 + c] * m2a);
    float yb = bfhi(gb) * (cw[c + 1] * m0b + cw[512 + c + 1] * m1b + cw[1024 + c + 1] * m2b);
    *(unsigned*)(A2 + (size_t)row * DM + c) = pk2(ya, yb);
  }
}

DI int kperm(int r) { return (r & 0x13) | ((r & 4) << 1) | ((r & 8) >> 1); }

template <int DV, int NCOMP>
DI void attn_task(char* smem, const u16* __restrict__ Qb, const u16* __restrict__ Kb, const u16* __restrict__ Vt,
                  int qh, int kslot, int q0w, int kh0, int vhead, int nkt, u16* __restrict__ A2, int ocol,
                  float lam, float lam_init, const float* __restrict__ subln) {
  const int tid = threadIdx.x, lane = tid & 63, w = tid >> 6, h = lane >> 5, l31 = lane & 31;
  constexpr int KT = 64 * 144;
  constexpr int STG = NCOMP * KT + DV * 144;
  constexpr int NDB = DV / 32;
  bf16x8 qf[4];
  {
    const u16* qp = Qb + ((size_t)qh * MT + q0w + l31) * 64 + h * 8;
#pragma unroll
    for (int ks = 0; ks < 4; ++ks) qf[ks] = *(const bf16x8*)(qp + ks * 16);
  }
  f32x16 O[NDB];
#pragma unroll
  for (int d = 0; d < NDB; ++d)
#pragma unroll
    for (int i = 0; i < 16; ++i) O[d][i] = 0.f;
  float m = -1e30f, lsum = 0.f;
  uint4 kr0, kr1, kr2, kr3, vr0, vr1, vr2, vr3;
  kr2 = kr3 = vr2 = vr3 = make_uint4(0, 0, 0, 0);
  const int skey = (tid & 511) >> 3, spart = tid & 7;
  const u16* kg = Kb + ((size_t)kh0 * MT + skey) * 64 + spart * 8;
  const u16* vg = Vt + ((size_t)vhead * DV + (tid >> 3)) * MT + spart * 8;
  const int ksl = skey * 144 + spart * 16;
  const int vsl = NCOMP * KT + (tid >> 3) * 144 + spart * 16;
#define A_LOAD(kt) { \
    kr0 = *(const uint4*)(kg + (size_t)(kt) * 64 * 64); kr1 = *(const uint4*)(kg + (size_t)(kt) * 64 * 64 + 32 * 64); \
    if (NCOMP == 2) { kr2 = *(const uint4*)(kg + (size_t)MT * 64 + (size_t)(kt) * 64 * 64); kr3 = *(const uint4*)(kg + (size_t)MT * 64 + (size_t)(kt) * 64 * 64 + 32 * 64); } \
    vr0 = *(const uint4*)(vg + (kt) * 64); vr1 = *(const uint4*)(vg + (size_t)32 * MT + (kt) * 64); \
    if (DV == 128) { vr2 = *(const uint4*)(vg + (size_t)64 * MT + (kt) * 64); vr3 = *(const uint4*)(vg + (size_t)96 * MT + (kt) * 64); } }
#define A_WRITE(buf) { char* sb_ = smem + (buf) * STG; \
    *(uint4*)(sb_ + ksl) = kr0; *(uint4*)(sb_ + ksl + 32 * 144) = kr1; \
    if (NCOMP == 2) { *(uint4*)(sb_ + KT + ksl) = kr2; *(uint4*)(sb_ + KT + ksl + 32 * 144) = kr3; } \
    *(uint4*)(sb_ + vsl) = vr0; *(uint4*)(sb_ + vsl + 32 * 144) = vr1; \
    if (DV == 128) { *(uint4*)(sb_ + vsl + 64 * 144) = vr2; *(uint4*)(sb_ + vsl + 96 * 144) = vr3; } }
  A_LOAD(0); A_WRITE(0); __syncthreads();
  for (int kt = 0; kt < nkt; ++kt) {
    const int ktn = (kt + 1 < nkt) ? kt + 1 : kt;
    A_LOAD(ktn);
    __builtin_amdgcn_sched_barrier(0);
    const char* sb = smem + (kt & 1) * STG;
    const char* kp = sb + kslot * KT + kperm(l31) * 144 + h * 16;
    f32x16 S0, S1;
#pragma unroll
    for (int i = 0; i < 16; ++i) { S0[i] = 0.f; S1[i] = 0.f; }
#pragma unroll
    for (int ks = 0; ks < 4; ++ks) {
      bf16x8 a0 = *(const bf16x8*)(kp + ks * 32);
      bf16x8 a1 = *(const bf16x8*)(kp + 32 * 144 + ks * 32);
      S0 = MFMA32(a0, qf[ks], S0);
      S1 = MFMA32(a1, qf[ks], S1);
    }
    float mx = S0[0];
#pragma unroll
    for (int i = 1; i < 16; ++i) mx = fmaxf(mx, S0[i]);
#pragma unroll
    for (int i = 0; i < 16; ++i) mx = fmaxf(mx, S1[i]);
    mx = fmaxf(mx, __shfl_xor(mx, 32));
    const float mnew = fmaxf(m, mx);
    if (__any(mnew > m)) {
      const float alpha = __builtin_amdgcn_exp2f(m - mnew);
      lsum *= alpha;
#pragma unroll
      for (int d = 0; d < NDB; ++d)
#pragma unroll
        for (int i = 0; i < 16; ++i) O[d][i] *= alpha;
      m = mnew;
    }
    float ps = 0.f;
#pragma unroll
    for (int i = 0; i < 16; ++i) { S0[i] = __builtin_amdgcn_exp2f(S0[i] - m); ps += S0[i]; }
#pragma unroll
    for (int i = 0; i < 16; ++i) { S1[i] = __builtin_amdgcn_exp2f(S1[i] - m); ps += S1[i]; }
    lsum += ps;
    bf16x8 pf[4];
#pragma unroll
    for (int s2 = 0; s2 < 2; ++s2) {
      uint4 a, b;
      a.x = pk2(S0[8 * s2], S0[8 * s2 + 1]); a.y = pk2(S0[8 * s2 + 2], S0[8 * s2 + 3]);
      a.z = pk2(S0[8 * s2 + 4], S0[8 * s2 + 5]); a.w = pk2(S0[8 * s2 + 6], S0[8 * s2 + 7]);
      b.x = pk2(S1[8 * s2], S1[8 * s2 + 1]); b.y = pk2(S1[8 * s2 + 2], S1[8 * s2 + 3]);
      b.z = pk2(S1[8 * s2 + 4], S1[8 * s2 + 5]); b.w = pk2(S1[8 * s2 + 6], S1[8 * s2 + 7]);
      pf[s2] = __builtin_bit_cast(bf16x8, a);
      pf[2 + s2] = __builtin_bit_cast(bf16x8, b);
    }
    const char* vp = sb + NCOMP * KT + l31 * 144 + h * 16;
#pragma unroll
    for (int kk = 0; kk < 4; ++kk)
#pragma unroll
      for (int d = 0; d < NDB; ++d) {
        bf16x8 vf = *(const bf16x8*)(vp + d * 32 * 144 + kk * 32);
        O[d] = MFMA32(vf, pf[kk], O[d]);
      }
    A_WRITE((kt + 1) & 1);
    __syncthreads();
  }
  const float ltot = lsum + __shfl_xor(lsum, 32);
  const float inv = 1.f / ltot;
  const int row = q0w + l31;
  if (NCOMP == 1) {
#pragma unroll
    for (int d = 0; d < NDB; ++d)
#pragma unroll
      for (int q = 0; q < 4; ++q) {
        const int dd = d * 32 + 8 * q + 4 * h;
        uint2 v; v.x = pk2(O[d][4 * q] * inv, O[d][4 * q + 1] * inv); v.y = pk2(O[d][4 * q + 2] * inv, O[d][4 * q + 3] * inv);
        *(uint2*)(A2 + (size_t)row * DM + ocol + dd) = v;
      }
  } else {
    float* ox = (float*)smem;
    const int ql = (w >> 1) * 32 + l31;
    if (w & 1) {
#pragma unroll
      for (int d = 0; d < NDB; ++d)
#pragma unroll
        for (int q = 0; q < 4; ++q) {
          const int dd = d * 32 + 8 * q + 4 * h;
          float4 v = make_float4(O[d][4 * q] * inv, O[d][4 * q + 1] * inv, O[d][4 * q + 2] * inv, O[d][4 * q + 3] * inv);
          *(float4*)(ox + ql * 132 + dd) = v;
        }
    }
    __syncthreads();
    if (!(w & 1)) {
      float ss = 0.f;
#pragma unroll
      for (int d = 0; d < NDB; ++d)
#pragma unroll
        for (int q = 0; q < 4; ++q) {
          const int dd = d * 32 + 8 * q + 4 * h;
          float4 o2 = *(const float4*)(ox + ql * 132 + dd);
          O[d][4 * q] = O[d][4 * q] * inv - lam * o2.x;
          O[d][4 * q + 1] = O[d][4 * q + 1] * inv - lam * o2.y;
          O[d][4 * q + 2] = O[d][4 * q + 2] * inv - lam * o2.z;
          O[d][4 * q + 3] = O[d][4 * q + 3] * inv - lam * o2.w;
          ss += O[d][4 * q] * O[d][4 * q] + O[d][4 * q + 1] * O[d][4 * q + 1] + O[d][4 * q + 2] * O[d][4 * q + 2] + O[d][4 * q + 3] * O[d][4 * q + 3];
        }
      ss += __shfl_xor(ss, 32);
      const float r = rsqrtf(ss * (1.f / 128.f) + 1e-6f) * (1.f - lam_init);
#pragma unroll
      for (int d = 0; d < NDB; ++d)
#pragma unroll
        for (int q = 0; q < 4; ++q) {
          const int dd = d * 32 + 8 * q + 4 * h;
          float4 gs = *(const float4*)(subln + dd);
          uint2 v; v.x = pk2(O[d][4 * q] * r * gs.x, O[d][4 * q + 1] * r * gs.y); v.y = pk2(O[d][4 * q + 2] * r * gs.z, O[d][4 * q + 3] * r * gs.w);
          *(uint2*)(A2 + (size_t)row * DM + ocol + dd) = v;
        }
    }
    __syncthreads();
  }
}

DI void s5_coeffs(const Params& p, int dir, int g, int pp, float& abr, float& abi, float& cr, float& ci) {
  const int idx = (dir * 32 + g) * 64 + pp;
  const float dt = expf(p.log_dt[dir * 32 + g]);
  const float are = p.a_re[idx], aim = p.a_im[idx];
  const float mag = expf(are * dt);
  float sn, cs; sincosf(aim * dt, &sn, &cs);
  abr = mag * cs; abi = mag * sn;
  const float nr = abr - 1.f, ni = abi;
  const float den = are * are + aim * aim;
  cr = (nr * are + ni * aim) / den;
  ci = (ni * are - nr * aim) / den;
}

template <bool OUT>
DI void s5_task(const Params& p, char* smem, int gp, int c, const u16* __restrict__ U1, u16* __restrict__ Z) {
  float* su = (float*)smem;
  u16* hm = (u16*)(smem + 8192);
  const int tid = threadIdx.x, lane = tid & 63, w = tid >> 6;
  const int gl = w >> 1, dir = w & 1, g = 2 * gp + gl;
  {
    const int t = tid >> 2, part = tid & 3;
    uint4 v = *(const uint4*)(U1 + (size_t)(c * 64 + t) * 512 + gp * 32 + part * 8);
    float* d = su + t * 32 + part * 8;
    d[0] = bflo(v.x); d[1] = bfhi(v.x); d[2] = bflo(v.y); d[3] = bfhi(v.y);
    d[4] = bflo(v.z); d[5] = bfhi(v.z); d[6] = bflo(v.w); d[7] = bfhi(v.w);
  }
  float abr, abi, cr, ci;
  s5_coeffs(p, dir, g, lane, abr, abi, cr, ci);
  float bbr[16], bbi[16];
  {
    const size_t bidx = ((size_t)(dir * 32 + g) * 64 + lane) * 16;
#pragma unroll
    for (int q = 0; q < 4; ++q) {
      float4 br = *(const float4*)(p.b_re + bidx + q * 4), bi = *(const float4*)(p.b_im + bidx + q * 4);
      bbr[4 * q] = cr * br.x - ci * bi.x; bbi[4 * q] = cr * bi.x + ci * br.x;
      bbr[4 * q + 1] = cr * br.y - ci * bi.y; bbi[4 * q + 1] = cr * bi.y + ci * br.y;
      bbr[4 * q + 2] = cr * br.z - ci * bi.z; bbi[4 * q + 2] = cr * bi.z + ci * br.z;
      bbr[4 * q + 3] = cr * br.w - ci * bi.w; bbi[4 * q + 3] = cr * bi.w + ci * br.w;
    }
  }
  float2* sp = (float2*)p.s5s + ((size_t)(dir * 32 + g) * NCHUNK + c) * 64 + lane;
  float hr = 0.f, hi = 0.f;
  if (OUT) { float2 h0 = *sp; hr = h0.x; hi = h0.y; }
  __syncthreads();
  for (int step = 0; step < 64; ++step) {
    const int t = dir ? 63 - step : step;
    const float* ur = su + t * 32 + gl * 16;
    float bur = 0.f, bui = 0.f;
#pragma unroll
    for (int q = 0; q < 4; ++q) {
      float4 u = *(const float4*)(ur + 4 * q);
      bur += bbr[4 * q] * u.x + bbr[4 * q + 1] * u.y + bbr[4 * q + 2] * u.z + bbr[4 * q + 3] * u.w;
      bui += bbi[4 * q] * u.x + bbi[4 * q + 1] * u.y + bbi[4 * q + 2] * u.z + bbi[4 * q + 3] * u.w;
    }
    const float nhr = abr * hr - abi * hi + bur;
    const float nhi = abr * hi + abi * hr + bui;
    hr = nhr; hi = nhi;
    if (OUT) {
      u16* hrow = hm + (gl * 64 + t) * 264 + dir * 128 + lane;
      hrow[0] = f2bf(hr); hrow[64] = f2bf(hi);
    }
  }
  if (!OUT) {
    *sp = make_float2(hr, hi);
    __syncthreads();
  } else {
    __syncthreads();
    const int l15 = lane & 15, lq = lane >> 4;
    f32x4 acc0 = {0.f, 0.f, 0.f, 0.f}, acc1 = {0.f, 0.f, 0.f, 0.f};
    const int tb0 = 2 * (w & 1);
#pragma unroll
    for (int kb = 0; kb < 8; ++kb) {
      const int k0 = kb * 32 + lq * 8;
      const int dk = k0 >> 7, rem = k0 & 127, isim = rem >> 6, pp = rem & 63;
      const float* cs = (isim ? p.c_im : p.c_re) + ((size_t)((dk * 32 + g) * 16 + l15)) * 64 + pp;
      const float sg = isim ? -1.f : 1.f;
      float4 c0 = *(const float4*)cs, c1 = *(const float4*)(cs + 4);
      uint4 bb; bb.x = pk2(sg * c0.x, sg * c0.y); bb.y = pk2(sg * c0.z, sg * c0.w); bb.z = pk2(sg * c1.x, sg * c1.y); bb.w = pk2(sg * c1.z, sg * c1.w);
      bf16x8 bfr = __builtin_bit_cast(bf16x8, bb);
      bf16x8 a0 = *(const bf16x8*)(hm + (gl * 64 + tb0 * 16 + l15) * 264 + k0);
      bf16x8 a1 = *(const bf16x8*)(hm + (gl * 64 + (tb0 + 1) * 16 + l15) * 264 + k0);
      acc0 = MFMA16(a0, bfr, acc0);
      acc1 = MFMA16(a1, bfr, acc1);
    }
    const float dsk = p.d_skip[g * 16 + l15];
#pragma unroll
    for (int j = 0; j < 4; ++j) {
      int t = tb0 * 16 + lq * 4 + j;
      float y = acc0[j] + dsk * su[t * 32 + gl * 16 + l15];
      Z[(size_t)(c * 64 + t) * 512 + g * 16 + l15] = f2bf(gelu_tanh(y));
      t += 16;
      y = acc1[j] + dsk * su[t * 32 + gl * 16 + l15];
      Z[(size_t)(c * 64 + t) * 512 + g * 16 + l15] = f2bf(gelu_tanh(y));
    }
    __syncthreads();
  }
}

DI void s5_carry(const Params& p) {
  if (blockIdx.x >= 16) return;
  const int s = blockIdx.x * 256 + threadIdx.x;
  const int dir = s >> 11, g = (s >> 6) & 31, pp = s & 63;
  float abr, abi, cr, ci;
  s5_coeffs(p, dir, g, pp, abr, abi, cr, ci);
#pragma unroll
  for (int q = 0; q < 6; ++q) { float nr = abr * abr - abi * abi, ni = 2.f * abr * abi; abr = nr; abi = ni; }
  float2* base = (float2*)p.s5s + ((size_t)(dir * 32 + g) * NCHUNK) * 64 + pp;
  float hr = 0.f, hi = 0.f;
  for (int b = 0; b < 10; ++b) {
    float2 tmp[26];
#pragma unroll
    for (int j = 0; j < 26; ++j) {
      const int step = b * 26 + j;
      const int c = dir == 0 ? step : (step < 4 ? 3 - step : 263 - step);
      tmp[j] = base[(size_t)c * 64];
    }
#pragma unroll
    for (int j = 0; j < 26; ++j) {
      const int step = b * 26 + j;
      const int c = dir == 0 ? step : (step < 4 ? 3 - step : 263 - step);
      base[(size_t)c * 64] = make_float2(hr, hi);
      const float nr = abr * hr - abi * hi + tmp[j].x;
      const float ni = abr * hi + abi * hr + tmp[j].y;
      hr = nr; hi = ni;
    }
  }
}

DI unsigned gb_ld(unsigned* p) { return __hip_atomic_load(p, __ATOMIC_RELAXED, __HIP_MEMORY_SCOPE_AGENT); }
DI unsigned gb_add(unsigned* p, unsigned v) { return __hip_atomic_fetch_add(p, v, __ATOMIC_RELAXED, __HIP_MEMORY_SCOPE_AGENT); }
DI void grid_barrier(unsigned* bar, unsigned& epoch) {
  asm volatile("s_waitcnt vmcnt(0)" ::: "memory");
  __syncthreads();
  if (threadIdx.x == 0) {
    __builtin_amdgcn_fence(__ATOMIC_RELEASE, "agent");
    asm volatile("s_waitcnt vmcnt(0)" ::: "memory");
    const unsigned grp = blockIdx.x & 15u;
    const unsigned ngb = (gridDim.x + 15u - grp) >> 4;
    const unsigned old = gb_add(&bar[64 * (1 + grp)], 1u);
    if (old + 1u == (epoch + 1u) * ngb) {
      const unsigned ot = gb_add(&bar[64 * 17], 1u);
      if (ot + 1u == (epoch + 1u) * 16u) __hip_atomic_store(&bar[0], epoch + 1u, __ATOMIC_RELAXED, __HIP_MEMORY_SCOPE_AGENT);
    }
    while (gb_ld(&bar[0]) < epoch + 1u) __builtin_amdgcn_s_sleep(1);
    __builtin_amdgcn_fence(__ATOMIC_ACQUIRE, "agent");
    asm volatile("s_waitcnt vmcnt(0)" ::: "memory");
  }
  epoch++;
  __syncthreads();
}

__global__ void __launch_bounds__(256, 2) fwd_megakernel(Params p) {
  extern __shared__ __attribute__((aligned(16))) char smem[];
  cg::grid_group grid = cg::this_grid();
  const size_t RW = (size_t)MT * DM;
  u16* A2 = p.H;
  u16* Qb = (u16*)p.Y;
  u16* Kb = Qb + RW / 2;
  u16* Vt = Kb + RW / 2;
  const float* mod0 = p.mod;
  const float* mod1 = p.mod + 2 * 6 * DM;

  unsigned epoch = 0;
  if (p.ph_lo < 0) grid.sync();
#define PHASE_BEGIN(k) if ((k) >= p.ph_lo && (k) < p.ph_hi) { if ((k) > p.ph_lo) grid_barrier(p.bar, epoch);
#define PHASE_END }

  PHASE_BEGIN(0) for (int rep = 0; rep < REP_P; ++rep) phase_prep_weights(p, smem); PHASE_END

  PHASE_BEGIN(1)
    for (int rep = 0; rep < REP_O; ++rep) phase_rows<false, true>(p, 0, MT, p.ctx, p.x, nullptr, nullptr, nullptr, nullptr, 0, nullptr, mod0, 0, p.norm_pre, p.H);
  PHASE_END

  PHASE_BEGIN(2) {
    GemmDesc g{}; g.A = p.H; g.Bt = p.wt_in0; g.lda = DM; g.K = DM; g.nN = 18; g.tm0 = 0; g.nM = 65;
    g.d0 = p.big; g.ld0 = 1536; g.d1 = p.big + (size_t)MT * 1536; g.ld1 = 768; g.split = 1536;
    phase_gemm<EPI_SPLIT>(g, smem);
  } PHASE_END

  PHASE_BEGIN(3) {
    const u16* G = p.big; const u16* QKV = p.big + (size_t)MT * 1536;
    for (int rep = 0; rep < REP_O; ++rep) {
    qk_prep(QKV, 768, 0, 8, Qb, p.ev_q_norm, 0.125f * LOG2E, 0);
    qk_prep(QKV, 768, 512, 2, Kb, p.ev_k_norm, 1.f, 0);
    v_transpose(QKV, 768, 640, 128, Vt, smem);
    gated_conv(p, G, A2);
    }
  } PHASE_END

  PHASE_BEGIN(4) {
    const int w = threadIdx.x >> 6;
    const int nlat = 8 * 128, nctx = 8 * 2;
    for (int t0 = blockIdx.x; t0 < (nlat + nctx) * REP_A; t0 += gridDim.x) {
      const int t = t0 % (nlat + nctx);
      int head, q0, nkt;
      if (t < nlat) { head = t & 7; q0 = CTXN + (t >> 3) * 128; nkt = NCHUNK; }
      else { int tt = t - nlat; head = tt & 7; q0 = (tt >> 3) * 128; nkt = CTXN / 64; }
      attn_task<64, 1>(smem, Qb, Kb, Vt, head, 0, q0 + 32 * w, head >> 2, head >> 2, nkt, A2, 512 + head * 64, 0.f, 0.f, nullptr);
    }
  } PHASE_END

  PHASE_BEGIN(5) {
    GemmDesc g{}; g.A = A2; g.Bt = p.wt_out0; g.lda = DM; g.K = DM; g.nN = 8; g.tm0 = 0; g.nM = 65;
    g.d0 = p.Y; g.ld0 = DM;
    phase_gemm<EPI_F32>(g, smem);
  } PHASE_END

  PHASE_BEGIN(6)
    for (int rep = 0; rep < REP_O; ++rep) phase_rows<true, true>(p, 0, MT, p.ctx, p.x, p.xctx, p.out, p.Y, mod0, 2, p.norm_post, mod0, 3, p.norm_pre + DM, p.H);
  PHASE_END

  PHASE_BEGIN(7) {
    GemmDesc g{}; g.A = p.H; g.Bt = p.wt_up0; g.lda = DM; g.K = DM; g.nN = 44; g.tm0 = 0; g.nM = 67;
    g.d0 = p.big; g.cw = p.ffn_conv_w; g.cb = p.ffn_conv_b; g.zrow = (const u16*)(p.bar + 1024);
    phase_gemm<EPI_FFNUP>(g, smem);
  } PHASE_END

  PHASE_BEGIN(8) {
    GemmDesc g{}; g.A = p.big; g.Bt = p.wt_dn0; g.lda = DFF; g.K = DFF; g.nN = 8; g.tm0 = 0; g.nM = 65;
    g.d0 = p.Y; g.ld0 = DM;
    phase_gemm<EPI_F32>(g, smem);
  } PHASE_END

  PHASE_BEGIN(9)
    phase_rows<true, true>(p, 0, MT, p.xctx, p.out, p.xctx, p.out, p.Y, mod0, 5, p.norm_post + DM, mod1, 0, p.norm_pre + 2 * DM, p.H);
  PHASE_END

  u16* U1 = p.big;
  u16* QKV1 = p.big + (size_t)MT * 512;
  u16* Z = p.big + (size_t)MT * 2048;

  PHASE_BEGIN(10) {
    GemmDesc g{}; g.A = p.H; g.Bt = p.wt_in1; g.lda = DM; g.K = DM; g.nN = 16; g.tm0 = 0; g.nM = 65;
    g.d0 = U1; g.ld0 = 512; g.d1 = QKV1; g.ld1 = 1536; g.split = 512;
    phase_gemm<EPI_SPLIT>(g, smem);
  } PHASE_END

  PHASE_BEGIN(11) {
    for (int rep = 0; rep < REP_O; ++rep) {
    qk_prep(QKV1, 1536, 0, 8, Qb, nullptr, 0.125f * LOG2E, CTXN);
    qk_prep(QKV1, 1536, 512, 8, Kb, nullptr, 1.f, 0);
    v_transpose(QKV1, 1536, 1024, 512, Vt, smem);
    }
    for (int t0 = blockIdx.x; t0 < 16 * NCHUNK * REP_S; t0 += gridDim.x) { const int t = t0 % (16 * NCHUNK); s5_task<false>(p, smem, t & 15, t >> 4, U1, Z); }
  } PHASE_END

  PHASE_BEGIN(12) {
    s5_carry(p);
    float lam;
    {
      const int lane = threadIdx.x & 63;
      float s1 = wsum(p.lam_q1[lane] * p.lam_k1[lane]);
      float s2 = wsum(p.lam_q2[lane] * p.lam_k2[lane]);
      lam = expf(s1) - expf(s2) + 0.35550906759f;
    }
    const int w = threadIdx.x >> 6;
    for (int t0 = blockIdx.x; t0 < 4 * 256 * REP_A; t0 += gridDim.x) {
      const int t = t0 & 1023;
      const int head = t & 3, q0 = CTXN + (t >> 2) * 64;
      attn_task<128, 2>(smem, Qb, Kb, Vt, head * 2 + (w & 1), w & 1, q0 + 32 * (w >> 1), head * 2, head, NCHUNK, A2, 512 + head * 128,
                        lam, 0.35550906759f, p.subln);
    }
  } PHASE_END

  PHASE_BEGIN(13) {
    for (int t0 = blockIdx.x; t0 < 16 * (NCHUNK - 4) * REP_S; t0 += gridDim.x) { const int t = t0 % (16 * (NCHUNK - 4)); s5_task<true>(p, smem, t & 15, 4 + (t >> 4), U1, Z); }
  } PHASE_END

  PHASE_BEGIN(14) {
    GemmDesc g{}; g.A = Z; g.Bt = p.wt_glu; g.lda = 512; g.K = 512; g.nN = 8; g.tm0 = 1; g.nM = 64;
    g.d0 = A2; g.ld0 = DM;
    phase_gemm<EPI_GLU>(g, smem);
  } PHASE_END

  PHASE_BEGIN(15) {
    GemmDesc g{}; g.A = A2; g.Bt = p.wt_out1; g.lda = DM; g.K = DM; g.nN = 8; g.tm0 = 1; g.nM = 64;
    g.d0 = p.Y; g.ld0 = DM;
    phase_gemm<EPI_F32>(g, smem);
  } PHASE_END

  PHASE_BEGIN(16)
    phase_rows<true, true>(p, CTXN, MT, p.xctx, p.out, p.xctx, p.out, p.Y, mod1, 2, p.norm_post + 2 * DM, mod1, 3, p.norm_pre + 3 * DM, p.H);
  PHASE_END

  PHASE_BEGIN(17) {
    GemmDesc g{}; g.A = p.H; g.Bt = p.wt_up1; g.lda = DM; g.K = DM; g.nN = 44; g.tm0 = 2; g.nM = 65;
    g.d0 = p.big; g.cw = p.ffn_conv_w + 3 * 2 * DFF; g.cb = p.ffn_conv_b + 2 * DFF; g.zrow = (const u16*)(p.bar + 1024);
    phase_gemm<EPI_FFNUP>(g, smem);
  } PHASE_END

  PHASE_BEGIN(18) {
    GemmDesc g{}; g.A = p.big; g.Bt = p.wt_dn1; g.lda = DFF; g.K = DFF; g.nN = 8; g.tm0 = 1; g.nM = 64;
    g.d0 = p.Y; g.ld0 = DM;
    phase_gemm<EPI_F32>(g, smem);
  } PHASE_END

  PHASE_BEGIN(19)
    phase_rows<true, false>(p, CTXN, MT, p.xctx, p.out, p.xctx, p.out, p.Y, mod1, 5, p.norm_post + 3 * DM, nullptr, 0, nullptr, nullptr);
  PHASE_END
}

extern "C" void kernel_launch(void* const* d_in, const int* in_sizes, int n_in, void* d_out, int out_size, void* d_ws,
                              size_t ws_size, hipStream_t stream) {
  static int grid_blocks = 0;
  if (!grid_blocks) {
    hipFuncSetAttribute((const void*)fwd_megakernel, hipFuncAttributeMaxDynamicSharedMemorySize, LDS_BYTES);
    int dev = 0, cus = 0, per_cu = 0;
    hipGetDevice(&dev);
    hipDeviceGetAttribute(&cus, hipDeviceAttributeMultiprocessorCount, dev);
    hipOccupancyMaxActiveBlocksPerMultiprocessor(&per_cu, fwd_megakernel, 256, LDS_BYTES);
    if (per_cu > 2) per_cu = 2;
    grid_blocks = cus * per_cu;
  }
  Params p{};
  const float* const* in = (const float* const*)d_in;
  p.x = in[0]; p.c = in[1]; p.ctx = in[2]; p.c_ctx = in[3]; p.mod_w = in[4]; p.mod_b = in[5]; p.norm_pre = in[6]; p.norm_post = in[7];
  p.ffn_w_up = in[8]; p.ffn_conv_w = in[9]; p.ffn_conv_b = in[10]; p.ffn_w_down = in[11];
  p.ev_w_in = in[12]; p.ev_conv_w = in[13]; p.ev_q_norm = in[14]; p.ev_k_norm = in[15]; p.ev_w_out = in[16];
  p.od_w_in = in[17]; p.a_re = in[18]; p.a_im = in[19]; p.log_dt = in[20]; p.b_re = in[21]; p.b_im = in[22]; p.c_re = in[23]; p.c_im = in[24];
  p.d_skip = in[25]; p.glu_w = in[26]; p.lam_q1 = in[27]; p.lam_k1 = in[28]; p.lam_q2 = in[29]; p.lam_k2 = in[30]; p.subln = in[31]; p.od_w_out = in[32];
  p.out = (float*)d_out;
  char* ws = (char*)d_ws;
  size_t off = 0;
  auto take = [&](size_t bytes) { char* r = ws + off; off += (bytes + 255) & ~(size_t)255; return r; };
  p.wt_in0 = (u16*)take((size_t)2304 * 1024 * 2);
  p.wt_out0 = (u16*)take((size_t)1024 * 1024 * 2);
  p.wt_up0 = (u16*)take((size_t)2 * DFF * 1024 * 2);
  p.wt_dn0 = (u16*)take((size_t)1024 * DFF * 2);
  p.wt_in1 = (u16*)take((size_t)2048 * 1024 * 2);
  p.wt_glu = (u16*)take((size_t)1024 * 512 * 2);
  p.wt_out1 = (u16*)take((size_t)1024 * 1024 * 2);
  p.wt_up1 = (u16*)take((size_t)2 * DFF * 1024 * 2);
  p.wt_dn1 = (u16*)take((size_t)1024 * DFF * 2);
  p.mod = (float*)take((size_t)2 * 2 * 6 * DM * 4);
  p.xctx = (float*)take((size_t)CTXN * DM * 4);
  p.s5s = (float*)take((size_t)2 * 32 * NCHUNK * 64 * 8);
  p.H = (u16*)take((size_t)MT * DM * 2);
  p.Y = (float*)take((size_t)MT * DM * 4);
  p.big = (u16*)take((size_t)MT * DFF * 2);
  p.bar = (unsigned*)take(8192);
  p.ph_lo = 0; p.ph_hi = 20;
  if (off > ws_size) { fprintf(stderr, "workspace too small: need %zu have %zu\n", off, ws_size); }
  (void)hipMemsetAsync(p.bar, 0, 8192, stream);
  void* args[] = {&p};
  hipError_t e = hipLaunchCooperativeKernel((const void*)fwd_megakernel, dim3(grid_blocks), dim3(256), args, LDS_BYTES, stream);
  if (e != hipSuccess) fprintf(stderr, "cooperative launch failed: %s (grid %d)\n", hipGetErrorString(e), grid_blocks);
}
```

```cpp
#include <hip/hip_runtime.h>
#include <hip/hip_cooperative_groups.h>
#include <stdint.h>
#include <stdio.h>
namespace cg = cooperative_groups;

#define DI __device__ __forceinline__
typedef unsigned short u16;
typedef short bf16x8 __attribute__((ext_vector_type(8)));
typedef float f32x16 __attribute__((ext_vector_type(16)));
typedef float f32x4 __attribute__((ext_vector_type(4)));
typedef __bf16 bf2_t __attribute__((ext_vector_type(2)));
typedef float f2_t __attribute__((ext_vector_type(2)));

constexpr int DM = 1024;
constexpr int LSEQ = 16384;
constexpr int CTXN = 256;
constexpr int MT = LSEQ + CTXN;
constexpr int DFF = 2816;
constexpr int NCHUNK = MT / 64;
constexpr int LDS_BYTES = 77824;
#ifndef REP_A
#define REP_A 1
#endif
#ifndef REP_G
#define REP_G 1
#endif
#ifndef REP_O
#define REP_O 1
#endif
#ifndef REP_P
#define REP_P 1
#endif
#ifndef KREP
#define KREP 1
#endif
#ifndef REP_S
#define REP_S 1
#endif
constexpr float LOG2E = 1.4426950408889634f;

DI unsigned pk2(float a, float b) { f2_t v = {a, b}; bf2_t r = __builtin_convertvector(v, bf2_t); return __builtin_bit_cast(unsigned, r); }
DI u16 f2bf(float a) { return (u16)(pk2(a, 0.f) & 0xffffu); }
DI float bflo(unsigned v) { return __uint_as_float(v << 16); }
DI float bfhi(unsigned v) { return __uint_as_float(v & 0xffff0000u); }
DI float bf2f(u16 v) { return __uint_as_float(((unsigned)v) << 16); }
DI size_t tidx(int col, int row, int nrows) { return ((size_t)(col >> 5) * nrows + row) * 32 + (col & 31); }
DI int crow(int i, int h) { return (i & 3) + 8 * (i >> 2) + 4 * h; }
DI float wsum(float v) {
  v += __shfl_xor(v, 32); v += __shfl_xor(v, 16); v += __shfl_xor(v, 8);
  v += __shfl_xor(v, 4); v += __shfl_xor(v, 2); v += __shfl_xor(v, 1); return v;
}
DI float hsum32(float v) {
  v += __shfl_xor(v, 16); v += __shfl_xor(v, 8); v += __shfl_xor(v, 4); v += __shfl_xor(v, 2); v += __shfl_xor(v, 1); return v;
}
DI float silu_f(float x) { return x / (1.f + __expf(-x)); }
DI float sigmoid_f(float x) { return 1.f / (1.f + __expf(-x)); }
DI float gelu_tanh(float x) {
  float a = 0.7978845608028654f * (x + 0.044715f * x * x * x);
  float t = 1.f - 2.f / (__expf(2.f * a) + 1.f);
  return 0.5f * x * (1.f + t);
}
#define MFMA32(a, b, c) __builtin_amdgcn_mfma_f32_32x32x16_bf16((a), (b), (c), 0, 0, 0)
#define MFMA16(a, b, c) __builtin_amdgcn_mfma_f32_16x16x32_bf16((a), (b), (c), 0, 0, 0)

struct Params {
  const float *x, *c, *ctx, *c_ctx, *mod_w, *mod_b, *norm_pre, *norm_post, *ffn_w_up, *ffn_conv_w, *ffn_conv_b, *ffn_w_down;
  const float *ev_w_in, *ev_conv_w, *ev_q_norm, *ev_k_norm, *ev_w_out;
  const float *od_w_in, *a_re, *a_im, *log_dt, *b_re, *b_im, *c_re, *c_im, *d_skip, *glu_w;
  const float *lam_q1, *lam_k1, *lam_q2, *lam_k2, *subln, *od_w_out;
  float* out;
  u16 *wt_in0, *wt_out0, *wt_up0, *wt_dn0, *wt_in1, *wt_glu, *wt_out1, *wt_up1, *wt_dn1;
  float* mod;
  float* xctx;
  float* s5s;
  u16* H;
  float* Y;
  u16* big;
  unsigned* bar;
  int ph_lo, ph_hi;
};

DI int perm_row(int kind, int n) {
  if (kind == 1) {
    if (n < DFF) return (n >> 6) * 128 + (n & 63);
    int m = n - DFF; return (m >> 6) * 128 + 64 + (m & 63);
  } else if (kind == 2) {
    if (n < 512) return (n >> 5) * 64 + (n & 31);
    int m = n - 512; return (m >> 5) * 64 + 32 + (m & 31);
  }
  return n;
}

DI void transpose_tile(const float* __restrict__ W, int K, int N, u16* __restrict__ Wt, int kind, int tile, float* sm) {
  const int nN = N >> 6;
  const int k0 = (tile / nN) * 64, n0 = (tile % nN) * 64;
  const int tid = threadIdx.x;
  for (int r = tid >> 6; r < 64; r += 4) sm[r * 65 + (tid & 63)] = W[(size_t)(k0 + r) * N + n0 + (tid & 63)];
  __syncthreads();
  const int kk = (tid & 31) * 2;
  for (int n = tid >> 5; n < 64; n += 8) {
    unsigned v = pk2(sm[kk * 65 + n], sm[(kk + 1) * 65 + n]);
    *(unsigned*)(Wt + tidx(k0 + kk, perm_row(kind, n0 + n), N)) = v;
  }
  __syncthreads();
}

DI void phase_prep_weights(const Params& p, char* smem) {
  float* sm = (float*)smem;
  const float* srcs[9] = {p.ev_w_in, p.ev_w_out, p.ffn_w_up, p.ffn_w_down, p.od_w_in, p.glu_w, p.od_w_out,
                          p.ffn_w_up + (size_t)DM * 2 * DFF, p.ffn_w_down + (size_t)DFF * DM};
  u16* dsts[9] = {p.wt_in0, p.wt_out0, p.wt_up0, p.wt_dn0, p.wt_in1, p.wt_glu, p.wt_out1, p.wt_up1, p.wt_dn1};
  const int Ks[9] = {1024, 1024, 1024, DFF, 1024, 512, 1024, 1024, DFF};
  const int Ns[9] = {2304, 1024, 2 * DFF, 1024, 2048, 1024, 1024, 2 * DFF, 1024};
  const int kinds[9] = {0, 0, 1, 0, 0, 2, 0, 1, 0};
  int total = 0;
#pragma unroll
  for (int i = 0; i < 9; ++i) total += (Ks[i] >> 6) * (Ns[i] >> 6);
  const int NMOD = 192;
  for (int t = blockIdx.x; t < NMOD + total; t += gridDim.x) {
    if (t < NMOD) {
      const int layer = t / 96, cgp = t % 96;
      const int tid = threadIdx.x, col = cgp * 64 + (tid & 63), kq = tid >> 6;
      const float* W = p.mod_w + (size_t)layer * DM * 6 * DM;
      float a0 = 0.f, a1 = 0.f;
      for (int k = kq * 256; k < kq * 256 + 256; ++k) {
        float w = W[(size_t)k * (6 * DM) + col];
        a0 += silu_f(p.c[k]) * w;
        a1 += silu_f(p.c_ctx[k]) * w;
      }
      sm[(kq * 64 + (tid & 63)) * 2] = a0;
      sm[(kq * 64 + (tid & 63)) * 2 + 1] = a1;
      __syncthreads();
      if (tid < 128) {
        int cc = tid & 63, which = tid >> 6;
        float s = 0.f;
        for (int q = 0; q < 4; ++q) s += sm[(q * 64 + cc) * 2 + which];
        int colo = cgp * 64 + cc;
        p.mod[(size_t)(layer * 2 + which) * 6 * DM + colo] = s + p.mod_b[layer * 6 * DM + colo];
      }
      __syncthreads();
    } else {
      int tt = t - NMOD;
#pragma unroll
      for (int i = 0; i < 9; ++i) {
        int cnt = (Ks[i] >> 6) * (Ns[i] >> 6);
        if (tt >= 0 && tt < cnt) transpose_tile(srcs[i], Ks[i], Ns[i], dsts[i], kinds[i], tt, sm);
        tt -= cnt;
      }
    }
  }
}

template <bool HAS_Y, bool HAS_H>
DI void phase_rows(const Params& p, int row0, int row1, const float* xin_ctx, const float* xin_lat,
                   float* xout_ctx, float* xout_lat, const float* Y, const float* modl  ,
                   int gate_idx, const float* gpost, const float* modh  , int shift_idx,
                   const float* gpre, u16* Hout) {
  const int lane = threadIdx.x & 63;
  const int wid = blockIdx.x * 4 + (threadIdx.x >> 6), nw = gridDim.x * 4;
  for (int row = row0 + wid; row < row1; row += nw) {
    const bool isc = row < CTXN;
    const float* xr = isc ? xin_ctx + (size_t)row * DM : xin_lat + (size_t)(row - CTXN) * DM;
    float4 xv[4];
#pragma unroll
    for (int j = 0; j < 4; ++j) xv[j] = *(const float4*)(xr + j * 256 + lane * 4);
    if (HAS_Y) {
      const float* yr = Y + (size_t)row * DM;
      const float* gt = modl + (size_t)(isc ? 6 : 0) * DM + gate_idx * DM;
      float4 yv[4];
      float ss = 0.f;
#pragma unroll
      for (int j = 0; j < 4; ++j) {
        yv[j] = *(const float4*)(yr + j * 256 + lane * 4);
        ss += yv[j].x * yv[j].x + yv[j].y * yv[j].y + yv[j].z * yv[j].z + yv[j].w * yv[j].w;
      }
      ss = wsum(ss);
      const float rinv = rsqrtf(ss * (1.f / DM) + 1e-6f);
      float* xo = isc ? xout_ctx + (size_t)row * DM : xout_lat + (size_t)(row - CTXN) * DM;
#pragma unroll
      for (int j = 0; j < 4; ++j) {
        float4 g = *(const float4*)(gpost + j * 256 + lane * 4);
        float4 gg = *(const float4*)(gt + j * 256 + lane * 4);
        xv[j].x += gg.x * (yv[j].x * rinv * g.x);
        xv[j].y += gg.y * (yv[j].y * rinv * g.y);
        xv[j].z += gg.z * (yv[j].z * rinv * g.z);
        xv[j].w += gg.w * (yv[j].w * rinv * g.w);
        *(float4*)(xo + j * 256 + lane * 4) = xv[j];
      }
    }
    if (HAS_H) {
      float ss = 0.f;
#pragma unroll
      for (int j = 0; j < 4; ++j) ss += xv[j].x * xv[j].x + xv[j].y * xv[j].y + xv[j].z * xv[j].z + xv[j].w * xv[j].w;
      ss = wsum(ss);
      const float rinv = rsqrtf(ss * (1.f / DM) + 1e-6f);
      const float* sh = modh + (size_t)(isc ? 6 : 0) * DM + shift_idx * DM;
      const float* sc = sh + DM;
#pragma unroll
      for (int j = 0; j < 4; ++j) {
        float4 g = *(const float4*)(gpre + j * 256 + lane * 4);
        float4 s1 = *(const float4*)(sh + j * 256 + lane * 4);
        float4 s2 = *(const float4*)(sc + j * 256 + lane * 4);
        float h0 = xv[j].x * rinv * g.x * (1.f + s2.x) + s1.x;
        float h1 = xv[j].y * rinv * g.y * (1.f + s2.y) + s1.y;
        float h2 = xv[j].z * rinv * g.z * (1.f + s2.z) + s1.z;
        float h3 = xv[j].w * rinv * g.w * (1.f + s2.w) + s1.w;
        uint2 o; o.x = pk2(h0, h1); o.y = pk2(h2, h3);
        *(uint2*)(Hout + tidx(j * 256 + lane * 4, row, MT)) = o;
      }
    }
  }
}

enum { EPI_SPLIT = 0, EPI_F32 = 1, EPI_GLU = 2, EPI_FFNUP = 3 };
struct GemmDesc {
  const u16* A; const u16* Bt; int lda; int K; int nN; int tm0; int nM;
  void* d0; void* d1; int ld0; int ld1; int split;
  const float* cw; const float* cb;
  const u16* zrow;
};

template <int MODE>
DI void gemm_tile(const GemmDesc& g, char* smem, int tmi, int tn) {
  const int tid = threadIdx.x, lane = tid & 63, w = tid >> 6, h = lane >> 5, l31 = lane & 31;
  const int wm = w >> 1, wn = w & 1;
  constexpr int ASZ = 256 * 64, BSZ = 128 * 64, STG = ASZ + BSZ;
  int seq_base = 0, seq_len = MT, vrow0 = tmi * 256;
  if (MODE == EPI_FFNUP) {
    if (tmi < 2) { seq_base = 0; seq_len = CTXN; vrow0 = 254 * tmi - 1; }
    else { seq_base = CTXN; seq_len = LSEQ; vrow0 = 254 * (tmi - 2) - 1; }
  }
  const int gkc = ((tid & 3) ^ ((tid >> 4) & 3)) * 8;
  const u16* arow[4];
  int astr[4];
#pragma unroll
  for (int j = 0; j < 4; ++j) {
    const int r = (tid >> 2) + 64 * j;
    if (MODE == EPI_FFNUP) {
      const int v = vrow0 + r;
      const bool ok = (v >= 0 && v < seq_len);
      arow[j] = ok ? g.A + (size_t)(seq_base + v) * 32 + gkc : g.zrow + gkc;
      astr[j] = ok ? MT * 32 : 0;
    } else {
      arow[j] = g.A + (size_t)(vrow0 + r) * 32 + gkc;
      astr[j] = MT * 32;
    }
  }
  const u16* brow[2];
#pragma unroll
  for (int j = 0; j < 2; ++j) brow[j] = g.Bt + (size_t)(tn * 128 + (tid >> 2) + 64 * j) * 32 + gkc;
  const int bstr = g.nN * 128 * 32;
  f32x16 acc[4][2];
#pragma unroll
  for (int a = 0; a < 4; ++a)
#pragma unroll
    for (int b = 0; b < 2; ++b)
#pragma unroll
      for (int i = 0; i < 16; ++i) acc[a][b][i] = 0.f;

  const int nk0 = g.K >> 5;
  const int nk = nk0 * KREP;
  char* dma_dst = smem + (w * 64) * 16;
#define G_DMA(kt_, stg) { char* d_ = dma_dst + (stg) * STG; const int kq_ = (KREP == 1) ? (kt_) : ((kt_) % nk0); \
    __builtin_amdgcn_global_load_lds((const unsigned*)(arow[0] + (size_t)(kq_) * astr[0]), (unsigned*)(d_), 16, 0, 0); \
    __builtin_amdgcn_global_load_lds((const unsigned*)(arow[1] + (size_t)(kq_) * astr[1]), (unsigned*)(d_ + 4096), 16, 0, 0); \
    __builtin_amdgcn_global_load_lds((const unsigned*)(arow[2] + (size_t)(kq_) * astr[2]), (unsigned*)(d_ + 8192), 16, 0, 0); \
    __builtin_amdgcn_global_load_lds((const unsigned*)(arow[3] + (size_t)(kq_) * astr[3]), (unsigned*)(d_ + 12288), 16, 0, 0); \
    __builtin_amdgcn_global_load_lds((const unsigned*)(brow[0] + (size_t)(kq_) * bstr), (unsigned*)(d_ + ASZ), 16, 0, 0); \
    __builtin_amdgcn_global_load_lds((const unsigned*)(brow[1] + (size_t)(kq_) * bstr), (unsigned*)(d_ + ASZ + 4096), 16, 0, 0); }
  const int sw = (l31 >> 2) & 3;
  const int aoff0 = (wm * 128 + l31) * 64 + ((h ^ sw) * 16);
  const int aoff1 = (wm * 128 + l31) * 64 + (((2 + h) ^ sw) * 16);
  const int boff0 = ASZ + (wn * 64 + l31) * 64 + ((h ^ sw) * 16);
  const int boff1 = ASZ + (wn * 64 + l31) * 64 + (((2 + h) ^ sw) * 16);
#define G_COMPUTE(stg) { const char* sb_ = smem + (stg) * STG; \
    _Pragma("unroll") for (int ks = 0; ks < 2; ++ks) { \
      bf16x8 af[4], bf[2]; \
      _Pragma("unroll") for (int mi = 0; mi < 4; ++mi) af[mi] = *(const bf16x8*)(sb_ + (ks ? aoff1 : aoff0) + mi * 32 * 64); \
      _Pragma("unroll") for (int ni = 0; ni < 2; ++ni) bf[ni] = *(const bf16x8*)(sb_ + (ks ? boff1 : boff0) + ni * 32 * 64); \
      _Pragma("unroll") for (int mi = 0; mi < 4; ++mi) \
        _Pragma("unroll") for (int ni = 0; ni < 2; ++ni) acc[mi][ni] = MFMA32(af[mi], bf[ni], acc[mi][ni]); \
    } }
#define RAW_BARRIER() { asm volatile("s_waitcnt lgkmcnt(0)" ::: "memory"); __builtin_amdgcn_s_barrier(); }
  G_DMA(0, 0);
  G_DMA(1, 1);
  int stg = 0;
#define SB_ __builtin_amdgcn_sched_barrier(0)
#define DMA1(ptr, off) __builtin_amdgcn_global_load_lds((const unsigned*)(ptr), (unsigned*)(d_ + (off)), 16, 0, 0)
  for (int kt = 0; kt < nk - 1; ++kt) {
    asm volatile("s_waitcnt vmcnt(6)" ::: "memory");
    RAW_BARRIER();
    const int s2 = (stg == 0) ? 2 : stg - 1;
    const int kn_ = (kt + 2 < nk) ? kt + 2 : nk - 1;
    const int kq_ = (KREP == 1) ? kn_ : (kn_ % nk0);
    char* d_ = dma_dst + s2 * STG;
    const char* sb_ = smem + stg * STG;
    bf16x8 af0[4], bf0[2], af1[4], bf1[2];
#pragma unroll
    for (int mi = 0; mi < 4; ++mi) af0[mi] = *(const bf16x8*)(sb_ + aoff0 + mi * 32 * 64);
#pragma unroll
    for (int ni = 0; ni < 2; ++ni) bf0[ni] = *(const bf16x8*)(sb_ + boff0 + ni * 32 * 64);
#pragma unroll
    for (int mi = 0; mi < 4; ++mi) af1[mi] = *(const bf16x8*)(sb_ + aoff1 + mi * 32 * 64);
#pragma unroll
    for (int ni = 0; ni < 2; ++ni) bf1[ni] = *(const bf16x8*)(sb_ + boff1 + ni * 32 * 64);
    SB_;
    acc[0][0] = MFMA32(af0[0], bf0[0], acc[0][0]); acc[0][1] = MFMA32(af0[0], bf0[1], acc[0][1]); SB_;
    DMA1(arow[0] + (size_t)kq_ * astr[0], 0); SB_;
    acc[1][0] = MFMA32(af0[1], bf0[0], acc[1][0]); acc[1][1] = MFMA32(af0[1], bf0[1], acc[1][1]); SB_;
    DMA1(arow[1] + (size_t)kq_ * astr[1], 4096); SB_;
    acc[2][0] = MFMA32(af0[2], bf0[0], acc[2][0]); acc[2][1] = MFMA32(af0[2], bf0[1], acc[2][1]); SB_;
    DMA1(arow[2] + (size_t)kq_ * astr[2], 8192); SB_;
    acc[3][0] = MFMA32(af0[3], bf0[0], acc[3][0]); acc[3][1] = MFMA32(af0[3], bf0[1], acc[3][1]); SB_;
    DMA1(arow[3] + (size_t)kq_ * astr[3], 12288); SB_;
    acc[0][0] = MFMA32(af1[0], bf1[0], acc[0][0]); acc[0][1] = MFMA32(af1[0], bf1[1], acc[0][1]); SB_;
    DMA1(brow[0] + (size_t)kq_ * bstr, ASZ); SB_;
    acc[1][0] = MFMA32(af1[1], bf1[0], acc[1][0]); acc[1][1] = MFMA32(af1[1], bf1[1], acc[1][1]); SB_;
    DMA1(brow[1] + (size_t)kq_ * bstr, ASZ + 4096); SB_;
    acc[2][0] = MFMA32(af1[2], bf1[0], acc[2][0]); acc[2][1] = MFMA32(af1[2], bf1[1], acc[2][1]);
    acc[3][0] = MFMA32(af1[3], bf1[0], acc[3][0]); acc[3][1] = MFMA32(af1[3], bf1[1], acc[3][1]);
    stg = (stg == 2) ? 0 : stg + 1;
  }
  asm volatile("s_waitcnt vmcnt(0)" ::: "memory");
  RAW_BARRIER();
  G_COMPUTE(stg);
  __syncthreads();
  if (KREP == 2) {
#pragma unroll
    for (int a = 0; a < 4; ++a)
#pragma unroll
      for (int b = 0; b < 2; ++b)
#pragma unroll
        for (int i = 0; i < 16; ++i) acc[a][b][i] *= 0.5f;
  }
  const int rbase = tmi * 256 + wm * 128;
  const int cbase = tn * 128 + wn * 64;
  char* wl = smem + w * 19456;
  if (MODE == EPI_F32) {
    float* dst = (float*)g.d0;
    float* lf = (float*)wl;
#pragma unroll
    for (int mi = 0; mi < 4; ++mi) {
#pragma unroll
      for (int ni = 0; ni < 2; ++ni)
#pragma unroll
        for (int i = 0; i < 16; ++i) lf[crow(i, h) * 68 + ni * 32 + l31] = acc[mi][ni][i];
#pragma unroll
      for (int it = 0; it < 8; ++it) {
        const int r = it * 4 + (lane >> 4), c4 = (lane & 15) * 4;
        float4 v = *(const float4*)(lf + r * 68 + c4);
        *(float4*)(dst + (size_t)(rbase + mi * 32 + r) * g.ld0 + cbase + c4) = v;
      }
    }
  } else if (MODE == EPI_SPLIT) {
    u16* dst; int ld, cc;
    if (cbase < g.split) { dst = (u16*)g.d0; ld = g.ld0; cc = cbase; } else { dst = (u16*)g.d1; ld = g.ld1; cc = cbase - g.split; }
    u16* lh = (u16*)wl;
#pragma unroll
    for (int mi = 0; mi < 4; ++mi) {
#pragma unroll
      for (int ni = 0; ni < 2; ++ni)
#pragma unroll
        for (int i = 0; i < 16; ++i) lh[crow(i, h) * 72 + ni * 32 + l31] = f2bf(acc[mi][ni][i]);
#pragma unroll
      for (int it = 0; it < 4; ++it) {
        const int r = it * 8 + (lane >> 3), c8 = (lane & 7) * 8;
        uint4 v = *(const uint4*)(lh + r * 72 + c8);
        *(uint4*)(dst + (size_t)(rbase + mi * 32 + r) * ld + cc + c8) = v;
      }
    }
  } else if (MODE == EPI_GLU) {
    u16* dst = (u16*)g.d0;
    const int col0 = (tn * 2 + wn) * 32;
    u16* lh = (u16*)wl;
#pragma unroll
    for (int mi = 0; mi < 4; ++mi) {
#pragma unroll
      for (int i = 0; i < 16; ++i) lh[crow(i, h) * 40 + l31] = f2bf(acc[mi][0][i] * sigmoid_f(acc[mi][1][i]));
#pragma unroll
      for (int it = 0; it < 2; ++it) {
        const int r = it * 16 + (lane >> 2), c8 = (lane & 3) * 8;
        uint4 v = *(const uint4*)(lh + r * 40 + c8);
        *(uint4*)(dst + tidx(col0 + c8, rbase + mi * 32 + r, MT)) = v;
      }
    }
  } else {
    u16* T = (u16*)smem;
#pragma unroll
    for (int mi = 0; mi < 4; ++mi)
#pragma unroll
      for (int ni = 0; ni < 2; ++ni)
#pragma unroll
        for (int i = 0; i < 16; ++i)
          T[(wm * 128 + mi * 32 + crow(i, h)) * 136 + wn * 64 + ni * 32 + l31] = f2bf(acc[mi][ni][i]);
    __syncthreads();
    {
      const int cg8 = (tid & 7) * 8, r0 = (tid >> 3) * 8;
      const int fa = tn * 64 + cg8, fg = DFF + fa;
      float wa[3][8], wg[3][8], ba[8], bg[8];
#pragma unroll
      for (int q = 0; q < 3; ++q)
#pragma unroll
        for (int e = 0; e < 8; e += 4) {
          float4 x = *(const float4*)(g.cw + q * 2 * DFF + fa + e); wa[q][e] = x.x; wa[q][e + 1] = x.y; wa[q][e + 2] = x.z; wa[q][e + 3] = x.w;
          float4 y = *(const float4*)(g.cw + q * 2 * DFF + fg + e); wg[q][e] = y.x; wg[q][e + 1] = y.y; wg[q][e + 2] = y.z; wg[q][e + 3] = y.w;
        }
#pragma unroll
      for (int e = 0; e < 8; e += 4) {
        float4 x = *(const float4*)(g.cb + fa + e); ba[e] = x.x; ba[e + 1] = x.y; ba[e + 2] = x.z; ba[e + 3] = x.w;
        float4 y = *(const float4*)(g.cb + fg + e); bg[e] = y.x; bg[e + 1] = y.y; bg[e + 2] = y.z; bg[e + 3] = y.w;
      }
      float ap[8], ac[8], an[8], gp[8], gc[8], gn[8];
      auto ld8 = [&](int r, int coff, float* o) {
        uint4 v = *(const uint4*)(T + r * 136 + coff);
        o[0] = bflo(v.x); o[1] = bfhi(v.x); o[2] = bflo(v.y); o[3] = bfhi(v.y); o[4] = bflo(v.z); o[5] = bfhi(v.z); o[6] = bflo(v.w); o[7] = bfhi(v.w);
      };
      const int rm1 = (r0 > 0) ? r0 - 1 : 0;
      ld8(rm1, cg8, ap); ld8(rm1, 64 + cg8, gp);
      ld8(r0, cg8, ac); ld8(r0, 64 + cg8, gc);
      u16* dst = (u16*)g.d0;
#pragma unroll
      for (int rr = 0; rr < 8; ++rr) {
        const int r = r0 + rr;
        const int rn = (r < 255) ? r + 1 : 255;
        ld8(rn, cg8, an); ld8(rn, 64 + cg8, gn);
        const int v = vrow0 + r;
        if (r >= 1 && r <= 254 && v < seq_len) {
          float o[8];
#pragma unroll
          for (int e = 0; e < 8; ++e) {
            const float av = wa[0][e] * ap[e] + wa[1][e] * ac[e] + wa[2][e] * an[e] + ba[e];
            const float gv = wg[0][e] * gp[e] + wg[1][e] * gc[e] + wg[2][e] * gn[e] + bg[e];
            o[e] = av * silu_f(gv);
          }
          uint4 ov; ov.x = pk2(o[0], o[1]); ov.y = pk2(o[2], o[3]); ov.z = pk2(o[4], o[5]); ov.w = pk2(o[6], o[7]);
          *(uint4*)(dst + tidx(fa, seq_base + v, MT)) = ov;
        }
#pragma unroll
        for (int e = 0; e < 8; ++e) { ap[e] = ac[e]; ac[e] = an[e]; gp[e] = gc[e]; gc[e] = gn[e]; }
      }
    }
  }
  __syncthreads();
}

template <int MODE>
DI void phase_gemm(const GemmDesc& g, char* smem) {
  const int ntiles = g.nM * g.nN;
  const int per = gridDim.x >> 3;
  const int slot = (blockIdx.x & 7) * per + (blockIdx.x >> 3);
  for (int q0 = slot; q0 < ntiles * REP_G; q0 += gridDim.x) {
    const int q = q0 % ntiles;
    const int gm = q / (8 * g.nN);
    const int rows = min(8, g.nM - 8 * gm);
    const int ql = q - gm * 8 * g.nN;
    const int tn = ql / rows, tm = g.tm0 + gm * 8 + ql % rows;
    gemm_tile<MODE>(g, smem, tm, tn);
  }
}

DI void rope_angles(int row, int i, float& cs, float& sn) {
  const int pos = row - CTXN;
  const int rr = pos >> 6, cc = pos & 63;
  const int fi = i & 15;
  const float inv = exp2f(-(float)fi * (13.287712379549449f / 16.f));
  const float ang = (float)((i < 16) ? rr : cc) * inv;
  sincosf(ang, &sn, &cs);
}

DI void qk_prep(const u16* __restrict__ src, int lds, int coff, int nheads, u16* __restrict__ dst, const float* gnorm  ,
                float oscale, int row0) {
  const int lane = threadIdx.x & 63, hh = lane >> 5, i = lane & 31;
  const int wid = blockIdx.x * 4 + (threadIdx.x >> 6), nw = gridDim.x * 4;
  const int npair = nheads >> 1;
  const int nitems = (MT - row0) * npair;
  for (int it = wid; it < nitems; it += nw) {
    const int row = row0 + it / npair, head = (it % npair) * 2 + hh;
    unsigned v = *(const unsigned*)(src + (size_t)row * lds + coff + head * 64 + 2 * i);
    float e = bflo(v), o = bfhi(v);
    if (gnorm) {
      float ss = hsum32(e * e + o * o);
      float rinv = rsqrtf(ss * (1.f / 64.f) + 1e-6f);
      e = e * rinv * gnorm[2 * i]; o = o * rinv * gnorm[2 * i + 1];
    }
    if (row >= CTXN) {
      float cs, sn; rope_angles(row, i, cs, sn);
      float e2 = e * cs - o * sn, o2 = e * sn + o * cs;
      e = e2; o = o2;
    }
    *(unsigned*)(dst + ((size_t)head * MT + row) * 64 + 2 * i) = pk2(e * oscale, o * oscale);
  }
}

DI void v_transpose(const u16* __restrict__ src, int lds, int coff, int ncols, u16* __restrict__ dst, char* smem) {
  u16* sm = (u16*)smem;
  const int tid = threadIdx.x;
  const int ndt = ncols >> 6;
  const int ntasks = NCHUNK * ndt;
  for (int t = blockIdx.x; t < ntasks; t += gridDim.x) {
    const int tt = t / ndt, dt = t % ndt;
    {
      const int tok = tid >> 2, part = tid & 3;
      const u16* sp = src + (size_t)(tt * 64 + tok) * lds + coff + dt * 64 + part * 16;
      uint4 a = *(const uint4*)sp, b = *(const uint4*)(sp + 8);
      unsigned* d = (unsigned*)(sm + tok * 66 + part * 16);
      d[0] = a.x; d[1] = a.y; d[2] = a.z; d[3] = a.w; d[4] = b.x; d[5] = b.y; d[6] = b.z; d[7] = b.w;
    }
    __syncthreads();
    {
      const int d = tid >> 2, part = tid & 3;
      unsigned o[8];
#pragma unroll
      for (int j = 0; j < 8; ++j) {
        unsigned lo = sm[(part * 16 + 2 * j) * 66 + d], hi = sm[(part * 16 + 2 * j + 1) * 66 + d];
        o[j] = lo | (hi << 16);
      }
      u16* dp = dst + (size_t)(dt * 64 + d) * MT + tt * 64 + part * 16;
      *(uint4*)dp = make_uint4(o[0], o[1], o[2], o[3]);
      *(uint4*)(dp + 8) = make_uint4(o[4], o[5], o[6], o[7]);
    }
    __syncthreads();
  }
}

DI void gated_conv(const Params& p, const u16* __restrict__ G, u16* __restrict__ A2) {
  const int lane = threadIdx.x & 63;
  const int wid = blockIdx.x * 4 + (threadIdx.x >> 6), nw = gridDim.x * 4;
  const int nitems = MT * 4;
  for (int it = wid; it < nitems; it += nw) {
    const int row = it >> 2, c = ((it & 3) * 64 + lane) * 2;
    const bool first = (row == 0) || (row == CTXN), last = (row == CTXN - 1) || (row == MT - 1);
    const u16* gr = G + (size_t)row * 1536;
    unsigned gb = *(const unsigned*)(gr + c);
    unsigned c1 = *(const unsigned*)(gr + 512 + c), v1 = *(const unsigned*)(gr + 1024 + c);
    float m1a = bflo(c1) * bflo(v1), m1b = bfhi(c1) * bfhi(v1);
    float m0a = 0.f, m0b = 0.f, m2a = 0.f, m2b = 0.f;
    if (!first) {
      unsigned c0 = *(const unsigned*)(gr - 1536 + 512 + c), v0 = *(const unsigned*)(gr - 1536 + 1024 + c);
      m0a = bflo(c0) * bflo(v0); m0b = bfhi(c0) * bfhi(v0);
    }
    if (!last) {
      unsigned c2 = *(const unsigned*)(gr + 1536 + 512 + c), v2 = *(const unsigned*)(gr + 1536 + 1024 + c);
      m2a = bflo(c2) * bflo(v2); m2b = bfhi(c2) * bfhi(v2);
    }
    const float* cw = p.ev_conv_w;
    float ya = bflo(gb) * (cw[c] * m0a + cw[512 + c] * m1a + cw[1024 + c] * m2a);
    float yb = bfhi(gb) * (cw[c + 1] * m0b + cw[512 + c + 1] * m1b + cw[1024 + c + 1] * m2b);
    *(unsigned*)(A2 + tidx(c, row, MT)) = pk2(ya, yb);
  }
}

DI int kperm(int r) { return (r & 0x13) | ((r & 4) << 1) | ((r & 8) >> 1); }

template <int DV, int NCOMP>
DI void attn_task(char* smem, const u16* __restrict__ Qb, const u16* __restrict__ Kb, const u16* __restrict__ Vt,
                  int qh, int kslot, int q0w, int kh0, int vhead, int nkt, u16* __restrict__ A2, int ocol,
                  float lam, float lam_init, const float* __restrict__ subln) {
  const int tid = threadIdx.x, lane = tid & 63, w = tid >> 6, h = lane >> 5, l31 = lane & 31;
  constexpr int KT = 64 * 144;
  constexpr int STG = NCOMP * KT + DV * 144;
  constexpr int NDB = DV / 32;
  bf16x8 qf[4];
  {
    const u16* qp = Qb + ((size_t)qh * MT + q0w + l31) * 64 + h * 8;
#pragma unroll
    for (int ks = 0; ks < 4; ++ks) qf[ks] = *(const bf16x8*)(qp + ks * 16);
  }
  f32x16 O[NDB];
#pragma unroll
  for (int d = 0; d < NDB; ++d)
#pragma unroll
    for (int i = 0; i < 16; ++i) O[d][i] = 0.f;
  float m = 0.f, lsum = 0.f;
  f32x16 negm, Lacc;
#pragma unroll
  for (int i = 0; i < 16; ++i) { negm[i] = 0.f; Lacc[i] = 0.f; }
  bf16x8 ones;
  {
    const short ov = (l31 == 0) ? (short)0x3F80 : (short)0;
#pragma unroll
    for (int j = 0; j < 8; ++j) ones[j] = ov;
  }
  uint4 kr0, kr1, kr2, kr3, vr0, vr1, vr2, vr3;
  kr2 = kr3 = vr2 = vr3 = make_uint4(0, 0, 0, 0);
  const int skey = (tid & 511) >> 3, spart = tid & 7;
  const u16* kg = Kb + ((size_t)kh0 * MT + skey) * 64 + spart * 8;
  const u16* vg = Vt + ((size_t)vhead * DV + (tid >> 3)) * MT + spart * 8;
  const int ksl = skey * 144 + spart * 16;
  const int vsl = NCOMP * KT + (tid >> 3) * 144 + spart * 16;
#define A_LOAD(kt) { \
    kr0 = *(const uint4*)(kg + (size_t)(kt) * 64 * 64); kr1 = *(const uint4*)(kg + (size_t)(kt) * 64 * 64 + 32 * 64); \
    if (NCOMP == 2) { kr2 = *(const uint4*)(kg + (size_t)MT * 64 + (size_t)(kt) * 64 * 64); kr3 = *(const uint4*)(kg + (size_t)MT * 64 + (size_t)(kt) * 64 * 64 + 32 * 64); } \
    vr0 = *(const uint4*)(vg + (kt) * 64); vr1 = *(const uint4*)(vg + (size_t)32 * MT + (kt) * 64); \
    if (DV == 128) { vr2 = *(const uint4*)(vg + (size_t)64 * MT + (kt) * 64); vr3 = *(const uint4*)(vg + (size_t)96 * MT + (kt) * 64); } }
#define A_WRITE(buf) { char* sb_ = smem + (buf) * STG; \
    *(uint4*)(sb_ + ksl) = kr0; *(uint4*)(sb_ + ksl + 32 * 144) = kr1; \
    if (NCOMP == 2) { *(uint4*)(sb_ + KT + ksl) = kr2; *(uint4*)(sb_ + KT + ksl + 32 * 144) = kr3; } \
    *(uint4*)(sb_ + vsl) = vr0; *(uint4*)(sb_ + vsl + 32 * 144) = vr1; \
    if (DV == 128) { *(uint4*)(sb_ + vsl + 64 * 144) = vr2; *(uint4*)(sb_ + vsl + 96 * 144) = vr3; } }
  A_LOAD(0); A_WRITE(0); __syncthreads();
  for (int kt = 0; kt < nkt; ++kt) {
    const int ktn = (kt + 1 < nkt) ? kt + 1 : kt;
    A_LOAD(ktn);
    __builtin_amdgcn_sched_barrier(0);
    const char* sb = smem + (kt & 1) * STG;
    const char* kp = sb + kslot * KT + kperm(l31) * 144 + h * 16;
    f32x16 S0, S1;
    {
      bf16x8 a0 = *(const bf16x8*)(kp);
      bf16x8 a1 = *(const bf16x8*)(kp + 32 * 144);
      if (NCOMP == 1) { S0 = MFMA32(a0, qf[0], negm); S1 = MFMA32(a1, qf[0], negm); }
      else {
        f32x16 z;
#pragma unroll
        for (int i = 0; i < 16; ++i) z[i] = 0.f;
        S0 = MFMA32(a0, qf[0], z); S1 = MFMA32(a1, qf[0], z);
      }
    }
#pragma unroll
    for (int ks = 1; ks < 4; ++ks) {
      bf16x8 a0 = *(const bf16x8*)(kp + ks * 32);
      bf16x8 a1 = *(const bf16x8*)(kp + 32 * 144 + ks * 32);
      S0 = MFMA32(a0, qf[ks], S0);
      S1 = MFMA32(a1, qf[ks], S1);
    }
    float mx = fmaxf(S0[0], S1[0]);
#pragma unroll
    for (int i = 1; i < 16; ++i) mx = fmaxf(mx, fmaxf(S0[i], S1[i]));
    mx = fmaxf(mx, __shfl_xor(mx, 32));
    if (NCOMP == 2) mx -= m;
    const bool recentre = (kt == 0) || (mx > 8.f);
    if (__any(recentre)) {
      const float delta = recentre ? mx : 0.f;
      const float alpha = __builtin_amdgcn_exp2f(-delta);
      m += delta;
      lsum *= alpha;
      if (NCOMP == 1) {
#pragma unroll
        for (int i = 0; i < 16; ++i) { negm[i] = -m; S0[i] -= delta; S1[i] -= delta; }
        Lacc[0] *= alpha;
      }
#pragma unroll
      for (int d = 0; d < NDB; ++d)
#pragma unroll
        for (int i = 0; i < 16; ++i) O[d][i] *= alpha;
    }
    if (NCOMP == 1) {
#pragma unroll
      for (int i = 0; i < 16; ++i) { S0[i] = __builtin_amdgcn_exp2f(S0[i]); S1[i] = __builtin_amdgcn_exp2f(S1[i]); }
    } else {
      float ps = 0.f;
#pragma unroll
      for (int i = 0; i < 16; ++i) { S0[i] = __builtin_amdgcn_exp2f(S0[i] - m); ps += S0[i]; }
#pragma unroll
      for (int i = 0; i < 16; ++i) { S1[i] = __builtin_amdgcn_exp2f(S1[i] - m); ps += S1[i]; }
      lsum += ps;
    }
    bf16x8 pf[4];
#pragma unroll
    for (int s2 = 0; s2 < 2; ++s2) {
      uint4 a, b;
      a.x = pk2(S0[8 * s2], S0[8 * s2 + 1]); a.y = pk2(S0[8 * s2 + 2], S0[8 * s2 + 3]);
      a.z = pk2(S0[8 * s2 + 4], S0[8 * s2 + 5]); a.w = pk2(S0[8 * s2 + 6], S0[8 * s2 + 7]);
      b.x = pk2(S1[8 * s2], S1[8 * s2 + 1]); b.y = pk2(S1[8 * s2 + 2], S1[8 * s2 + 3]);
      b.z = pk2(S1[8 * s2 + 4], S1[8 * s2 + 5]); b.w = pk2(S1[8 * s2 + 6], S1[8 * s2 + 7]);
      pf[s2] = __builtin_bit_cast(bf16x8, a);
      pf[2 + s2] = __builtin_bit_cast(bf16x8, b);
    }
    const char* vp = sb + NCOMP * KT + l31 * 144 + h * 16;
#pragma unroll
    for (int kk = 0; kk < 4; ++kk)
#pragma unroll
      for (int d = 0; d < NDB; ++d) {
        bf16x8 vf = *(const bf16x8*)(vp + d * 32 * 144 + kk * 32);
        O[d] = MFMA32(vf, pf[kk], O[d]);
      }
    if (NCOMP == 1) {
#pragma unroll
      for (int kk = 0; kk < 4; ++kk) Lacc = MFMA32(ones, pf[kk], Lacc);
    }
    A_WRITE((kt + 1) & 1);
    __syncthreads();
  }
  const float ltot = (NCOMP == 1) ? __shfl(Lacc[0], l31) : lsum + __shfl_xor(lsum, 32);
  const float inv = 1.f / ltot;
  const int row = q0w + l31;
  if (NCOMP == 1) {
#pragma unroll
    for (int d = 0; d < NDB; ++d)
#pragma unroll
      for (int q = 0; q < 4; ++q) {
        const int dd = d * 32 + 8 * q + 4 * h;
        uint2 v; v.x = pk2(O[d][4 * q] * inv, O[d][4 * q + 1] * inv); v.y = pk2(O[d][4 * q + 2] * inv, O[d][4 * q + 3] * inv);
        *(uint2*)(A2 + tidx(ocol + dd, row, MT)) = v;
      }
  } else {
    float* ox = (float*)smem;
    const int ql = (w >> 1) * 32 + l31;
    if (w & 1) {
#pragma unroll
      for (int d = 0; d < NDB; ++d)
#pragma unroll
        for (int q = 0; q < 4; ++q) {
          const int dd = d * 32 + 8 * q + 4 * h;
          float4 v = make_float4(O[d][4 * q] * inv, O[d][4 * q + 1] * inv, O[d][4 * q + 2] * inv, O[d][4 * q + 3] * inv);
          *(float4*)(ox + ql * 132 + dd) = v;
        }
    }
    __syncthreads();
    if (!(w & 1)) {
      float ss = 0.f;
#pragma unroll
      for (int d = 0; d < NDB; ++d)
#pragma unroll
        for (int q = 0; q < 4; ++q) {
          const int dd = d * 32 + 8 * q + 4 * h;
          float4 o2 = *(const float4*)(ox + ql * 132 + dd);
          O[d][4 * q] = O[d][4 * q] * inv - lam * o2.x;
          O[d][4 * q + 1] = O[d][4 * q + 1] * inv - lam * o2.y;
          O[d][4 * q + 2] = O[d][4 * q + 2] * inv - lam * o2.z;
          O[d][4 * q + 3] = O[d][4 * q + 3] * inv - lam * o2.w;
          ss += O[d][4 * q] * O[d][4 * q] + O[d][4 * q + 1] * O[d][4 * q + 1] + O[d][4 * q + 2] * O[d][4 * q + 2] + O[d][4 * q + 3] * O[d][4 * q + 3];
        }
      ss += __shfl_xor(ss, 32);
      const float r = rsqrtf(ss * (1.f / 128.f) + 1e-6f) * (1.f - lam_init);
#pragma unroll
      for (int d = 0; d < NDB; ++d)
#pragma unroll
        for (int q = 0; q < 4; ++q) {
          const int dd = d * 32 + 8 * q + 4 * h;
          float4 gs = *(const float4*)(subln + dd);
          uint2 v; v.x = pk2(O[d][4 * q] * r * gs.x, O[d][4 * q + 1] * r * gs.y); v.y = pk2(O[d][4 * q + 2] * r * gs.z, O[d][4 * q + 3] * r * gs.w);
          *(uint2*)(A2 + tidx(ocol + dd, row, MT)) = v;
        }
    }
    __syncthreads();
  }
}

DI void s5_coeffs(const Params& p, int dir, int g, int pp, float& abr, float& abi, float& cr, float& ci) {
  const int idx = (dir * 32 + g) * 64 + pp;
  const float dt = expf(p.log_dt[dir * 32 + g]);
  const float are = p.a_re[idx], aim = p.a_im[idx];
  const float mag = expf(are * dt);
  float sn, cs; sincosf(aim * dt, &sn, &cs);
  abr = mag * cs; abi = mag * sn;
  const float nr = abr - 1.f, ni = abi;
  const float den = are * are + aim * aim;
  cr = (nr * are + ni * aim) / den;
  ci = (ni * are - nr * aim) / den;
}

template <bool OUT>
DI void s5_task(const Params& p, char* smem, int gp, int c, const u16* __restrict__ U1, u16* __restrict__ Z) {
  float* su = (float*)smem;
  u16* hm = (u16*)(smem + 8192);
  const int tid = threadIdx.x, lane = tid & 63, w = tid >> 6;
  const int gl = w >> 1, dir = w & 1, g = 2 * gp + gl;
  {
    const int t = tid >> 2, part = tid & 3;
    uint4 v = *(const uint4*)(U1 + (size_t)(c * 64 + t) * 512 + gp * 32 + part * 8);
    float* d = su + t * 32 + part * 8;
    d[0] = bflo(v.x); d[1] = bfhi(v.x); d[2] = bflo(v.y); d[3] = bfhi(v.y);
    d[4] = bflo(v.z); d[5] = bfhi(v.z); d[6] = bflo(v.w); d[7] = bfhi(v.w);
  }
  float abr, abi, cr, ci;
  s5_coeffs(p, dir, g, lane, abr, abi, cr, ci);
  float bbr[16], bbi[16];
  {
    const size_t bidx = ((size_t)(dir * 32 + g) * 64 + lane) * 16;
#pragma unroll
    for (int q = 0; q < 4; ++q) {
      float4 br = *(const float4*)(p.b_re + bidx + q * 4), bi = *(const float4*)(p.b_im + bidx + q * 4);
      bbr[4 * q] = cr * br.x - ci * bi.x; bbi[4 * q] = cr * bi.x + ci * br.x;
      bbr[4 * q + 1] = cr * br.y - ci * bi.y; bbi[4 * q + 1] = cr * bi.y + ci * br.y;
      bbr[4 * q + 2] = cr * br.z - ci * bi.z; bbi[4 * q + 2] = cr * bi.z + ci * br.z;
      bbr[4 * q + 3] = cr * br.w - ci * bi.w; bbi[4 * q + 3] = cr * bi.w + ci * br.w;
    }
  }
  float2* sp = (float2*)p.s5s + ((size_t)(dir * 32 + g) * NCHUNK + c) * 64 + lane;
  float hr = 0.f, hi = 0.f;
  if (OUT) { float2 h0 = *sp; hr = h0.x; hi = h0.y; }
  __syncthreads();
  for (int step = 0; step < 64; ++step) {
    const int t = dir ? 63 - step : step;
    const float* ur = su + t * 32 + gl * 16;
    float bur = 0.f, bui = 0.f;
#pragma unroll
    for (int q = 0; q < 4; ++q) {
      float4 u = *(const float4*)(ur + 4 * q);
      bur += bbr[4 * q] * u.x + bbr[4 * q + 1] * u.y + bbr[4 * q + 2] * u.z + bbr[4 * q + 3] * u.w;
      bui += bbi[4 * q] * u.x + bbi[4 * q + 1] * u.y + bbi[4 * q + 2] * u.z + bbi[4 * q + 3] * u.w;
    }
    const float nhr = abr * hr - abi * hi + bur;
    const float nhi = abr * hi + abi * hr + bui;
    hr = nhr; hi = nhi;
    if (OUT) {
      u16* hrow = hm + (gl * 64 + t) * 264 + dir * 128 + lane;
      hrow[0] = f2bf(hr); hrow[64] = f2bf(hi);
    }
  }
  if (!OUT) {
    *sp = make_float2(hr, hi);
    __syncthreads();
  } else {
    __syncthreads();
    const int l15 = lane & 15, lq = lane >> 4;
    f32x4 acc0 = {0.f, 0.f, 0.f, 0.f}, acc1 = {0.f, 0.f, 0.f, 0.f};
    const int tb0 = 2 * (w & 1);
#pragma unroll
    for (int kb = 0; kb < 8; ++kb) {
      const int k0 = kb * 32 + lq * 8;
      const int dk = k0 >> 7, rem = k0 & 127, isim = rem >> 6, pp = rem & 63;
      const float* cs = (isim ? p.c_im : p.c_re) + ((size_t)((dk * 32 + g) * 16 + l15)) * 64 + pp;
      const float sg = isim ? -1.f : 1.f;
      float4 c0 = *(const float4*)cs, c1 = *(const float4*)(cs + 4);
      uint4 bb; bb.x = pk2(sg * c0.x, sg * c0.y); bb.y = pk2(sg * c0.z, sg * c0.w); bb.z = pk2(sg * c1.x, sg * c1.y); bb.w = pk2(sg * c1.z, sg * c1.w);
      bf16x8 bfr = __builtin_bit_cast(bf16x8, bb);
      bf16x8 a0 = *(const bf16x8*)(hm + (gl * 64 + tb0 * 16 + l15) * 264 + k0);
      bf16x8 a1 = *(const bf16x8*)(hm + (gl * 64 + (tb0 + 1) * 16 + l15) * 264 + k0);
      acc0 = MFMA16(a0, bfr, acc0);
      acc1 = MFMA16(a1, bfr, acc1);
    }
    const float dsk = p.d_skip[g * 16 + l15];
#pragma unroll
    for (int j = 0; j < 4; ++j) {
      int t = tb0 * 16 + lq * 4 + j;
      float y = acc0[j] + dsk * su[t * 32 + gl * 16 + l15];
      Z[tidx(g * 16 + l15, c * 64 + t, MT)] = f2bf(gelu_tanh(y));
      t += 16;
      y = acc1[j] + dsk * su[t * 32 + gl * 16 + l15];
      Z[tidx(g * 16 + l15, c * 64 + t, MT)] = f2bf(gelu_tanh(y));
    }
    __syncthreads();
  }
}

DI void s5_carry(const Params& p) {
  if (blockIdx.x >= 16) return;
  const int s = blockIdx.x * 256 + threadIdx.x;
  const int dir = s >> 11, g = (s >> 6) & 31, pp = s & 63;
  float abr, abi, cr, ci;
  s5_coeffs(p, dir, g, pp, abr, abi, cr, ci);
#pragma unroll
  for (int q = 0; q < 6; ++q) { float nr = abr * abr - abi * abi, ni = 2.f * abr * abi; abr = nr; abi = ni; }
  float2* base = (float2*)p.s5s + ((size_t)(dir * 32 + g) * NCHUNK) * 64 + pp;
  float hr = 0.f, hi = 0.f;
  for (int b = 0; b < 10; ++b) {
    float2 tmp[26];
#pragma unroll
    for (int j = 0; j < 26; ++j) {
      const int step = b * 26 + j;
      const int c = dir == 0 ? step : (step < 4 ? 3 - step : 263 - step);
      tmp[j] = base[(size_t)c * 64];
    }
#pragma unroll
    for (int j = 0; j < 26; ++j) {
      const int step = b * 26 + j;
      const int c = dir == 0 ? step : (step < 4 ? 3 - step : 263 - step);
      base[(size_t)c * 64] = make_float2(hr, hi);
      const float nr = abr * hr - abi * hi + tmp[j].x;
      const float ni = abr * hi + abi * hr + tmp[j].y;
      hr = nr; hi = ni;
    }
  }
}

DI unsigned gb_ld(unsigned* p) { return __hip_atomic_load(p, __ATOMIC_RELAXED, __HIP_MEMORY_SCOPE_AGENT); }
DI unsigned gb_add(unsigned* p, unsigned v) { return __hip_atomic_fetch_add(p, v, __ATOMIC_RELAXED, __HIP_MEMORY_SCOPE_AGENT); }
DI void grid_barrier(unsigned* bar, unsigned& epoch) {
  asm volatile("s_waitcnt vmcnt(0)" ::: "memory");
  __syncthreads();
  if (threadIdx.x == 0) {
    __builtin_amdgcn_fence(__ATOMIC_RELEASE, "agent");
    asm volatile("s_waitcnt vmcnt(0)" ::: "memory");
    const unsigned grp = blockIdx.x & 15u;
    const unsigned ngb = (gridDim.x + 15u - grp) >> 4;
    const unsigned old = gb_add(&bar[64 * (1 + grp)], 1u);
    if (old + 1u == (epoch + 1u) * ngb) {
      const unsigned ot = gb_add(&bar[64 * 17], 1u);
      if (ot + 1u == (epoch + 1u) * 16u) __hip_atomic_store(&bar[0], epoch + 1u, __ATOMIC_RELAXED, __HIP_MEMORY_SCOPE_AGENT);
    }
    while (gb_ld(&bar[0]) < epoch + 1u) __builtin_amdgcn_s_sleep(1);
    __builtin_amdgcn_fence(__ATOMIC_ACQUIRE, "agent");
    asm volatile("s_waitcnt vmcnt(0)" ::: "memory");
  }
  epoch++;
  __syncthreads();
}

__global__ void __launch_bounds__(256, 2) fwd_megakernel(Params p) {
  extern __shared__ __attribute__((aligned(16))) char smem[];
  cg::grid_group grid = cg::this_grid();
  const size_t RW = (size_t)MT * DM;
  u16* A2 = p.H;
  u16* Qb = (u16*)p.Y;
  u16* Kb = Qb + RW / 2;
  u16* Vt = Kb + RW / 2;
  const float* mod0 = p.mod;
  const float* mod1 = p.mod + 2 * 6 * DM;

  unsigned epoch = 0;
  if (p.ph_lo < 0) grid.sync();
#define PHASE_BEGIN(k) if ((k) >= p.ph_lo && (k) < p.ph_hi) { if ((k) > p.ph_lo) grid_barrier(p.bar, epoch);
#define PHASE_END }

  PHASE_BEGIN(0) for (int rep = 0; rep < REP_P; ++rep) phase_prep_weights(p, smem); PHASE_END

  PHASE_BEGIN(1)
    for (int rep = 0; rep < REP_O; ++rep) phase_rows<false, true>(p, 0, MT, p.ctx, p.x, nullptr, nullptr, nullptr, nullptr, 0, nullptr, mod0, 0, p.norm_pre, p.H);
  PHASE_END

  PHASE_BEGIN(2) {
    GemmDesc g{}; g.A = p.H; g.Bt = p.wt_in0; g.lda = DM; g.K = DM; g.nN = 18; g.tm0 = 0; g.nM = 65;
    g.d0 = p.big; g.ld0 = 1536; g.d1 = p.big + (size_t)MT * 1536; g.ld1 = 768; g.split = 1536;
    phase_gemm<EPI_SPLIT>(g, smem);
  } PHASE_END

  PHASE_BEGIN(3) {
    const u16* G = p.big; const u16* QKV = p.big + (size_t)MT * 1536;
    for (int rep = 0; rep < REP_O; ++rep) {
    qk_prep(QKV, 768, 0, 8, Qb, p.ev_q_norm, 0.125f * LOG2E, 0);
    qk_prep(QKV, 768, 512, 2, Kb, p.ev_k_norm, 1.f, 0);
    v_transpose(QKV, 768, 640, 128, Vt, smem);
    gated_conv(p, G, A2);
    }
  } PHASE_END

  PHASE_BEGIN(4) {
    const int w = threadIdx.x >> 6;
    const int nlat = 8 * 128, nctx = 8 * 2;
    for (int t0 = blockIdx.x; t0 < (nlat + nctx) * REP_A; t0 += gridDim.x) {
      const int t = t0 % (nlat + nctx);
      int head, q0, nkt;
      if (t < nlat) { head = t & 7; q0 = CTXN + (t >> 3) * 128; nkt = NCHUNK; }
      else { int tt = t - nlat; head = tt & 7; q0 = (tt >> 3) * 128; nkt = CTXN / 64; }
      attn_task<64, 1>(smem, Qb, Kb, Vt, head, 0, q0 + 32 * w, head >> 2, head >> 2, nkt, A2, 512 + head * 64, 0.f, 0.f, nullptr);
    }
  } PHASE_END

  PHASE_BEGIN(5) {
    GemmDesc g{}; g.A = A2; g.Bt = p.wt_out0; g.lda = DM; g.K = DM; g.nN = 8; g.tm0 = 0; g.nM = 65;
    g.d0 = p.Y; g.ld0 = DM;
    phase_gemm<EPI_F32>(g, smem);
  } PHASE_END

  PHASE_BEGIN(6)
    for (int rep = 0; rep < REP_O; ++rep) phase_rows<true, true>(p, 0, MT, p.ctx, p.x, p.xctx, p.out, p.Y, mod0, 2, p.norm_post, mod0, 3, p.norm_pre + DM, p.H);
  PHASE_END

  PHASE_BEGIN(7) {
    GemmDesc g{}; g.A = p.H; g.Bt = p.wt_up0; g.lda = DM; g.K = DM; g.nN = 44; g.tm0 = 0; g.nM = 67;
    g.d0 = p.big; g.cw = p.ffn_conv_w; g.cb = p.ffn_conv_b; g.zrow = (const u16*)(p.bar + 1536);
    phase_gemm<EPI_FFNUP>(g, smem);
  } PHASE_END

  PHASE_BEGIN(8) {
    GemmDesc g{}; g.A = p.big; g.Bt = p.wt_dn0; g.lda = DFF; g.K = DFF; g.nN = 8; g.tm0 = 0; g.nM = 65;
    g.d0 = p.Y; g.ld0 = DM;
    phase_gemm<EPI_F32>(g, smem);
  } PHASE_END

  PHASE_BEGIN(9)
    phase_rows<true, true>(p, 0, MT, p.xctx, p.out, p.xctx, p.out, p.Y, mod0, 5, p.norm_post + DM, mod1, 0, p.norm_pre + 2 * DM, p.H);
  PHASE_END

  u16* U1 = p.big;
  u16* QKV1 = p.big + (size_t)MT * 512;
  u16* Z = p.big + (size_t)MT * 2048;

  PHASE_BEGIN(10) {
    GemmDesc g{}; g.A = p.H; g.Bt = p.wt_in1; g.lda = DM; g.K = DM; g.nN = 16; g.tm0 = 0; g.nM = 65;
    g.d0 = U1; g.ld0 = 512; g.d1 = QKV1; g.ld1 = 1536; g.split = 512;
    phase_gemm<EPI_SPLIT>(g, smem);
  } PHASE_END

  PHASE_BEGIN(11) {
    for (int rep = 0; rep < REP_O; ++rep) {
    qk_prep(QKV1, 1536, 0, 8, Qb, nullptr, 0.125f * LOG2E, CTXN);
    qk_prep(QKV1, 1536, 512, 8, Kb, nullptr, 1.f, 0);
    v_transpose(QKV1, 1536, 1024, 512, Vt, smem);
    }
    for (int t0 = blockIdx.x; t0 < 16 * NCHUNK * REP_S; t0 += gridDim.x) { const int t = t0 % (16 * NCHUNK); s5_task<false>(p, smem, t & 15, t >> 4, U1, Z); }
  } PHASE_END

  PHASE_BEGIN(12) {
    s5_carry(p);
    float lam;
    {
      const int lane = threadIdx.x & 63;
      float s1 = wsum(p.lam_q1[lane] * p.lam_k1[lane]);
      float s2 = wsum(p.lam_q2[lane] * p.lam_k2[lane]);
      lam = expf(s1) - expf(s2) + 0.35550906759f;
    }
    const int w = threadIdx.x >> 6;
    for (int t0 = blockIdx.x; t0 < 4 * 256 * REP_A; t0 += gridDim.x) {
      const int t = t0 & 1023;
      const int head = t & 3, q0 = CTXN + (t >> 2) * 64;
      attn_task<128, 2>(smem, Qb, Kb, Vt, head * 2 + (w & 1), w & 1, q0 + 32 * (w >> 1), head * 2, head, NCHUNK, A2, 512 + head * 128,
                        lam, 0.35550906759f, p.subln);
    }
  } PHASE_END

  PHASE_BEGIN(13) {
    for (int t0 = blockIdx.x; t0 < 16 * (NCHUNK - 4) * REP_S; t0 += gridDim.x) { const int t = t0 % (16 * (NCHUNK - 4)); s5_task<true>(p, smem, t & 15, 4 + (t >> 4), U1, Z); }
  } PHASE_END

  PHASE_BEGIN(14) {
    GemmDesc g{}; g.A = Z; g.Bt = p.wt_glu; g.lda = 512; g.K = 512; g.nN = 8; g.tm0 = 1; g.nM = 64;
    g.d0 = A2; g.ld0 = DM;
    phase_gemm<EPI_GLU>(g, smem);
  } PHASE_END

  PHASE_BEGIN(15) {
    GemmDesc g{}; g.A = A2; g.Bt = p.wt_out1; g.lda = DM; g.K = DM; g.nN = 8; g.tm0 = 1; g.nM = 64;
    g.d0 = p.Y; g.ld0 = DM;
    phase_gemm<EPI_F32>(g, smem);
  } PHASE_END

  PHASE_BEGIN(16)
    phase_rows<true, true>(p, CTXN, MT, p.xctx, p.out, p.xctx, p.out, p.Y, mod1, 2, p.norm_post + 2 * DM, mod1, 3, p.norm_pre + 3 * DM, p.H);
  PHASE_END

  PHASE_BEGIN(17) {
    GemmDesc g{}; g.A = p.H; g.Bt = p.wt_up1; g.lda = DM; g.K = DM; g.nN = 44; g.tm0 = 2; g.nM = 65;
    g.d0 = p.big; g.cw = p.ffn_conv_w + 3 * 2 * DFF; g.cb = p.ffn_conv_b + 2 * DFF; g.zrow = (const u16*)(p.bar + 1536);
    phase_gemm<EPI_FFNUP>(g, smem);
  } PHASE_END

  PHASE_BEGIN(18) {
    GemmDesc g{}; g.A = p.big; g.Bt = p.wt_dn1; g.lda = DFF; g.K = DFF; g.nN = 8; g.tm0 = 1; g.nM = 64;
    g.d0 = p.Y; g.ld0 = DM;
    phase_gemm<EPI_F32>(g, smem);
  } PHASE_END

  PHASE_BEGIN(19)
    phase_rows<true, false>(p, CTXN, MT, p.xctx, p.out, p.xctx, p.out, p.Y, mod1, 5, p.norm_post + 3 * DM, nullptr, 0, nullptr, nullptr);
  PHASE_END
}

extern "C" void kernel_launch(void* const* d_in, const int* in_sizes, int n_in, void* d_out, int out_size, void* d_ws,
                              size_t ws_size, hipStream_t stream) {
  static int grid_blocks = 0;
  if (!grid_blocks) {
    hipFuncSetAttribute((const void*)fwd_megakernel, hipFuncAttributeMaxDynamicSharedMemorySize, LDS_BYTES);
    int dev = 0, cus = 0, per_cu = 0;
    hipGetDevice(&dev);
    hipDeviceGetAttribute(&cus, hipDeviceAttributeMultiprocessorCount, dev);
    hipOccupancyMaxActiveBlocksPerMultiprocessor(&per_cu, fwd_megakernel, 256, LDS_BYTES);
    if (per_cu > 2) per_cu = 2;
    grid_blocks = cus * per_cu;
  }
  Params p{};
  const float* const* in = (const float* const*)d_in;
  p.x = in[0]; p.c = in[1]; p.ctx = in[2]; p.c_ctx = in[3]; p.mod_w = in[4]; p.mod_b = in[5]; p.norm_pre = in[6]; p.norm_post = in[7];
  p.ffn_w_up = in[8]; p.ffn_conv_w = in[9]; p.ffn_conv_b = in[10]; p.ffn_w_down = in[11];
  p.ev_w_in = in[12]; p.ev_conv_w = in[13]; p.ev_q_norm = in[14]; p.ev_k_norm = in[15]; p.ev_w_out = in[16];
  p.od_w_in = in[17]; p.a_re = in[18]; p.a_im = in[19]; p.log_dt = in[20]; p.b_re = in[21]; p.b_im = in[22]; p.c_re = in[23]; p.c_im = in[24];
  p.d_skip = in[25]; p.glu_w = in[26]; p.lam_q1 = in[27]; p.lam_k1 = in[28]; p.lam_q2 = in[29]; p.lam_k2 = in[30]; p.subln = in[31]; p.od_w_out = in[32];
  p.out = (float*)d_out;
  char* ws = (char*)d_ws;
  size_t off = 0;
  auto take = [&](size_t bytes) { char* r = ws + off; off += (bytes + 255) & ~(size_t)255; return r; };
  p.wt_in0 = (u16*)take((size_t)2304 * 1024 * 2);
  p.wt_out0 = (u16*)take((size_t)1024 * 1024 * 2);
  p.wt_up0 = (u16*)take((size_t)2 * DFF * 1024 * 2);
  p.wt_dn0 = (u16*)take((size_t)1024 * DFF * 2);
  p.wt_in1 = (u16*)take((size_t)2048 * 1024 * 2);
  p.wt_glu = (u16*)take((size_t)1024 * 512 * 2);
  p.wt_out1 = (u16*)take((size_t)1024 * 1024 * 2);
  p.wt_up1 = (u16*)take((size_t)2 * DFF * 1024 * 2);
  p.wt_dn1 = (u16*)take((size_t)1024 * DFF * 2);
  p.mod = (float*)take((size_t)2 * 2 * 6 * DM * 4);
  p.xctx = (float*)take((size_t)CTXN * DM * 4);
  p.s5s = (float*)take((size_t)2 * 32 * NCHUNK * 64 * 8);
  p.H = (u16*)take((size_t)MT * DM * 2);
  p.Y = (float*)take((size_t)MT * DM * 4);
  p.big = (u16*)take((size_t)MT * DFF * 2);
  p.bar = (unsigned*)take(8192);
  p.ph_lo = 0; p.ph_hi = 20;
  if (off > ws_size) { fprintf(stderr, "workspace too small: need %zu have %zu\n", off, ws_size); }
  (void)hipMemsetAsync(p.bar, 0, 8192, stream);
  void* args[] = {&p};
  hipError_t e = hipLaunchCooperativeKernel((const void*)fwd_megakernel, dim3(grid_blocks), dim3(256), args, LDS_BYTES, stream);
  if (e != hipSuccess) fprintf(stderr, "cooperative launch failed: %s (grid %d)\n", hipGetErrorString(e), grid_blocks);
}
```

```cpp
#include <hip/hip_runtime.h>
#include <hip/hip_cooperative_groups.h>
#include <stdint.h>
#include <stdio.h>
namespace cg = cooperative_groups;

#define DI __device__ __forceinline__
typedef unsigned short u16;
typedef short bf16x8 __attribute__((ext_vector_type(8)));
typedef float f32x16 __attribute__((ext_vector_type(16)));
typedef float f32x4 __attribute__((ext_vector_type(4)));
typedef __bf16 bf2_t __attribute__((ext_vector_type(2)));
typedef float f2_t __attribute__((ext_vector_type(2)));

constexpr int DM = 1024;
constexpr int LSEQ = 16384;
constexpr int CTXN = 256;
constexpr int MT = LSEQ + CTXN;
constexpr int DFF = 2816;
constexpr int NCHUNK = MT / 64;
constexpr int LDS_BYTES = 77824;
#ifndef REP_A
#define REP_A 1
#endif
#ifndef REP_G
#define REP_G 1
#endif
#ifndef REP_O
#define REP_O 1
#endif
#ifndef REP_P
#define REP_P 1
#endif
#ifndef KREP
#define KREP 1
#endif
#ifndef REP_S
#define REP_S 1
#endif
constexpr float LOG2E = 1.4426950408889634f;

DI unsigned pk2(float a, float b) { f2_t v = {a, b}; bf2_t r = __builtin_convertvector(v, bf2_t); return __builtin_bit_cast(unsigned, r); }
DI u16 f2bf(float a) { return (u16)(pk2(a, 0.f) & 0xffffu); }
DI float bflo(unsigned v) { return __uint_as_float(v << 16); }
DI float bfhi(unsigned v) { return __uint_as_float(v & 0xffff0000u); }
DI float bf2f(u16 v) { return __uint_as_float(((unsigned)v) << 16); }
DI size_t tidx(int col, int row, int nrows) { return ((size_t)(col >> 5) * nrows + row) * 32 + (col & 31); }
DI int crow(int i, int h) { return (i & 3) + 8 * (i >> 2) + 4 * h; }
DI float wsum(float v) {
  v += __shfl_xor(v, 32); v += __shfl_xor(v, 16); v += __shfl_xor(v, 8);
  v += __shfl_xor(v, 4); v += __shfl_xor(v, 2); v += __shfl_xor(v, 1); return v;
}
DI float hsum32(float v) {
  v += __shfl_xor(v, 16); v += __shfl_xor(v, 8); v += __shfl_xor(v, 4); v += __shfl_xor(v, 2); v += __shfl_xor(v, 1); return v;
}
DI float silu_f(float x) { return x / (1.f + __expf(-x)); }
DI float sigmoid_f(float x) { return 1.f / (1.f + __expf(-x)); }
DI float gelu_tanh(float x) {
  float a = 0.7978845608028654f * (x + 0.044715f * x * x * x);
  float t = 1.f - 2.f / (__expf(2.f * a) + 1.f);
  return 0.5f * x * (1.f + t);
}
#define MFMA32(a, b, c) __builtin_amdgcn_mfma_f32_32x32x16_bf16((a), (b), (c), 0, 0, 0)
#define MFMA16(a, b, c) __builtin_amdgcn_mfma_f32_16x16x32_bf16((a), (b), (c), 0, 0, 0)

struct Params {
  const float *x, *c, *ctx, *c_ctx, *mod_w, *mod_b, *norm_pre, *norm_post, *ffn_w_up, *ffn_conv_w, *ffn_conv_b, *ffn_w_down;
  const float *ev_w_in, *ev_conv_w, *ev_q_norm, *ev_k_norm, *ev_w_out;
  const float *od_w_in, *a_re, *a_im, *log_dt, *b_re, *b_im, *c_re, *c_im, *d_skip, *glu_w;
  const float *lam_q1, *lam_k1, *lam_q2, *lam_k2, *subln, *od_w_out;
  float* out;
  u16 *wt_in0, *wt_out0, *wt_up0, *wt_dn0, *wt_in1, *wt_glu, *wt_out1, *wt_up1, *wt_dn1;
  float* mod;
  float* xctx;
  float* s5s;
  u16* H;
  float* Y;
  u16* big;
  unsigned* bar;
  int ph_lo, ph_hi;
};

DI int perm_row(int kind, int n) {
  if (kind == 1) {
    if (n < DFF) return (n >> 6) * 128 + (n & 63);
    int m = n - DFF; return (m >> 6) * 128 + 64 + (m & 63);
  } else if (kind == 2) {
    if (n < 512) return (n >> 5) * 64 + (n & 31);
    int m = n - 512; return (m >> 5) * 64 + 32 + (m & 31);
  }
  return n;
}

DI void transpose_tile(const float* __restrict__ W, int K, int N, u16* __restrict__ Wt, int kind, int tile, float* sm) {
  const int nN = N >> 6;
  const int k0 = (tile / nN) * 64, n0 = (tile % nN) * 64;
  const int tid = threadIdx.x;
  for (int r = tid >> 6; r < 64; r += 4) sm[r * 65 + (tid & 63)] = W[(size_t)(k0 + r) * N + n0 + (tid & 63)];
  __syncthreads();
  const int kk = (tid & 31) * 2;
  for (int n = tid >> 5; n < 64; n += 8) {
    unsigned v = pk2(sm[kk * 65 + n], sm[(kk + 1) * 65 + n]);
    *(unsigned*)(Wt + tidx(k0 + kk, perm_row(kind, n0 + n), N)) = v;
  }
  __syncthreads();
}

DI void phase_prep_weights(const Params& p, char* smem) {
  float* sm = (float*)smem;
  const float* srcs[9] = {p.ev_w_in, p.ev_w_out, p.ffn_w_up, p.ffn_w_down, p.od_w_in, p.glu_w, p.od_w_out,
                          p.ffn_w_up + (size_t)DM * 2 * DFF, p.ffn_w_down + (size_t)DFF * DM};
  u16* dsts[9] = {p.wt_in0, p.wt_out0, p.wt_up0, p.wt_dn0, p.wt_in1, p.wt_glu, p.wt_out1, p.wt_up1, p.wt_dn1};
  const int Ks[9] = {1024, 1024, 1024, DFF, 1024, 512, 1024, 1024, DFF};
  const int Ns[9] = {2304, 1024, 2 * DFF, 1024, 2048, 1024, 1024, 2 * DFF, 1024};
  const int kinds[9] = {0, 0, 1, 0, 0, 2, 0, 1, 0};
  int total = 0;
#pragma unroll
  for (int i = 0; i < 9; ++i) total += (Ks[i] >> 6) * (Ns[i] >> 6);
  const int NMOD = 192;
  for (int t = blockIdx.x; t < NMOD + total; t += gridDim.x) {
    if (t < NMOD) {
      const int layer = t / 96, cgp = t % 96;
      const int tid = threadIdx.x, col = cgp * 64 + (tid & 63), kq = tid >> 6;
      const float* W = p.mod_w + (size_t)layer * DM * 6 * DM;
      float* ssc = sm + 1024;
      for (int k = tid; k < DM; k += 256) { ssc[k] = silu_f(p.c[k]); ssc[DM + k] = silu_f(p.c_ctx[k]); }
      __syncthreads();
      float a0 = 0.f, a1 = 0.f;
      const float* wp = W + (size_t)(kq * 256) * (6 * DM) + col;
#pragma unroll 8
      for (int k = 0; k < 256; ++k) {
        const float w = wp[(size_t)k * (6 * DM)];
        a0 += ssc[kq * 256 + k] * w;
        a1 += ssc[DM + kq * 256 + k] * w;
      }
      sm[(kq * 64 + (tid & 63)) * 2] = a0;
      sm[(kq * 64 + (tid & 63)) * 2 + 1] = a1;
      __syncthreads();
      if (tid < 128) {
        int cc = tid & 63, which = tid >> 6;
        float s = 0.f;
        for (int q = 0; q < 4; ++q) s += sm[(q * 64 + cc) * 2 + which];
        int colo = cgp * 64 + cc;
        p.mod[(size_t)(layer * 2 + which) * 6 * DM + colo] = s + p.mod_b[layer * 6 * DM + colo];
      }
      __syncthreads();
    } else {
      int tt = t - NMOD;
#pragma unroll
      for (int i = 0; i < 9; ++i) {
        int cnt = (Ks[i] >> 6) * (Ns[i] >> 6);
        if (tt >= 0 && tt < cnt) transpose_tile(srcs[i], Ks[i], Ns[i], dsts[i], kinds[i], tt, sm);
        tt -= cnt;
      }
    }
  }
}

template <bool HAS_Y, bool HAS_H>
DI void phase_rows(const Params& p, int row0, int row1, const float* xin_ctx, const float* xin_lat,
                   float* xout_ctx, float* xout_lat, const u16* Y, const float* modl  ,
                   int gate_idx, const float* gpost, const float* modh  , int shift_idx,
                   const float* gpre, u16* Hout) {
  const int lane = threadIdx.x & 63;
  const int wid = blockIdx.x * 4 + (threadIdx.x >> 6), nw = gridDim.x * 4;
#pragma unroll 1
  for (int pass = 0; pass < 2; ++pass) {
    const bool isc = pass == 0;
    const int ra = isc ? row0 : max(row0, CTXN);
    const int rb = isc ? min(row1, CTXN) : row1;
    if (ra + wid >= rb) continue;
    float4 va[4], vb[4], vc[4];
#pragma unroll
    for (int j = 0; j < 4; ++j) {
      const int c = j * 256 + lane * 4;
      if (HAS_Y) {
        float4 g = *(const float4*)(gpost + c);
        float4 gg = *(const float4*)(modl + (size_t)(isc ? 6 : 0) * DM + gate_idx * DM + c);
        va[j] = make_float4(g.x * gg.x, g.y * gg.y, g.z * gg.z, g.w * gg.w);
      }
      if (HAS_H) {
        const float* sh = modh + (size_t)(isc ? 6 : 0) * DM + shift_idx * DM;
        float4 g = *(const float4*)(gpre + c);
        float4 s1 = *(const float4*)(sh + c);
        float4 s2 = *(const float4*)(sh + DM + c);
        vb[j] = make_float4(g.x * (1.f + s2.x), g.y * (1.f + s2.y), g.z * (1.f + s2.z), g.w * (1.f + s2.w));
        vc[j] = s1;
      }
    }
    const float* xin = isc ? xin_ctx : xin_lat - (size_t)CTXN * DM;
    float* xout = isc ? xout_ctx : xout_lat - (size_t)CTXN * DM;
#pragma unroll 1
    for (int row = ra + wid; row < rb; row += 2 * nw) {
      const int rowB = row + nw;
      const bool hasB = rowB < rb;
      const int rB = hasB ? rowB : row;
      float4 xa[4], xb[4], ya[4], yb[4];
#pragma unroll
      for (int j = 0; j < 4; ++j) {
        xa[j] = *(const float4*)(xin + (size_t)row * DM + j * 256 + lane * 4);
        xb[j] = *(const float4*)(xin + (size_t)rB * DM + j * 256 + lane * 4);
        if (HAS_Y) {
          const uint2 ua = *(const uint2*)(Y + (size_t)row * DM + j * 256 + lane * 4);
          const uint2 ub = *(const uint2*)(Y + (size_t)rB * DM + j * 256 + lane * 4);
          ya[j] = make_float4(bflo(ua.x), bfhi(ua.x), bflo(ua.y), bfhi(ua.y));
          yb[j] = make_float4(bflo(ub.x), bfhi(ub.x), bflo(ub.y), bfhi(ub.y));
        }
      }
      if (HAS_Y) {
        float sa = 0.f, sb2 = 0.f;
#pragma unroll
        for (int j = 0; j < 4; ++j) {
          sa += ya[j].x * ya[j].x + ya[j].y * ya[j].y + ya[j].z * ya[j].z + ya[j].w * ya[j].w;
          sb2 += yb[j].x * yb[j].x + yb[j].y * yb[j].y + yb[j].z * yb[j].z + yb[j].w * yb[j].w;
        }
        sa = wsum(sa); sb2 = wsum(sb2);
        const float ia = rsqrtf(sa * (1.f / DM) + 1e-6f), ib = rsqrtf(sb2 * (1.f / DM) + 1e-6f);
#pragma unroll
        for (int j = 0; j < 4; ++j) {
          xa[j].x += va[j].x * (ya[j].x * ia); xa[j].y += va[j].y * (ya[j].y * ia); xa[j].z += va[j].z * (ya[j].z * ia); xa[j].w += va[j].w * (ya[j].w * ia);
          xb[j].x += va[j].x * (yb[j].x * ib); xb[j].y += va[j].y * (yb[j].y * ib); xb[j].z += va[j].z * (yb[j].z * ib); xb[j].w += va[j].w * (yb[j].w * ib);
          *(float4*)(xout + (size_t)row * DM + j * 256 + lane * 4) = xa[j];
          if (hasB) *(float4*)(xout + (size_t)rowB * DM + j * 256 + lane * 4) = xb[j];
        }
      }
      if (HAS_H) {
        float sa = 0.f, sb2 = 0.f;
#pragma unroll
        for (int j = 0; j < 4; ++j) {
          sa += xa[j].x * xa[j].x + xa[j].y * xa[j].y + xa[j].z * xa[j].z + xa[j].w * xa[j].w;
          sb2 += xb[j].x * xb[j].x + xb[j].y * xb[j].y + xb[j].z * xb[j].z + xb[j].w * xb[j].w;
        }
        sa = wsum(sa); sb2 = wsum(sb2);
        const float ia = rsqrtf(sa * (1.f / DM) + 1e-6f), ib = rsqrtf(sb2 * (1.f / DM) + 1e-6f);
#pragma unroll
        for (int j = 0; j < 4; ++j) {
          uint2 o;
          o.x = pk2(xa[j].x * ia * vb[j].x + vc[j].x, xa[j].y * ia * vb[j].y + vc[j].y);
          o.y = pk2(xa[j].z * ia * vb[j].z + vc[j].z, xa[j].w * ia * vb[j].w + vc[j].w);
          *(uint2*)(Hout + tidx(j * 256 + lane * 4, row, MT)) = o;
          if (hasB) {
            o.x = pk2(xb[j].x * ib * vb[j].x + vc[j].x, xb[j].y * ib * vb[j].y + vc[j].y);
            o.y = pk2(xb[j].z * ib * vb[j].z + vc[j].z, xb[j].w * ib * vb[j].w + vc[j].w);
            *(uint2*)(Hout + tidx(j * 256 + lane * 4, rowB, MT)) = o;
          }
        }
      }
    }
  }
}

enum { EPI_SPLIT = 0, EPI_F32 = 1, EPI_GLU = 2, EPI_FFNUP = 3 };
struct GemmDesc {
  const u16* A; const u16* Bt; int lda; int K; int nN; int tm0; int nM;
  void* d0; void* d1; int ld0; int ld1; int split;
  const float* cw; const float* cb;
  const u16* zrow;
};

template <int MODE>
DI void gemm_tile(const GemmDesc& g, char* smem, int tmi, int tn) {
  const int tid = threadIdx.x, lane = tid & 63, w = tid >> 6, h = lane >> 5, l31 = lane & 31;
  const int wm = w >> 1, wn = w & 1;
  constexpr int ASZ = 256 * 64, BSZ = 128 * 64, STG = ASZ + BSZ;
  int seq_base = 0, seq_len = MT, vrow0 = tmi * 256;
  if (MODE == EPI_FFNUP) {
    if (tmi < 2) { seq_base = 0; seq_len = CTXN; vrow0 = 254 * tmi - 1; }
    else { seq_base = CTXN; seq_len = LSEQ; vrow0 = 254 * (tmi - 2) - 1; }
  }
  const int gkc = ((tid & 3) ^ ((tid >> 4) & 3)) * 8;
  const u16* arow[4];
  int astr[4];
#pragma unroll
  for (int j = 0; j < 4; ++j) {
    const int r = (tid >> 2) + 64 * j;
    if (MODE == EPI_FFNUP) {
      const int v = vrow0 + r;
      const bool ok = (v >= 0 && v < seq_len);
      arow[j] = ok ? g.A + (size_t)(seq_base + v) * 32 + gkc : g.zrow + gkc;
      astr[j] = ok ? MT * 32 : 0;
    } else {
      arow[j] = g.A + (size_t)(vrow0 + r) * 32 + gkc;
      astr[j] = MT * 32;
    }
  }
  const u16* brow[2];
#pragma unroll
  for (int j = 0; j < 2; ++j) brow[j] = g.Bt + (size_t)(tn * 128 + (tid >> 2) + 64 * j) * 32 + gkc;
  const int bstr = g.nN * 128 * 32;
  f32x16 acc[4][2];
#pragma unroll
  for (int a = 0; a < 4; ++a)
#pragma unroll
    for (int b = 0; b < 2; ++b)
#pragma unroll
      for (int i = 0; i < 16; ++i) acc[a][b][i] = 0.f;

  const int nk0 = g.K >> 5;
  const int nk = nk0 * KREP;
  char* dma_dst = smem + (w * 64) * 16;
#define G_DMA(kt_, stg) { char* d_ = dma_dst + (stg) * STG; const int kq_ = (KREP == 1) ? (kt_) : ((kt_) % nk0); \
    __builtin_amdgcn_global_load_lds((const unsigned*)(arow[0] + (size_t)(kq_) * astr[0]), (unsigned*)(d_), 16, 0, 0); \
    __builtin_amdgcn_global_load_lds((const unsigned*)(arow[1] + (size_t)(kq_) * astr[1]), (unsigned*)(d_ + 4096), 16, 0, 0); \
    __builtin_amdgcn_global_load_lds((const unsigned*)(arow[2] + (size_t)(kq_) * astr[2]), (unsigned*)(d_ + 8192), 16, 0, 0); \
    __builtin_amdgcn_global_load_lds((const unsigned*)(arow[3] + (size_t)(kq_) * astr[3]), (unsigned*)(d_ + 12288), 16, 0, 0); \
    __builtin_amdgcn_global_load_lds((const unsigned*)(brow[0] + (size_t)(kq_) * bstr), (unsigned*)(d_ + ASZ), 16, 0, 0); \
    __builtin_amdgcn_global_load_lds((const unsigned*)(brow[1] + (size_t)(kq_) * bstr), (unsigned*)(d_ + ASZ + 4096), 16, 0, 0); }
  const int sw = (l31 >> 2) & 3;
  const int aoff0 = (wm * 128 + l31) * 64 + ((h ^ sw) * 16);
  const int aoff1 = (wm * 128 + l31) * 64 + (((2 + h) ^ sw) * 16);
  const int boff0 = ASZ + (wn * 64 + l31) * 64 + ((h ^ sw) * 16);
  const int boff1 = ASZ + (wn * 64 + l31) * 64 + (((2 + h) ^ sw) * 16);
#define G_COMPUTE(stg) { const char* sb_ = smem + (stg) * STG; \
    _Pragma("unroll") for (int ks = 0; ks < 2; ++ks) { \
      bf16x8 af[4], bf[2]; \
      _Pragma("unroll") for (int mi = 0; mi < 4; ++mi) af[mi] = *(const bf16x8*)(sb_ + (ks ? aoff1 : aoff0) + mi * 32 * 64); \
      _Pragma("unroll") for (int ni = 0; ni < 2; ++ni) bf[ni] = *(const bf16x8*)(sb_ + (ks ? boff1 : boff0) + ni * 32 * 64); \
      _Pragma("unroll") for (int mi = 0; mi < 4; ++mi) \
        _Pragma("unroll") for (int ni = 0; ni < 2; ++ni) acc[mi][ni] = MFMA32(af[mi], bf[ni], acc[mi][ni]); \
    } }
#define RAW_BARRIER() { asm volatile("s_waitcnt lgkmcnt(0)" ::: "memory"); __builtin_amdgcn_s_barrier(); }
  G_DMA(0, 0);
  G_DMA(1, 1);
  int stg = 0;
#define SB_ __builtin_amdgcn_sched_barrier(0)
#define DMA1(ptr, off) __builtin_amdgcn_global_load_lds((const unsigned*)(ptr), (unsigned*)(d_ + (off)), 16, 0, 0)
  for (int kt = 0; kt < nk - 1; ++kt) {
    asm volatile("s_waitcnt vmcnt(6)" ::: "memory");
    RAW_BARRIER();
    const int s2 = (stg == 0) ? 2 : stg - 1;
    const int kn_ = (kt + 2 < nk) ? kt + 2 : nk - 1;
    const int kq_ = (KREP == 1) ? kn_ : (kn_ % nk0);
    char* d_ = dma_dst + s2 * STG;
    const char* sb_ = smem + stg * STG;
    bf16x8 af0[4], bf0[2], af1[4], bf1[2];
#pragma unroll
    for (int mi = 0; mi < 4; ++mi) af0[mi] = *(const bf16x8*)(sb_ + aoff0 + mi * 32 * 64);
#pragma unroll
    for (int ni = 0; ni < 2; ++ni) bf0[ni] = *(const bf16x8*)(sb_ + boff0 + ni * 32 * 64);
#pragma unroll
    for (int mi = 0; mi < 4; ++mi) af1[mi] = *(const bf16x8*)(sb_ + aoff1 + mi * 32 * 64);
#pragma unroll
    for (int ni = 0; ni < 2; ++ni) bf1[ni] = *(const bf16x8*)(sb_ + boff1 + ni * 32 * 64);
    SB_;
    acc[0][0] = MFMA32(af0[0], bf0[0], acc[0][0]); acc[0][1] = MFMA32(af0[0], bf0[1], acc[0][1]); SB_;
    DMA1(arow[0] + (size_t)kq_ * astr[0], 0); SB_;
    acc[1][0] = MFMA32(af0[1], bf0[0], acc[1][0]); acc[1][1] = MFMA32(af0[1], bf0[1], acc[1][1]); SB_;
    DMA1(arow[1] + (size_t)kq_ * astr[1], 4096); SB_;
    acc[2][0] = MFMA32(af0[2], bf0[0], acc[2][0]); acc[2][1] = MFMA32(af0[2], bf0[1], acc[2][1]); SB_;
    DMA1(arow[2] + (size_t)kq_ * astr[2], 8192); SB_;
    acc[3][0] = MFMA32(af0[3], bf0[0], acc[3][0]); acc[3][1] = MFMA32(af0[3], bf0[1], acc[3][1]); SB_;
    DMA1(arow[3] + (size_t)kq_ * astr[3], 12288); SB_;
    acc[0][0] = MFMA32(af1[0], bf1[0], acc[0][0]); acc[0][1] = MFMA32(af1[0], bf1[1], acc[0][1]); SB_;
    DMA1(brow[0] + (size_t)kq_ * bstr, ASZ); SB_;
    acc[1][0] = MFMA32(af1[1], bf1[0], acc[1][0]); acc[1][1] = MFMA32(af1[1], bf1[1], acc[1][1]); SB_;
    DMA1(brow[1] + (size_t)kq_ * bstr, ASZ + 4096); SB_;
    acc[2][0] = MFMA32(af1[2], bf1[0], acc[2][0]); acc[2][1] = MFMA32(af1[2], bf1[1], acc[2][1]);
    acc[3][0] = MFMA32(af1[3], bf1[0], acc[3][0]); acc[3][1] = MFMA32(af1[3], bf1[1], acc[3][1]);
    stg = (stg == 2) ? 0 : stg + 1;
  }
  asm volatile("s_waitcnt vmcnt(0)" ::: "memory");
  RAW_BARRIER();
  G_COMPUTE(stg);
  __syncthreads();
  if (KREP == 2) {
#pragma unroll
    for (int a = 0; a < 4; ++a)
#pragma unroll
      for (int b = 0; b < 2; ++b)
#pragma unroll
        for (int i = 0; i < 16; ++i) acc[a][b][i] *= 0.5f;
  }
  const int rbase = tmi * 256 + wm * 128;
  const int cbase = tn * 128 + wn * 64;
  char* wl = smem + w * 19456;
  if (MODE == EPI_F32) {
    u16* dst = (u16*)g.d0;
    u16* lh = (u16*)wl;
#pragma unroll
    for (int mi = 0; mi < 4; ++mi) {
#pragma unroll
      for (int ni = 0; ni < 2; ++ni)
#pragma unroll
        for (int i = 0; i < 16; ++i) lh[crow(i, h) * 72 + ni * 32 + l31] = f2bf(acc[mi][ni][i]);
#pragma unroll
      for (int it = 0; it < 4; ++it) {
        const int r = it * 8 + (lane >> 3), c8 = (lane & 7) * 8;
        uint4 v = *(const uint4*)(lh + r * 72 + c8);
        *(uint4*)(dst + (size_t)(rbase + mi * 32 + r) * g.ld0 + cbase + c8) = v;
      }
    }
  } else if (MODE == EPI_SPLIT) {
    u16* dst; int ld, cc;
    if (cbase < g.split) { dst = (u16*)g.d0; ld = g.ld0; cc = cbase; } else { dst = (u16*)g.d1; ld = g.ld1; cc = cbase - g.split; }
    u16* lh = (u16*)wl;
#pragma unroll
    for (int mi = 0; mi < 4; ++mi) {
#pragma unroll
      for (int ni = 0; ni < 2; ++ni)
#pragma unroll
        for (int i = 0; i < 16; ++i) lh[crow(i, h) * 72 + ni * 32 + l31] = f2bf(acc[mi][ni][i]);
#pragma unroll
      for (int it = 0; it < 4; ++it) {
        const int r = it * 8 + (lane >> 3), c8 = (lane & 7) * 8;
        uint4 v = *(const uint4*)(lh + r * 72 + c8);
        *(uint4*)(dst + (size_t)(rbase + mi * 32 + r) * ld + cc + c8) = v;
      }
    }
  } else if (MODE == EPI_GLU) {
    u16* dst = (u16*)g.d0;
    const int col0 = (tn * 2 + wn) * 32;
    u16* lh = (u16*)wl;
#pragma unroll
    for (int mi = 0; mi < 4; ++mi) {
#pragma unroll
      for (int i = 0; i < 16; ++i) lh[crow(i, h) * 40 + l31] = f2bf(acc[mi][0][i] * sigmoid_f(acc[mi][1][i]));
#pragma unroll
      for (int it = 0; it < 2; ++it) {
        const int r = it * 16 + (lane >> 2), c8 = (lane & 3) * 8;
        uint4 v = *(const uint4*)(lh + r * 40 + c8);
        *(uint4*)(dst + tidx(col0 + c8, rbase + mi * 32 + r, MT)) = v;
      }
    }
  } else {
    u16* T = (u16*)smem;
#pragma unroll
    for (int mi = 0; mi < 4; ++mi)
#pragma unroll
      for (int ni = 0; ni < 2; ++ni)
#pragma unroll
        for (int i = 0; i < 16; ++i)
          T[(wm * 128 + mi * 32 + crow(i, h)) * 136 + wn * 64 + ni * 32 + l31] = f2bf(acc[mi][ni][i]);
    __syncthreads();
    {
      const int cg8 = (tid & 7) * 8, r0 = (tid >> 3) * 8;
      const int fa = tn * 64 + cg8, fg = DFF + fa;
      float wa[3][8], wg[3][8], ba[8], bg[8];
#pragma unroll
      for (int q = 0; q < 3; ++q)
#pragma unroll
        for (int e = 0; e < 8; e += 4) {
          float4 x = *(const float4*)(g.cw + q * 2 * DFF + fa + e); wa[q][e] = x.x; wa[q][e + 1] = x.y; wa[q][e + 2] = x.z; wa[q][e + 3] = x.w;
          float4 y = *(const float4*)(g.cw + q * 2 * DFF + fg + e); wg[q][e] = y.x; wg[q][e + 1] = y.y; wg[q][e + 2] = y.z; wg[q][e + 3] = y.w;
        }
#pragma unroll
      for (int e = 0; e < 8; e += 4) {
        float4 x = *(const float4*)(g.cb + fa + e); ba[e] = x.x; ba[e + 1] = x.y; ba[e + 2] = x.z; ba[e + 3] = x.w;
        float4 y = *(const float4*)(g.cb + fg + e); bg[e] = y.x; bg[e + 1] = y.y; bg[e + 2] = y.z; bg[e + 3] = y.w;
      }
      float ap[8], ac[8], an[8], gp[8], gc[8], gn[8];
      auto ld8 = [&](int r, int coff, float* o) {
        uint4 v = *(const uint4*)(T + r * 136 + coff);
        o[0] = bflo(v.x); o[1] = bfhi(v.x); o[2] = bflo(v.y); o[3] = bfhi(v.y); o[4] = bflo(v.z); o[5] = bfhi(v.z); o[6] = bflo(v.w); o[7] = bfhi(v.w);
      };
      const int rm1 = (r0 > 0) ? r0 - 1 : 0;
      ld8(rm1, cg8, ap); ld8(rm1, 64 + cg8, gp);
      ld8(r0, cg8, ac); ld8(r0, 64 + cg8, gc);
      u16* dst = (u16*)g.d0;
#pragma unroll
      for (int rr = 0; rr < 8; ++rr) {
        const int r = r0 + rr;
        const int rn = (r < 255) ? r + 1 : 255;
        ld8(rn, cg8, an); ld8(rn, 64 + cg8, gn);
        const int v = vrow0 + r;
        if (r >= 1 && r <= 254 && v < seq_len) {
          float o[8];
#pragma unroll
          for (int e = 0; e < 8; ++e) {
            const float av = wa[0][e] * ap[e] + wa[1][e] * ac[e] + wa[2][e] * an[e] + ba[e];
            const float gv = wg[0][e] * gp[e] + wg[1][e] * gc[e] + wg[2][e] * gn[e] + bg[e];
            o[e] = av * silu_f(gv);
          }
          uint4 ov; ov.x = pk2(o[0], o[1]); ov.y = pk2(o[2], o[3]); ov.z = pk2(o[4], o[5]); ov.w = pk2(o[6], o[7]);
          *(uint4*)(dst + tidx(fa, seq_base + v, MT)) = ov;
        }
#pragma unroll
        for (int e = 0; e < 8; ++e) { ap[e] = ac[e]; ac[e] = an[e]; gp[e] = gc[e]; gc[e] = gn[e]; }
      }
    }
  }
  __syncthreads();
}

template <int MODE>
DI void phase_gemm(const GemmDesc& g, char* smem) {
  const int ntiles = g.nM * g.nN;
  const int per = gridDim.x >> 3;
  const int slot = (blockIdx.x & 7) * per + (blockIdx.x >> 3);
  for (int q0 = slot; q0 < ntiles * REP_G; q0 += gridDim.x) {
    const int q = q0 % ntiles;
    const int gm = q / (8 * g.nN);
    const int rows = min(8, g.nM - 8 * gm);
    const int ql = q - gm * 8 * g.nN;
    const int tn = ql / rows, tm = g.tm0 + gm * 8 + ql % rows;
    gemm_tile<MODE>(g, smem, tm, tn);
  }
}

DI void rope_angles(int row, int i, float& cs, float& sn) {
  const int pos = row - CTXN;
  const int rr = pos >> 6, cc = pos & 63;
  const int fi = i & 15;
  const float inv = exp2f(-(float)fi * (13.287712379549449f / 16.f));
  const float ang = (float)((i < 16) ? rr : cc) * inv;
  sincosf(ang, &sn, &cs);
}

DI void qk_prep(const u16* __restrict__ src, int lds, int coff, int nheads, u16* __restrict__ dst, const float* gnorm  ,
                float oscale, int row0) {
  const int lane = threadIdx.x & 63, hh = lane >> 5, i = lane & 31;
  const int wid = blockIdx.x * 4 + (threadIdx.x >> 6), nw = gridDim.x * 4;
  const int npair = nheads >> 1;
  const int nitems = (MT - row0) * npair;
  for (int it = wid; it < nitems; it += nw) {
    const int row = row0 + it / npair, head = (it % npair) * 2 + hh;
    unsigned v = *(const unsigned*)(src + (size_t)row * lds + coff + head * 64 + 2 * i);
    float e = bflo(v), o = bfhi(v);
    if (gnorm) {
      float ss = hsum32(e * e + o * o);
      float rinv = rsqrtf(ss * (1.f / 64.f) + 1e-6f);
      e = e * rinv * gnorm[2 * i]; o = o * rinv * gnorm[2 * i + 1];
    }
    if (row >= CTXN) {
      float cs, sn; rope_angles(row, i, cs, sn);
      float e2 = e * cs - o * sn, o2 = e * sn + o * cs;
      e = e2; o = o2;
    }
    *(unsigned*)(dst + ((size_t)head * MT + row) * 64 + 2 * i) = pk2(e * oscale, o * oscale);
  }
}

DI void v_transpose(const u16* __restrict__ src, int lds, int coff, int ncols, u16* __restrict__ dst, char* smem) {
  u16* sm = (u16*)smem;
  const int tid = threadIdx.x;
  const int ndt = ncols >> 6;
  const int ntasks = NCHUNK * ndt;
  for (int t = blockIdx.x; t < ntasks; t += gridDim.x) {
    const int tt = t / ndt, dt = t % ndt;
    {
      const int tok = tid >> 2, part = tid & 3;
      const u16* sp = src + (size_t)(tt * 64 + tok) * lds + coff + dt * 64 + part * 16;
      uint4 a = *(const uint4*)sp, b = *(const uint4*)(sp + 8);
      unsigned* d = (unsigned*)(sm + tok * 66 + part * 16);
      d[0] = a.x; d[1] = a.y; d[2] = a.z; d[3] = a.w; d[4] = b.x; d[5] = b.y; d[6] = b.z; d[7] = b.w;
    }
    __syncthreads();
    {
      const int d = tid >> 2, part = tid & 3;
      unsigned o[8];
#pragma unroll
      for (int j = 0; j < 8; ++j) {
        unsigned lo = sm[(part * 16 + 2 * j) * 66 + d], hi = sm[(part * 16 + 2 * j + 1) * 66 + d];
        o[j] = lo | (hi << 16);
      }
      u16* dp = dst + (size_t)(dt * 64 + d) * MT + tt * 64 + part * 16;
      *(uint4*)dp = make_uint4(o[0], o[1], o[2], o[3]);
      *(uint4*)(dp + 8) = make_uint4(o[4], o[5], o[6], o[7]);
    }
    __syncthreads();
  }
}

DI void gated_conv(const Params& p, const u16* __restrict__ G, u16* __restrict__ A2) {
  const int lane = threadIdx.x & 63;
  const int wid = blockIdx.x * 4 + (threadIdx.x >> 6), nw = gridDim.x * 4;
  const int nitems = MT * 4;
  for (int it = wid; it < nitems; it += nw) {
    const int row = it >> 2, c = ((it & 3) * 64 + lane) * 2;
    const bool first = (row == 0) || (row == CTXN), last = (row == CTXN - 1) || (row == MT - 1);
    const u16* gr = G + (size_t)row * 1536;
    unsigned gb = *(const unsigned*)(gr + c);
    unsigned c1 = *(const unsigned*)(gr + 512 + c), v1 = *(const unsigned*)(gr + 1024 + c);
    float m1a = bflo(c1) * bflo(v1), m1b = bfhi(c1) * bfhi(v1);
    float m0a = 0.f, m0b = 0.f, m2a = 0.f, m2b = 0.f;
    if (!first) {
      unsigned c0 = *(const unsigned*)(gr - 1536 + 512 + c), v0 = *(const unsigned*)(gr - 1536 + 1024 + c);
      m0a = bflo(c0) * bflo(v0); m0b = bfhi(c0) * bfhi(v0);
    }
    if (!last) {
      unsigned c2 = *(const unsigned*)(gr + 1536 + 512 + c), v2 = *(const unsigned*)(gr + 1536 + 1024 + c);
      m2a = bflo(c2) * bflo(v2); m2b = bfhi(c2) * bfhi(v2);
    }
    const float* cw = p.ev_conv_w;
    float ya = bflo(gb) * (cw[c] * m0a + cw[512 + c] * m1a + cw[1024 + c] * m2a);
    float yb = bfhi(gb) * (cw[c + 1] * m0b + cw[512 + c + 1] * m1b + cw[1024 + c + 1] * m2b);
    *(unsigned*)(A2 + tidx(c, row, MT)) = pk2(ya, yb);
  }
}

DI int kperm(int r) { return (r & 0x13) | ((r & 4) << 1) | ((r & 8) >> 1); }

template <int DV, int NCOMP>
DI void attn_task(char* smem, const u16* __restrict__ Qb, const u16* __restrict__ Kb, const u16* __restrict__ Vt,
                  int qh, int kslot, int q0w, int kh0, int vhead, int nkt, u16* __restrict__ A2, int ocol,
                  float lam, float lam_init, const float* __restrict__ subln) {
  const int tid = threadIdx.x, lane = tid & 63, w = tid >> 6, h = lane >> 5, l31 = lane & 31;
  constexpr int KT = 64 * 144;
  constexpr int STG = NCOMP * KT + DV * 144;
  constexpr int NDB = DV / 32;
  bf16x8 qf[4];
  {
    const u16* qp = Qb + ((size_t)qh * MT + q0w + l31) * 64 + h * 8;
#pragma unroll
    for (int ks = 0; ks < 4; ++ks) qf[ks] = *(const bf16x8*)(qp + ks * 16);
  }
  f32x16 O[NDB];
#pragma unroll
  for (int d = 0; d < NDB; ++d)
#pragma unroll
    for (int i = 0; i < 16; ++i) O[d][i] = 0.f;
  float m = 0.f, lsum = 0.f;
  f32x16 negm, Lacc;
#pragma unroll
  for (int i = 0; i < 16; ++i) { negm[i] = 0.f; Lacc[i] = 0.f; }
  bf16x8 ones;
  {
    const short ov = (l31 == 0) ? (short)0x3F80 : (short)0;
#pragma unroll
    for (int j = 0; j < 8; ++j) ones[j] = ov;
  }
  uint4 kr0, kr1, kr2, kr3, vr0, vr1, vr2, vr3;
  kr2 = kr3 = vr2 = vr3 = make_uint4(0, 0, 0, 0);
  const int skey = (tid & 511) >> 3, spart = tid & 7;
  const u16* kg = Kb + ((size_t)kh0 * MT + skey) * 64 + spart * 8;
  const u16* vg = Vt + ((size_t)vhead * DV + (tid >> 3)) * MT + spart * 8;
  const int ksl = skey * 144 + spart * 16;
  const int vsl = NCOMP * KT + (tid >> 3) * 144 + spart * 16;
#define A_LOAD(kt) { \
    kr0 = *(const uint4*)(kg + (size_t)(kt) * 64 * 64); kr1 = *(const uint4*)(kg + (size_t)(kt) * 64 * 64 + 32 * 64); \
    if (NCOMP == 2) { kr2 = *(const uint4*)(kg + (size_t)MT * 64 + (size_t)(kt) * 64 * 64); kr3 = *(const uint4*)(kg + (size_t)MT * 64 + (size_t)(kt) * 64 * 64 + 32 * 64); } \
    vr0 = *(const uint4*)(vg + (kt) * 64); vr1 = *(const uint4*)(vg + (size_t)32 * MT + (kt) * 64); \
    if (DV == 128) { vr2 = *(const uint4*)(vg + (size_t)64 * MT + (kt) * 64); vr3 = *(const uint4*)(vg + (size_t)96 * MT + (kt) * 64); } }
#define A_WRITE(buf) { char* sb_ = smem + (buf) * STG; \
    *(uint4*)(sb_ + ksl) = kr0; *(uint4*)(sb_ + ksl + 32 * 144) = kr1; \
    if (NCOMP == 2) { *(uint4*)(sb_ + KT + ksl) = kr2; *(uint4*)(sb_ + KT + ksl + 32 * 144) = kr3; } \
    *(uint4*)(sb_ + vsl) = vr0; *(uint4*)(sb_ + vsl + 32 * 144) = vr1; \
    if (DV == 128) { *(uint4*)(sb_ + vsl + 64 * 144) = vr2; *(uint4*)(sb_ + vsl + 96 * 144) = vr3; } }
  A_LOAD(0); A_WRITE(0); __syncthreads();
  for (int kt = 0; kt < nkt; ++kt) {
    const int ktn = (kt + 1 < nkt) ? kt + 1 : kt;
    A_LOAD(ktn);
    __builtin_amdgcn_sched_barrier(0);
    const char* sb = smem + (kt & 1) * STG;
    const char* kp = sb + kslot * KT + kperm(l31) * 144 + h * 16;
    f32x16 S0, S1;
    {
      bf16x8 a0 = *(const bf16x8*)(kp);
      bf16x8 a1 = *(const bf16x8*)(kp + 32 * 144);
      if (NCOMP == 1) { S0 = MFMA32(a0, qf[0], negm); S1 = MFMA32(a1, qf[0], negm); }
      else {
        f32x16 z;
#pragma unroll
        for (int i = 0; i < 16; ++i) z[i] = 0.f;
        S0 = MFMA32(a0, qf[0], z); S1 = MFMA32(a1, qf[0], z);
      }
    }
#pragma unroll
    for (int ks = 1; ks < 4; ++ks) {
      bf16x8 a0 = *(const bf16x8*)(kp + ks * 32);
      bf16x8 a1 = *(const bf16x8*)(kp + 32 * 144 + ks * 32);
      S0 = MFMA32(a0, qf[ks], S0);
      S1 = MFMA32(a1, qf[ks], S1);
    }
    float mx = fmaxf(S0[0], S1[0]);
#pragma unroll
    for (int i = 1; i < 16; ++i) mx = fmaxf(mx, fmaxf(S0[i], S1[i]));
    mx = fmaxf(mx, __shfl_xor(mx, 32));
    if (NCOMP == 2) mx -= m;
    const bool recentre = (kt == 0) || (mx > 8.f);
    if (__any(recentre)) {
      const float delta = recentre ? mx : 0.f;
      const float alpha = __builtin_amdgcn_exp2f(-delta);
      m += delta;
      lsum *= alpha;
      if (NCOMP == 1) {
#pragma unroll
        for (int i = 0; i < 16; ++i) { negm[i] = -m; S0[i] -= delta; S1[i] -= delta; }
        Lacc[0] *= alpha;
      }
#pragma unroll
      for (int d = 0; d < NDB; ++d)
#pragma unroll
        for (int i = 0; i < 16; ++i) O[d][i] *= alpha;
    }
    if (NCOMP == 1) {
#pragma unroll
      for (int i = 0; i < 16; ++i) { S0[i] = __builtin_amdgcn_exp2f(S0[i]); S1[i] = __builtin_amdgcn_exp2f(S1[i]); }
    } else {
      float ps = 0.f;
#pragma unroll
      for (int i = 0; i < 16; ++i) { S0[i] = __builtin_amdgcn_exp2f(S0[i] - m); ps += S0[i]; }
#pragma unroll
      for (int i = 0; i < 16; ++i) { S1[i] = __builtin_amdgcn_exp2f(S1[i] - m); ps += S1[i]; }
      lsum += ps;
    }
    bf16x8 pf[4];
#pragma unroll
    for (int s2 = 0; s2 < 2; ++s2) {
      uint4 a, b;
      a.x = pk2(S0[8 * s2], S0[8 * s2 + 1]); a.y = pk2(S0[8 * s2 + 2], S0[8 * s2 + 3]);
      a.z = pk2(S0[8 * s2 + 4], S0[8 * s2 + 5]); a.w = pk2(S0[8 * s2 + 6], S0[8 * s2 + 7]);
      b.x = pk2(S1[8 * s2], S1[8 * s2 + 1]); b.y = pk2(S1[8 * s2 + 2], S1[8 * s2 + 3]);
      b.z = pk2(S1[8 * s2 + 4], S1[8 * s2 + 5]); b.w = pk2(S1[8 * s2 + 6], S1[8 * s2 + 7]);
      pf[s2] = __builtin_bit_cast(bf16x8, a);
      pf[2 + s2] = __builtin_bit_cast(bf16x8, b);
    }
    const char* vp = sb + NCOMP * KT + l31 * 144 + h * 16;
#pragma unroll
    for (int kk = 0; kk < 4; ++kk)
#pragma unroll
      for (int d = 0; d < NDB; ++d) {
        bf16x8 vf = *(const bf16x8*)(vp + d * 32 * 144 + kk * 32);
        O[d] = MFMA32(vf, pf[kk], O[d]);
      }
    if (NCOMP == 1) {
#pragma unroll
      for (int kk = 0; kk < 4; ++kk) Lacc = MFMA32(ones, pf[kk], Lacc);
    }
    A_WRITE((kt + 1) & 1);
    __syncthreads();
  }
  const float ltot = (NCOMP == 1) ? __shfl(Lacc[0], l31) : lsum + __shfl_xor(lsum, 32);
  const float inv = 1.f / ltot;
  const int row = q0w + l31;
  if (NCOMP == 1) {
#pragma unroll
    for (int d = 0; d < NDB; ++d)
#pragma unroll
      for (int q = 0; q < 4; ++q) {
        const int dd = d * 32 + 8 * q + 4 * h;
        uint2 v; v.x = pk2(O[d][4 * q] * inv, O[d][4 * q + 1] * inv); v.y = pk2(O[d][4 * q + 2] * inv, O[d][4 * q + 3] * inv);
        *(uint2*)(A2 + tidx(ocol + dd, row, MT)) = v;
      }
  } else {
    float* ox = (float*)smem;
    const int ql = (w >> 1) * 32 + l31;
    if (w & 1) {
#pragma unroll
      for (int d = 0; d < NDB; ++d)
#pragma unroll
        for (int q = 0; q < 4; ++q) {
          const int dd = d * 32 + 8 * q + 4 * h;
          float4 v = make_float4(O[d][4 * q] * inv, O[d][4 * q + 1] * inv, O[d][4 * q + 2] * inv, O[d][4 * q + 3] * inv);
          *(float4*)(ox + ql * 132 + dd) = v;
        }
    }
    __syncthreads();
    if (!(w & 1)) {
      float ss = 0.f;
#pragma unroll
      for (int d = 0; d < NDB; ++d)
#pragma unroll
        for (int q = 0; q < 4; ++q) {
          const int dd = d * 32 + 8 * q + 4 * h;
          float4 o2 = *(const float4*)(ox + ql * 132 + dd);
          O[d][4 * q] = O[d][4 * q] * inv - lam * o2.x;
          O[d][4 * q + 1] = O[d][4 * q + 1] * inv - lam * o2.y;
          O[d][4 * q + 2] = O[d][4 * q + 2] * inv - lam * o2.z;
          O[d][4 * q + 3] = O[d][4 * q + 3] * inv - lam * o2.w;
          ss += O[d][4 * q] * O[d][4 * q] + O[d][4 * q + 1] * O[d][4 * q + 1] + O[d][4 * q + 2] * O[d][4 * q + 2] + O[d][4 * q + 3] * O[d][4 * q + 3];
        }
      ss += __shfl_xor(ss, 32);
      const float r = rsqrtf(ss * (1.f / 128.f) + 1e-6f) * (1.f - lam_init);
#pragma unroll
      for (int d = 0; d < NDB; ++d)
#pragma unroll
        for (int q = 0; q < 4; ++q) {
          const int dd = d * 32 + 8 * q + 4 * h;
          float4 gs = *(const float4*)(subln + dd);
          uint2 v; v.x = pk2(O[d][4 * q] * r * gs.x, O[d][4 * q + 1] * r * gs.y); v.y = pk2(O[d][4 * q + 2] * r * gs.z, O[d][4 * q + 3] * r * gs.w);
          *(uint2*)(A2 + tidx(ocol + dd, row, MT)) = v;
        }
    }
    __syncthreads();
  }
}

DI void s5_coeffs(const Params& p, int dir, int g, int pp, float& abr, float& abi, float& cr, float& ci) {
  const int idx = (dir * 32 + g) * 64 + pp;
  const float dt = expf(p.log_dt[dir * 32 + g]);
  const float are = p.a_re[idx], aim = p.a_im[idx];
  const float mag = expf(are * dt);
  float sn, cs; sincosf(aim * dt, &sn, &cs);
  abr = mag * cs; abi = mag * sn;
  const float nr = abr - 1.f, ni = abi;
  const float den = are * are + aim * aim;
  cr = (nr * are + ni * aim) / den;
  ci = (ni * are - nr * aim) / den;
}

template <bool OUT>
DI void s5_task(const Params& p, char* smem, int gp, int c, const u16* __restrict__ U1, u16* __restrict__ Z) {
  float* su = (float*)smem;
  u16* hm = (u16*)(smem + 8192);
  const int tid = threadIdx.x, lane = tid & 63, w = tid >> 6;
  const int gl = w >> 1, dir = w & 1, g = 2 * gp + gl;
  {
    const int t = tid >> 2, part = tid & 3;
    uint4 v = *(const uint4*)(U1 + (size_t)(c * 64 + t) * 512 + gp * 32 + part * 8);
    float* d = su + t * 32 + part * 8;
    d[0] = bflo(v.x); d[1] = bfhi(v.x); d[2] = bflo(v.y); d[3] = bfhi(v.y);
    d[4] = bflo(v.z); d[5] = bfhi(v.z); d[6] = bflo(v.w); d[7] = bfhi(v.w);
  }
  float abr, abi, cr, ci;
  s5_coeffs(p, dir, g, lane, abr, abi, cr, ci);
  float bbr[16], bbi[16];
  {
    const size_t bidx = ((size_t)(dir * 32 + g) * 64 + lane) * 16;
#pragma unroll
    for (int q = 0; q < 4; ++q) {
      float4 br = *(const float4*)(p.b_re + bidx + q * 4), bi = *(const float4*)(p.b_im + bidx + q * 4);
      bbr[4 * q] = cr * br.x - ci * bi.x; bbi[4 * q] = cr * bi.x + ci * br.x;
      bbr[4 * q + 1] = cr * br.y - ci * bi.y; bbi[4 * q + 1] = cr * bi.y + ci * br.y;
      bbr[4 * q + 2] = cr * br.z - ci * bi.z; bbi[4 * q + 2] = cr * bi.z + ci * br.z;
      bbr[4 * q + 3] = cr * br.w - ci * bi.w; bbi[4 * q + 3] = cr * bi.w + ci * br.w;
    }
  }
  float2* sp = (float2*)p.s5s + ((size_t)(dir * 32 + g) * NCHUNK + c) * 64 + lane;
  float hr = 0.f, hi = 0.f;
  if (OUT) { float2 h0 = *sp; hr = h0.x; hi = h0.y; }
  __syncthreads();
  for (int step = 0; step < 64; ++step) {
    const int t = dir ? 63 - step : step;
    const float* ur = su + t * 32 + gl * 16;
    float bur = 0.f, bui = 0.f;
#pragma unroll
    for (int q = 0; q < 4; ++q) {
      float4 u = *(const float4*)(ur + 4 * q);
      bur += bbr[4 * q] * u.x + bbr[4 * q + 1] * u.y + bbr[4 * q + 2] * u.z + bbr[4 * q + 3] * u.w;
      bui += bbi[4 * q] * u.x + bbi[4 * q + 1] * u.y + bbi[4 * q + 2] * u.z + bbi[4 * q + 3] * u.w;
    }
    const float nhr = abr * hr - abi * hi + bur;
    const float nhi = abr * hi + abi * hr + bui;
    hr = nhr; hi = nhi;
    if (OUT) {
      u16* hrow = hm + (gl * 64 + t) * 264 + dir * 128 + lane;
      hrow[0] = f2bf(hr); hrow[64] = f2bf(hi);
    }
  }
  if (!OUT) {
    *sp = make_float2(hr, hi);
    __syncthreads();
  } else {
    __syncthreads();
    const int l15 = lane & 15, lq = lane >> 4;
    f32x4 acc0 = {0.f, 0.f, 0.f, 0.f}, acc1 = {0.f, 0.f, 0.f, 0.f};
    const int tb0 = 2 * (w & 1);
#pragma unroll
    for (int kb = 0; kb < 8; ++kb) {
      const int k0 = kb * 32 + lq * 8;
      const int dk = k0 >> 7, rem = k0 & 127, isim = rem >> 6, pp = rem & 63;
      const float* cs = (isim ? p.c_im : p.c_re) + ((size_t)((dk * 32 + g) * 16 + l15)) * 64 + pp;
      const float sg = isim ? -1.f : 1.f;
      float4 c0 = *(const float4*)cs, c1 = *(const float4*)(cs + 4);
      uint4 bb; bb.x = pk2(sg * c0.x, sg * c0.y); bb.y = pk2(sg * c0.z, sg * c0.w); bb.z = pk2(sg * c1.x, sg * c1.y); bb.w = pk2(sg * c1.z, sg * c1.w);
      bf16x8 bfr = __builtin_bit_cast(bf16x8, bb);
      bf16x8 a0 = *(const bf16x8*)(hm + (gl * 64 + tb0 * 16 + l15) * 264 + k0);
      bf16x8 a1 = *(const bf16x8*)(hm + (gl * 64 + (tb0 + 1) * 16 + l15) * 264 + k0);
      acc0 = MFMA16(a0, bfr, acc0);
      acc1 = MFMA16(a1, bfr, acc1);
    }
    const float dsk = p.d_skip[g * 16 + l15];
#pragma unroll
    for (int j = 0; j < 4; ++j) {
      int t = tb0 * 16 + lq * 4 + j;
      float y = acc0[j] + dsk * su[t * 32 + gl * 16 + l15];
      Z[tidx(g * 16 + l15, c * 64 + t, MT)] = f2bf(gelu_tanh(y));
      t += 16;
      y = acc1[j] + dsk * su[t * 32 + gl * 16 + l15];
      Z[tidx(g * 16 + l15, c * 64 + t, MT)] = f2bf(gelu_tanh(y));
    }
    __syncthreads();
  }
}

DI void s5_carry(const Params& p) {
  if (blockIdx.x >= 16) return;
  const int s = blockIdx.x * 256 + threadIdx.x;
  const int dir = s >> 11, g = (s >> 6) & 31, pp = s & 63;
  float abr, abi, cr, ci;
  s5_coeffs(p, dir, g, pp, abr, abi, cr, ci);
#pragma unroll
  for (int q = 0; q < 6; ++q) { float nr = abr * abr - abi * abi, ni = 2.f * abr * abi; abr = nr; abi = ni; }
  float2* base = (float2*)p.s5s + ((size_t)(dir * 32 + g) * NCHUNK) * 64 + pp;
  float hr = 0.f, hi = 0.f;
  for (int b = 0; b < 10; ++b) {
    float2 tmp[26];
#pragma unroll
    for (int j = 0; j < 26; ++j) {
      const int step = b * 26 + j;
      const int c = dir == 0 ? step : (step < 4 ? 3 - step : 263 - step);
      tmp[j] = base[(size_t)c * 64];
    }
#pragma unroll
    for (int j = 0; j < 26; ++j) {
      const int step = b * 26 + j;
      const int c = dir == 0 ? step : (step < 4 ? 3 - step : 263 - step);
      base[(size_t)c * 64] = make_float2(hr, hi);
      const float nr = abr * hr - abi * hi + tmp[j].x;
      const float ni = abr * hi + abi * hr + tmp[j].y;
      hr = nr; hi = ni;
    }
  }
}

DI unsigned gb_ld(unsigned* p) { return __hip_atomic_load(p, __ATOMIC_RELAXED, __HIP_MEMORY_SCOPE_AGENT); }
DI unsigned gb_add(unsigned* p, unsigned v) { return __hip_atomic_fetch_add(p, v, __ATOMIC_RELAXED, __HIP_MEMORY_SCOPE_AGENT); }
DI void grid_barrier(unsigned* bar, unsigned& epoch) {
  asm volatile("s_waitcnt vmcnt(0)" ::: "memory");
  __syncthreads();
  if (threadIdx.x == 0) {
    __builtin_amdgcn_fence(__ATOMIC_RELEASE, "agent");
    asm volatile("s_waitcnt vmcnt(0)" ::: "memory");
    const unsigned grp = blockIdx.x & 15u;
    const unsigned ngb = (gridDim.x + 15u - grp) >> 4;
    const unsigned old = gb_add(&bar[64 * (1 + grp)], 1u);
    if (old + 1u == (epoch + 1u) * ngb) {
      const unsigned ot = gb_add(&bar[64 * 17], 1u);
      if (ot + 1u == (epoch + 1u) * 16u) __hip_atomic_store(&bar[0], epoch + 1u, __ATOMIC_RELAXED, __HIP_MEMORY_SCOPE_AGENT);
    }
    while (gb_ld(&bar[0]) < epoch + 1u) __builtin_amdgcn_s_sleep(1);
    __builtin_amdgcn_fence(__ATOMIC_ACQUIRE, "agent");
    asm volatile("s_waitcnt vmcnt(0)" ::: "memory");
  }
  epoch++;
  __syncthreads();
}

__global__ void __launch_bounds__(256, 2) fwd_megakernel(Params p) {
  extern __shared__ __attribute__((aligned(16))) char smem[];
  cg::grid_group grid = cg::this_grid();
  const size_t RW = (size_t)MT * DM;
  u16* A2 = p.H;
  u16* Qb = (u16*)p.Y;
  u16* Kb = Qb + RW / 2;
  u16* Vt = Kb + RW / 2;
  const float* mod0 = p.mod;
  const float* mod1 = p.mod + 2 * 6 * DM;

  unsigned epoch = 0;
  if (p.ph_lo < 0) grid.sync();
#define PHASE_BEGIN(k) if ((k) >= p.ph_lo && (k) < p.ph_hi) { if ((k) > p.ph_lo) grid_barrier(p.bar, epoch);
#define PHASE_END }

  PHASE_BEGIN(0) for (int rep = 0; rep < REP_P; ++rep) phase_prep_weights(p, smem); PHASE_END

  PHASE_BEGIN(1)
    for (int rep = 0; rep < REP_O; ++rep) phase_rows<false, true>(p, 0, MT, p.ctx, p.x, nullptr, nullptr, nullptr, nullptr, 0, nullptr, mod0, 0, p.norm_pre, p.H);
  PHASE_END

  PHASE_BEGIN(2) {
    GemmDesc g{}; g.A = p.H; g.Bt = p.wt_in0; g.lda = DM; g.K = DM; g.nN = 18; g.tm0 = 0; g.nM = 65;
    g.d0 = p.big; g.ld0 = 1536; g.d1 = p.big + (size_t)MT * 1536; g.ld1 = 768; g.split = 1536;
    phase_gemm<EPI_SPLIT>(g, smem);
  } PHASE_END

  PHASE_BEGIN(3) {
    const u16* G = p.big; const u16* QKV = p.big + (size_t)MT * 1536;
    for (int rep = 0; rep < REP_O; ++rep) {
    qk_prep(QKV, 768, 0, 8, Qb, p.ev_q_norm, 0.125f * LOG2E, 0);
    qk_prep(QKV, 768, 512, 2, Kb, p.ev_k_norm, 1.f, 0);
    v_transpose(QKV, 768, 640, 128, Vt, smem);
    gated_conv(p, G, A2);
    }
  } PHASE_END

  PHASE_BEGIN(4) {
    const int w = threadIdx.x >> 6;
    const int nlat = 8 * 128, nctx = 8 * 2;
    for (int t0 = blockIdx.x; t0 < (nlat + nctx) * REP_A; t0 += gridDim.x) {
      const int t = t0 % (nlat + nctx);
      int head, q0, nkt;
      if (t < nlat) { head = t & 7; q0 = CTXN + (t >> 3) * 128; nkt = NCHUNK; }
      else { int tt = t - nlat; head = tt & 7; q0 = (tt >> 3) * 128; nkt = CTXN / 64; }
      attn_task<64, 1>(smem, Qb, Kb, Vt, head, 0, q0 + 32 * w, head >> 2, head >> 2, nkt, A2, 512 + head * 64, 0.f, 0.f, nullptr);
    }
  } PHASE_END

  PHASE_BEGIN(5) {
    GemmDesc g{}; g.A = A2; g.Bt = p.wt_out0; g.lda = DM; g.K = DM; g.nN = 8; g.tm0 = 0; g.nM = 65;
    g.d0 = p.Y; g.ld0 = DM;
    phase_gemm<EPI_F32>(g, smem);
  } PHASE_END

  PHASE_BEGIN(6)
    for (int rep = 0; rep < REP_O; ++rep) phase_rows<true, true>(p, 0, MT, p.ctx, p.x, p.xctx, p.out, (const u16*)p.Y, mod0, 2, p.norm_post, mod0, 3, p.norm_pre + DM, p.H);
  PHASE_END

  PHASE_BEGIN(7) {
    GemmDesc g{}; g.A = p.H; g.Bt = p.wt_up0; g.lda = DM; g.K = DM; g.nN = 44; g.tm0 = 0; g.nM = 67;
    g.d0 = p.big; g.cw = p.ffn_conv_w; g.cb = p.ffn_conv_b; g.zrow = (const u16*)(p.bar + 1536);
    phase_gemm<EPI_FFNUP>(g, smem);
  } PHASE_END

  PHASE_BEGIN(8) {
    GemmDesc g{}; g.A = p.big; g.Bt = p.wt_dn0; g.lda = DFF; g.K = DFF; g.nN = 8; g.tm0 = 0; g.nM = 65;
    g.d0 = p.Y; g.ld0 = DM;
    phase_gemm<EPI_F32>(g, smem);
  } PHASE_END

  PHASE_BEGIN(9)
    phase_rows<true, true>(p, 0, MT, p.xctx, p.out, p.xctx, p.out, (const u16*)p.Y, mod0, 5, p.norm_post + DM, mod1, 0, p.norm_pre + 2 * DM, p.H);
  PHASE_END

  u16* U1 = p.big;
  u16* QKV1 = p.big + (size_t)MT * 512;
  u16* Z = p.big + (size_t)MT * 2048;

  PHASE_BEGIN(10) {
    GemmDesc g{}; g.A = p.H; g.Bt = p.wt_in1; g.lda = DM; g.K = DM; g.nN = 16; g.tm0 = 0; g.nM = 65;
    g.d0 = U1; g.ld0 = 512; g.d1 = QKV1; g.ld1 = 1536; g.split = 512;
    phase_gemm<EPI_SPLIT>(g, smem);
  } PHASE_END

  PHASE_BEGIN(11) {
    for (int rep = 0; rep < REP_O; ++rep) {
    qk_prep(QKV1, 1536, 0, 8, Qb, nullptr, 0.125f * LOG2E, CTXN);
    qk_prep(QKV1, 1536, 512, 8, Kb, nullptr, 1.f, 0);
    v_transpose(QKV1, 1536, 1024, 512, Vt, smem);
    }
    for (int t0 = blockIdx.x; t0 < 16 * NCHUNK * REP_S; t0 += gridDim.x) { const int t = t0 % (16 * NCHUNK); s5_task<false>(p, smem, t & 15, t >> 4, U1, Z); }
  } PHASE_END

  PHASE_BEGIN(12) {
    s5_carry(p);
    float lam;
    {
      const int lane = threadIdx.x & 63;
      float s1 = wsum(p.lam_q1[lane] * p.lam_k1[lane]);
      float s2 = wsum(p.lam_q2[lane] * p.lam_k2[lane]);
      lam = expf(s1) - expf(s2) + 0.35550906759f;
    }
    const int w = threadIdx.x >> 6;
    for (int t0 = blockIdx.x; t0 < 4 * 256 * REP_A; t0 += gridDim.x) {
      const int t = t0 & 1023;
      const int head = t & 3, q0 = CTXN + (t >> 2) * 64;
      attn_task<128, 2>(smem, Qb, Kb, Vt, head * 2 + (w & 1), w & 1, q0 + 32 * (w >> 1), head * 2, head, NCHUNK, A2, 512 + head * 128,
                        lam, 0.35550906759f, p.subln);
    }
  } PHASE_END

  PHASE_BEGIN(13) {
    for (int t0 = blockIdx.x; t0 < 16 * (NCHUNK - 4) * REP_S; t0 += gridDim.x) { const int t = t0 % (16 * (NCHUNK - 4)); s5_task<true>(p, smem, t & 15, 4 + (t >> 4), U1, Z); }
  } PHASE_END

  PHASE_BEGIN(14) {
    GemmDesc g{}; g.A = Z; g.Bt = p.wt_glu; g.lda = 512; g.K = 512; g.nN = 8; g.tm0 = 1; g.nM = 64;
    g.d0 = A2; g.ld0 = DM;
    phase_gemm<EPI_GLU>(g, smem);
  } PHASE_END

  PHASE_BEGIN(15) {
    GemmDesc g{}; g.A = A2; g.Bt = p.wt_out1; g.lda = DM; g.K = DM; g.nN = 8; g.tm0 = 1; g.nM = 64;
    g.d0 = p.Y; g.ld0 = DM;
    phase_gemm<EPI_F32>(g, smem);
  } PHASE_END

  PHASE_BEGIN(16)
    phase_rows<true, true>(p, CTXN, MT, p.xctx, p.out, p.xctx, p.out, (const u16*)p.Y, mod1, 2, p.norm_post + 2 * DM, mod1, 3, p.norm_pre + 3 * DM, p.H);
  PHASE_END

  PHASE_BEGIN(17) {
    GemmDesc g{}; g.A = p.H; g.Bt = p.wt_up1; g.lda = DM; g.K = DM; g.nN = 44; g.tm0 = 2; g.nM = 65;
    g.d0 = p.big; g.cw = p.ffn_conv_w + 3 * 2 * DFF; g.cb = p.ffn_conv_b + 2 * DFF; g.zrow = (const u16*)(p.bar + 1536);
    phase_gemm<EPI_FFNUP>(g, smem);
  } PHASE_END

  PHASE_BEGIN(18) {
    GemmDesc g{}; g.A = p.big; g.Bt = p.wt_dn1; g.lda = DFF; g.K = DFF; g.nN = 8; g.tm0 = 1; g.nM = 64;
    g.d0 = p.Y; g.ld0 = DM;
    phase_gemm<EPI_F32>(g, smem);
  } PHASE_END

  PHASE_BEGIN(19)
    phase_rows<true, false>(p, CTXN, MT, p.xctx, p.out, p.xctx, p.out, (const u16*)p.Y, mod1, 5, p.norm_post + 3 * DM, nullptr, 0, nullptr, nullptr);
  PHASE_END
}

extern "C" void kernel_launch(void* const* d_in, const int* in_sizes, int n_in, void* d_out, int out_size, void* d_ws,
                              size_t ws_size, hipStream_t stream) {
  static int grid_blocks = 0;
  if (!grid_blocks) {
    hipFuncSetAttribute((const void*)fwd_megakernel, hipFuncAttributeMaxDynamicSharedMemorySize, LDS_BYTES);
    int dev = 0, cus = 0, per_cu = 0;
    hipGetDevice(&dev);
    hipDeviceGetAttribute(&cus, hipDeviceAttributeMultiprocessorCount, dev);
    hipOccupancyMaxActiveBlocksPerMultiprocessor(&per_cu, fwd_megakernel, 256, LDS_BYTES);
    if (per_cu > 2) per_cu = 2;
    grid_blocks = cus * per_cu;
  }
  Params p{};
  const float* const* in = (const float* const*)d_in;
  p.x = in[0]; p.c = in[1]; p.ctx = in[2]; p.c_ctx = in[3]; p.mod_w = in[4]; p.mod_b = in[5]; p.norm_pre = in[6]; p.norm_post = in[7];
  p.ffn_w_up = in[8]; p.ffn_conv_w = in[9]; p.ffn_conv_b = in[10]; p.ffn_w_down = in[11];
  p.ev_w_in = in[12]; p.ev_conv_w = in[13]; p.ev_q_norm = in[14]; p.ev_k_norm = in[15]; p.ev_w_out = in[16];
  p.od_w_in = in[17]; p.a_re = in[18]; p.a_im = in[19]; p.log_dt = in[20]; p.b_re = in[21]; p.b_im = in[22]; p.c_re = in[23]; p.c_im = in[24];
  p.d_skip = in[25]; p.glu_w = in[26]; p.lam_q1 = in[27]; p.lam_k1 = in[28]; p.lam_q2 = in[29]; p.lam_k2 = in[30]; p.subln = in[31]; p.od_w_out = in[32];
  p.out = (float*)d_out;
  char* ws = (char*)d_ws;
  size_t off = 0;
  auto take = [&](size_t bytes) { char* r = ws + off; off += (bytes + 255) & ~(size_t)255; return r; };
  p.wt_in0 = (u16*)take((size_t)2304 * 1024 * 2);
  p.wt_out0 = (u16*)take((size_t)1024 * 1024 * 2);
  p.wt_up0 = (u16*)take((size_t)2 * DFF * 1024 * 2);
  p.wt_dn0 = (u16*)take((size_t)1024 * DFF * 2);
  p.wt_in1 = (u16*)take((size_t)2048 * 1024 * 2);
  p.wt_glu = (u16*)take((size_t)1024 * 512 * 2);
  p.wt_out1 = (u16*)take((size_t)1024 * 1024 * 2);
  p.wt_up1 = (u16*)take((size_t)2 * DFF * 1024 * 2);
  p.wt_dn1 = (u16*)take((size_t)1024 * DFF * 2);
  p.mod = (float*)take((size_t)2 * 2 * 6 * DM * 4);
  p.xctx = (float*)take((size_t)CTXN * DM * 4);
  p.s5s = (float*)take((size_t)2 * 32 * NCHUNK * 64 * 8);
  p.H = (u16*)take((size_t)MT * DM * 2);
  p.Y = (float*)take((size_t)MT * DM * 4);
  p.big = (u16*)take((size_t)MT * DFF * 2);
  p.bar = (unsigned*)take(8192);
  p.ph_lo = 0; p.ph_hi = 20;
  if (off > ws_size) { fprintf(stderr, "workspace too small: need %zu have %zu\n", off, ws_size); }
  (void)hipMemsetAsync(p.bar, 0, 8192, stream);
  void* args[] = {&p};
  hipError_t e = hipLaunchCooperativeKernel((const void*)fwd_megakernel, dim3(grid_blocks), dim3(256), args, LDS_BYTES, stream);
  if (e != hipSuccess) fprintf(stderr, "cooperative launch failed: %s (grid %d)\n", hipGetErrorString(e), grid_blocks);
}
```

```cpp
#include <hip/hip_runtime.h>
#include <hip/hip_cooperative_groups.h>
#include <stdint.h>
#include <stdio.h>
namespace cg = cooperative_groups;

#define DI __device__ __forceinline__
typedef unsigned short u16;
typedef short bf16x8 __attribute__((ext_vector_type(8)));
typedef float f32x16 __attribute__((ext_vector_type(16)));
typedef float f32x4 __attribute__((ext_vector_type(4)));
typedef __bf16 bf2_t __attribute__((ext_vector_type(2)));
typedef float f2_t __attribute__((ext_vector_type(2)));

constexpr int DM = 1024;
constexpr int LSEQ = 16384;
constexpr int CTXN = 256;
constexpr int MT = LSEQ + CTXN;
constexpr int DFF = 2816;
constexpr int NCHUNK = MT / 64;
constexpr int LDS_BYTES = 77824;
#ifndef REP_A
#define REP_A 1
#endif
#ifndef REP_G
#define REP_G 1
#endif
#ifndef REP_O
#define REP_O 1
#endif
#ifndef REP_P
#define REP_P 1
#endif
#ifndef KREP
#define KREP 1
#endif
#ifndef REP_S
#define REP_S 1
#endif
constexpr float LOG2E = 1.4426950408889634f;

DI unsigned pk2(float a, float b) { f2_t v = {a, b}; bf2_t r = __builtin_convertvector(v, bf2_t); return __builtin_bit_cast(unsigned, r); }
DI u16 f2bf(float a) { return (u16)(pk2(a, 0.f) & 0xffffu); }
DI float bflo(unsigned v) { return __uint_as_float(v << 16); }
DI float bfhi(unsigned v) { return __uint_as_float(v & 0xffff0000u); }
DI float bf2f(u16 v) { return __uint_as_float(((unsigned)v) << 16); }
DI size_t tidx(int col, int row, int nrows) { return ((size_t)(col >> 5) * nrows + row) * 32 + (col & 31); }
DI int crow(int i, int h) { return (i & 3) + 8 * (i >> 2) + 4 * h; }
DI float wsum(float v) {
  v += __shfl_xor(v, 32); v += __shfl_xor(v, 16); v += __shfl_xor(v, 8);
  v += __shfl_xor(v, 4); v += __shfl_xor(v, 2); v += __shfl_xor(v, 1); return v;
}
DI float hsum32(float v) {
  v += __shfl_xor(v, 16); v += __shfl_xor(v, 8); v += __shfl_xor(v, 4); v += __shfl_xor(v, 2); v += __shfl_xor(v, 1); return v;
}
DI float silu_f(float x) { return x / (1.f + __expf(-x)); }
DI float sigmoid_f(float x) { return 1.f / (1.f + __expf(-x)); }
DI float gelu_tanh(float x) {
  float a = 0.7978845608028654f * (x + 0.044715f * x * x * x);
  float t = 1.f - 2.f / (__expf(2.f * a) + 1.f);
  return 0.5f * x * (1.f + t);
}
#define MFMA32(a, b, c) __builtin_amdgcn_mfma_f32_32x32x16_bf16((a), (b), (c), 0, 0, 0)
#define MFMA16(a, b, c) __builtin_amdgcn_mfma_f32_16x16x32_bf16((a), (b), (c), 0, 0, 0)

struct Params {
  const float *x, *c, *ctx, *c_ctx, *mod_w, *mod_b, *norm_pre, *norm_post, *ffn_w_up, *ffn_conv_w, *ffn_conv_b, *ffn_w_down;
  const float *ev_w_in, *ev_conv_w, *ev_q_norm, *ev_k_norm, *ev_w_out;
  const float *od_w_in, *a_re, *a_im, *log_dt, *b_re, *b_im, *c_re, *c_im, *d_skip, *glu_w;
  const float *lam_q1, *lam_k1, *lam_q2, *lam_k2, *subln, *od_w_out;
  float* out;
  u16 *wt_in0, *wt_out0, *wt_up0, *wt_dn0, *wt_in1, *wt_glu, *wt_out1, *wt_up1, *wt_dn1;
  float* mod;
  float* xctx;
  float* s5s;
  u16* H;
  float* Y;
  u16* big;
  unsigned* bar;
  int ph_lo, ph_hi;
};

DI int perm_row(int kind, int n) {
  if (kind == 1) {
    if (n < DFF) return (n >> 6) * 128 + (n & 63);
    int m = n - DFF; return (m >> 6) * 128 + 64 + (m & 63);
  } else if (kind == 2) {
    if (n < 512) return (n >> 5) * 64 + (n & 31);
    int m = n - 512; return (m >> 5) * 64 + 32 + (m & 31);
  }
  return n;
}

DI void transpose_tile(const float* __restrict__ W, int K, int N, u16* __restrict__ Wt, int kind, int tile, float* sm) {
  const int nN = N >> 6;
  const int k0 = (tile / nN) * 64, n0 = (tile % nN) * 64;
  const int tid = threadIdx.x;
  for (int r = tid >> 6; r < 64; r += 4) sm[r * 65 + (tid & 63)] = W[(size_t)(k0 + r) * N + n0 + (tid & 63)];
  __syncthreads();
  const int kk = (tid & 31) * 2;
  for (int n = tid >> 5; n < 64; n += 8) {
    unsigned v = pk2(sm[kk * 65 + n], sm[(kk + 1) * 65 + n]);
    *(unsigned*)(Wt + tidx(k0 + kk, perm_row(kind, n0 + n), N)) = v;
  }
  __syncthreads();
}

DI void phase_prep_weights(const Params& p, char* smem) {
  float* sm = (float*)smem;
  const float* srcs[9] = {p.ev_w_in, p.ev_w_out, p.ffn_w_up, p.ffn_w_down, p.od_w_in, p.glu_w, p.od_w_out,
                          p.ffn_w_up + (size_t)DM * 2 * DFF, p.ffn_w_down + (size_t)DFF * DM};
  u16* dsts[9] = {p.wt_in0, p.wt_out0, p.wt_up0, p.wt_dn0, p.wt_in1, p.wt_glu, p.wt_out1, p.wt_up1, p.wt_dn1};
  const int Ks[9] = {1024, 1024, 1024, DFF, 1024, 512, 1024, 1024, DFF};
  const int Ns[9] = {2304, 1024, 2 * DFF, 1024, 2048, 1024, 1024, 2 * DFF, 1024};
  const int kinds[9] = {0, 0, 1, 0, 0, 2, 0, 1, 0};
  int total = 0;
#pragma unroll
  for (int i = 0; i < 9; ++i) total += (Ks[i] >> 6) * (Ns[i] >> 6);
  const int NMOD = 192;
  for (int t = blockIdx.x; t < NMOD + total; t += gridDim.x) {
    if (t < NMOD) {
      const int layer = t / 96, cgp = t % 96;
      const int tid = threadIdx.x, col = cgp * 64 + (tid & 63), kq = tid >> 6;
      const float* W = p.mod_w + (size_t)layer * DM * 6 * DM;
      float* ssc = sm + 1024;
      for (int k = tid; k < DM; k += 256) { ssc[k] = silu_f(p.c[k]); ssc[DM + k] = silu_f(p.c_ctx[k]); }
      __syncthreads();
      float a0 = 0.f, a1 = 0.f;
      const float* wp = W + (size_t)(kq * 256) * (6 * DM) + col;
#pragma unroll 8
      for (int k = 0; k < 256; ++k) {
        const float w = wp[(size_t)k * (6 * DM)];
        a0 += ssc[kq * 256 + k] * w;
        a1 += ssc[DM + kq * 256 + k] * w;
      }
      sm[(kq * 64 + (tid & 63)) * 2] = a0;
      sm[(kq * 64 + (tid & 63)) * 2 + 1] = a1;
      __syncthreads();
      if (tid < 128) {
        int cc = tid & 63, which = tid >> 6;
        float s = 0.f;
        for (int q = 0; q < 4; ++q) s += sm[(q * 64 + cc) * 2 + which];
        int colo = cgp * 64 + cc;
        p.mod[(size_t)(layer * 2 + which) * 6 * DM + colo] = s + p.mod_b[layer * 6 * DM + colo];
      }
      __syncthreads();
    } else {
      int tt = t - NMOD;
#pragma unroll
      for (int i = 0; i < 9; ++i) {
        int cnt = (Ks[i] >> 6) * (Ns[i] >> 6);
        if (tt >= 0 && tt < cnt) transpose_tile(srcs[i], Ks[i], Ns[i], dsts[i], kinds[i], tt, sm);
        tt -= cnt;
      }
    }
  }
}

template <bool HAS_Y, bool HAS_H>
DI void phase_rows(const Params& p, int row0, int row1, const float* xin_ctx, const float* xin_lat,
                   float* xout_ctx, float* xout_lat, const u16* Y, const float* modl  ,
                   int gate_idx, const float* gpost, const float* modh  , int shift_idx,
                   const float* gpre, u16* Hout) {
  const int lane = threadIdx.x & 63;
  const int wid = blockIdx.x * 4 + (threadIdx.x >> 6), nw = gridDim.x * 4;
#pragma unroll 1
  for (int pass = 0; pass < 2; ++pass) {
    const bool isc = pass == 0;
    const int ra = isc ? row0 : max(row0, CTXN);
    const int rb = isc ? min(row1, CTXN) : row1;
    if (ra + wid >= rb) continue;
    float4 va[4], vb[4], vc[4];
#pragma unroll
    for (int j = 0; j < 4; ++j) {
      const int c = j * 256 + lane * 4;
      if (HAS_Y) {
        float4 g = *(const float4*)(gpost + c);
        float4 gg = *(const float4*)(modl + (size_t)(isc ? 6 : 0) * DM + gate_idx * DM + c);
        va[j] = make_float4(g.x * gg.x, g.y * gg.y, g.z * gg.z, g.w * gg.w);
      }
      if (HAS_H) {
        const float* sh = modh + (size_t)(isc ? 6 : 0) * DM + shift_idx * DM;
        float4 g = *(const float4*)(gpre + c);
        float4 s1 = *(const float4*)(sh + c);
        float4 s2 = *(const float4*)(sh + DM + c);
        vb[j] = make_float4(g.x * (1.f + s2.x), g.y * (1.f + s2.y), g.z * (1.f + s2.z), g.w * (1.f + s2.w));
        vc[j] = s1;
      }
    }
    const float* xin = isc ? xin_ctx : xin_lat - (size_t)CTXN * DM;
    float* xout = isc ? xout_ctx : xout_lat - (size_t)CTXN * DM;
#pragma unroll 1
    for (int row = ra + wid; row < rb; row += 2 * nw) {
      const int rowB = row + nw;
      const bool hasB = rowB < rb;
      const int rB = hasB ? rowB : row;
      float4 xa[4], xb[4], ya[4], yb[4];
#pragma unroll
      for (int j = 0; j < 4; ++j) {
        xa[j] = *(const float4*)(xin + (size_t)row * DM + j * 256 + lane * 4);
        xb[j] = *(const float4*)(xin + (size_t)rB * DM + j * 256 + lane * 4);
        if (HAS_Y) {
          const uint2 ua = *(const uint2*)(Y + (size_t)row * DM + j * 256 + lane * 4);
          const uint2 ub = *(const uint2*)(Y + (size_t)rB * DM + j * 256 + lane * 4);
          ya[j] = make_float4(bflo(ua.x), bfhi(ua.x), bflo(ua.y), bfhi(ua.y));
          yb[j] = make_float4(bflo(ub.x), bfhi(ub.x), bflo(ub.y), bfhi(ub.y));
        }
      }
      if (HAS_Y) {
        float sa = 0.f, sb2 = 0.f;
#pragma unroll
        for (int j = 0; j < 4; ++j) {
          sa += ya[j].x * ya[j].x + ya[j].y * ya[j].y + ya[j].z * ya[j].z + ya[j].w * ya[j].w;
          sb2 += yb[j].x * yb[j].x + yb[j].y * yb[j].y + yb[j].z * yb[j].z + yb[j].w * yb[j].w;
        }
        sa = wsum(sa); sb2 = wsum(sb2);
        const float ia = rsqrtf(sa * (1.f / DM) + 1e-6f), ib = rsqrtf(sb2 * (1.f / DM) + 1e-6f);
#pragma unroll
        for (int j = 0; j < 4; ++j) {
          xa[j].x += va[j].x * (ya[j].x * ia); xa[j].y += va[j].y * (ya[j].y * ia); xa[j].z += va[j].z * (ya[j].z * ia); xa[j].w += va[j].w * (ya[j].w * ia);
          xb[j].x += va[j].x * (yb[j].x * ib); xb[j].y += va[j].y * (yb[j].y * ib); xb[j].z += va[j].z * (yb[j].z * ib); xb[j].w += va[j].w * (yb[j].w * ib);
          *(float4*)(xout + (size_t)row * DM + j * 256 + lane * 4) = xa[j];
          if (hasB) *(float4*)(xout + (size_t)rowB * DM + j * 256 + lane * 4) = xb[j];
        }
      }
      if (HAS_H) {
        float sa = 0.f, sb2 = 0.f;
#pragma unroll
        for (int j = 0; j < 4; ++j) {
          sa += xa[j].x * xa[j].x + xa[j].y * xa[j].y + xa[j].z * xa[j].z + xa[j].w * xa[j].w;
          sb2 += xb[j].x * xb[j].x + xb[j].y * xb[j].y + xb[j].z * xb[j].z + xb[j].w * xb[j].w;
        }
        sa = wsum(sa); sb2 = wsum(sb2);
        const float ia = rsqrtf(sa * (1.f / DM) + 1e-6f), ib = rsqrtf(sb2 * (1.f / DM) + 1e-6f);
#pragma unroll
        for (int j = 0; j < 4; ++j) {
          uint2 o;
          o.x = pk2(xa[j].x * ia * vb[j].x + vc[j].x, xa[j].y * ia * vb[j].y + vc[j].y);
          o.y = pk2(xa[j].z * ia * vb[j].z + vc[j].z, xa[j].w * ia * vb[j].w + vc[j].w);
          *(uint2*)(Hout + tidx(j * 256 + lane * 4, row, MT)) = o;
          if (hasB) {
            o.x = pk2(xb[j].x * ib * vb[j].x + vc[j].x, xb[j].y * ib * vb[j].y + vc[j].y);
            o.y = pk2(xb[j].z * ib * vb[j].z + vc[j].z, xb[j].w * ib * vb[j].w + vc[j].w);
            *(uint2*)(Hout + tidx(j * 256 + lane * 4, rowB, MT)) = o;
          }
        }
      }
    }
  }
}

enum { EPI_SPLIT = 0, EPI_F32 = 1, EPI_GLU = 2, EPI_FFNUP = 3 };
struct GemmDesc {
  const u16* A; const u16* Bt; int lda; int K; int nN; int tm0; int nM;
  void* d0; void* d1; int ld0; int ld1; int split;
  const float* cw; const float* cb;
  const u16* zrow;
};

template <int MODE>
DI void gemm_tile(const GemmDesc& g, char* smem, int tmi, int tn) {
  const int tid = threadIdx.x, lane = tid & 63, w = tid >> 6, h = lane >> 5, l31 = lane & 31;
  const int wm = w >> 1, wn = w & 1;
  constexpr int ASZ = 256 * 64, BSZ = 128 * 64, STG = ASZ + BSZ;
  int seq_base = 0, seq_len = MT, vrow0 = tmi * 256;
  if (MODE == EPI_FFNUP) {
    if (tmi < 2) { seq_base = 0; seq_len = CTXN; vrow0 = 254 * tmi - 1; }
    else { seq_base = CTXN; seq_len = LSEQ; vrow0 = 254 * (tmi - 2) - 1; }
  }
  const int gkc = ((tid & 3) ^ ((tid >> 4) & 3)) * 8;
  const u16* arow[4];
  int astr[4];
#pragma unroll
  for (int j = 0; j < 4; ++j) {
    const int r = (tid >> 2) + 64 * j;
    if (MODE == EPI_FFNUP) {
      const int v = vrow0 + r;
      const bool ok = (v >= 0 && v < seq_len);
      arow[j] = ok ? g.A + (size_t)(seq_base + v) * 32 + gkc : g.zrow + gkc;
      astr[j] = ok ? MT * 32 : 0;
    } else {
      arow[j] = g.A + (size_t)(vrow0 + r) * 32 + gkc;
      astr[j] = MT * 32;
    }
  }
  const u16* brow[2];
#pragma unroll
  for (int j = 0; j < 2; ++j) brow[j] = g.Bt + (size_t)(tn * 128 + (tid >> 2) + 64 * j) * 32 + gkc;
  const int bstr = g.nN * 128 * 32;
  f32x16 acc[4][2];
#pragma unroll
  for (int a = 0; a < 4; ++a)
#pragma unroll
    for (int b = 0; b < 2; ++b)
#pragma unroll
      for (int i = 0; i < 16; ++i) acc[a][b][i] = 0.f;

  const int nk0 = g.K >> 5;
  const int nk = nk0 * KREP;
  char* dma_dst = smem + (w * 64) * 16;
#define G_DMA(kt_, stg) { char* d_ = dma_dst + (stg) * STG; const int kq_ = (KREP == 1) ? (kt_) : ((kt_) % nk0); \
    __builtin_amdgcn_global_load_lds((const unsigned*)(arow[0] + (size_t)(kq_) * astr[0]), (unsigned*)(d_), 16, 0, 0); \
    __builtin_amdgcn_global_load_lds((const unsigned*)(arow[1] + (size_t)(kq_) * astr[1]), (unsigned*)(d_ + 4096), 16, 0, 0); \
    __builtin_amdgcn_global_load_lds((const unsigned*)(arow[2] + (size_t)(kq_) * astr[2]), (unsigned*)(d_ + 8192), 16, 0, 0); \
    __builtin_amdgcn_global_load_lds((const unsigned*)(arow[3] + (size_t)(kq_) * astr[3]), (unsigned*)(d_ + 12288), 16, 0, 0); \
    __builtin_amdgcn_global_load_lds((const unsigned*)(brow[0] + (size_t)(kq_) * bstr), (unsigned*)(d_ + ASZ), 16, 0, 0); \
    __builtin_amdgcn_global_load_lds((const unsigned*)(brow[1] + (size_t)(kq_) * bstr), (unsigned*)(d_ + ASZ + 4096), 16, 0, 0); }
  const int sw = (l31 >> 2) & 3;
  const int aoff0 = (wm * 128 + l31) * 64 + ((h ^ sw) * 16);
  const int aoff1 = (wm * 128 + l31) * 64 + (((2 + h) ^ sw) * 16);
  const int boff0 = ASZ + (wn * 64 + l31) * 64 + ((h ^ sw) * 16);
  const int boff1 = ASZ + (wn * 64 + l31) * 64 + (((2 + h) ^ sw) * 16);
#define G_COMPUTE(stg) { const char* sb_ = smem + (stg) * STG; \
    _Pragma("unroll") for (int ks = 0; ks < 2; ++ks) { \
      bf16x8 af[4], bf[2]; \
      _Pragma("unroll") for (int mi = 0; mi < 4; ++mi) af[mi] = *(const bf16x8*)(sb_ + (ks ? aoff1 : aoff0) + mi * 32 * 64); \
      _Pragma("unroll") for (int ni = 0; ni < 2; ++ni) bf[ni] = *(const bf16x8*)(sb_ + (ks ? boff1 : boff0) + ni * 32 * 64); \
      _Pragma("unroll") for (int mi = 0; mi < 4; ++mi) \
        _Pragma("unroll") for (int ni = 0; ni < 2; ++ni) acc[mi][ni] = MFMA32(af[mi], bf[ni], acc[mi][ni]); \
    } }
#define RAW_BARRIER() { asm volatile("s_waitcnt lgkmcnt(0)" ::: "memory"); __builtin_amdgcn_s_barrier(); }
  G_DMA(0, 0);
  G_DMA(1, 1);
  int stg = 0;
#define SB_ __builtin_amdgcn_sched_barrier(0)
#define DMA1(ptr, off) __builtin_amdgcn_global_load_lds((const unsigned*)(ptr), (unsigned*)(d_ + (off)), 16, 0, 0)
  for (int kt = 0; kt < nk - 1; ++kt) {
    asm volatile("s_waitcnt vmcnt(6)" ::: "memory");
    RAW_BARRIER();
    const int s2 = (stg == 0) ? 2 : stg - 1;
    const int kn_ = (kt + 2 < nk) ? kt + 2 : nk - 1;
    const int kq_ = (KREP == 1) ? kn_ : (kn_ % nk0);
    char* d_ = dma_dst + s2 * STG;
    const char* sb_ = smem + stg * STG;
    bf16x8 af0[4], bf0[2], af1[4], bf1[2];
#pragma unroll
    for (int mi = 0; mi < 4; ++mi) af0[mi] = *(const bf16x8*)(sb_ + aoff0 + mi * 32 * 64);
#pragma unroll
    for (int ni = 0; ni < 2; ++ni) bf0[ni] = *(const bf16x8*)(sb_ + boff0 + ni * 32 * 64);
#pragma unroll
    for (int mi = 0; mi < 4; ++mi) af1[mi] = *(const bf16x8*)(sb_ + aoff1 + mi * 32 * 64);
#pragma unroll
    for (int ni = 0; ni < 2; ++ni) bf1[ni] = *(const bf16x8*)(sb_ + boff1 + ni * 32 * 64);
    SB_;
    acc[0][0] = MFMA32(af0[0], bf0[0], acc[0][0]); acc[0][1] = MFMA32(af0[0], bf0[1], acc[0][1]); SB_;
    DMA1(arow[0] + (size_t)kq_ * astr[0], 0); SB_;
    acc[1][0] = MFMA32(af0[1], bf0[0], acc[1][0]); acc[1][1] = MFMA32(af0[1], bf0[1], acc[1][1]); SB_;
    DMA1(arow[1] + (size_t)kq_ * astr[1], 4096); SB_;
    acc[2][0] = MFMA32(af0[2], bf0[0], acc[2][0]); acc[2][1] = MFMA32(af0[2], bf0[1], acc[2][1]); SB_;
    DMA1(arow[2] + (size_t)kq_ * astr[2], 8192); SB_;
    acc[3][0] = MFMA32(af0[3], bf0[0], acc[3][0]); acc[3][1] = MFMA32(af0[3], bf0[1], acc[3][1]); SB_;
    DMA1(arow[3] + (size_t)kq_ * astr[3], 12288); SB_;
    acc[0][0] = MFMA32(af1[0], bf1[0], acc[0][0]); acc[0][1] = MFMA32(af1[0], bf1[1], acc[0][1]); SB_;
    DMA1(brow[0] + (size_t)kq_ * bstr, ASZ); SB_;
    acc[1][0] = MFMA32(af1[1], bf1[0], acc[1][0]); acc[1][1] = MFMA32(af1[1], bf1[1], acc[1][1]); SB_;
    DMA1(brow[1] + (size_t)kq_ * bstr, ASZ + 4096); SB_;
    acc[2][0] = MFMA32(af1[2], bf1[0], acc[2][0]); acc[2][1] = MFMA32(af1[2], bf1[1], acc[2][1]);
    acc[3][0] = MFMA32(af1[3], bf1[0], acc[3][0]); acc[3][1] = MFMA32(af1[3], bf1[1], acc[3][1]);
    stg = (stg == 2) ? 0 : stg + 1;
  }
  asm volatile("s_waitcnt vmcnt(0)" ::: "memory");
  RAW_BARRIER();
  G_COMPUTE(stg);
  __syncthreads();
  if (KREP == 2) {
#pragma unroll
    for (int a = 0; a < 4; ++a)
#pragma unroll
      for (int b = 0; b < 2; ++b)
#pragma unroll
        for (int i = 0; i < 16; ++i) acc[a][b][i] *= 0.5f;
  }
  const int rbase = tmi * 256 + wm * 128;
  const int cbase = tn * 128 + wn * 64;
  char* wl = smem + w * 19456;
  if (MODE == EPI_F32) {
    u16* dst = (u16*)g.d0;
    u16* lh = (u16*)wl;
#pragma unroll
    for (int mi = 0; mi < 4; ++mi) {
#pragma unroll
      for (int ni = 0; ni < 2; ++ni)
#pragma unroll
        for (int i = 0; i < 16; ++i) lh[crow(i, h) * 72 + ni * 32 + l31] = f2bf(acc[mi][ni][i]);
#pragma unroll
      for (int it = 0; it < 4; ++it) {
        const int r = it * 8 + (lane >> 3), c8 = (lane & 7) * 8;
        uint4 v = *(const uint4*)(lh + r * 72 + c8);
        *(uint4*)(dst + (size_t)(rbase + mi * 32 + r) * g.ld0 + cbase + c8) = v;
      }
    }
  } else if (MODE == EPI_SPLIT) {
    u16* dst; int ld, cc;
    if (cbase < g.split) { dst = (u16*)g.d0; ld = g.ld0; cc = cbase; } else { dst = (u16*)g.d1; ld = g.ld1; cc = cbase - g.split; }
    u16* lh = (u16*)wl;
#pragma unroll
    for (int mi = 0; mi < 4; ++mi) {
#pragma unroll
      for (int ni = 0; ni < 2; ++ni)
#pragma unroll
        for (int i = 0; i < 16; ++i) lh[crow(i, h) * 72 + ni * 32 + l31] = f2bf(acc[mi][ni][i]);
#pragma unroll
      for (int it = 0; it < 4; ++it) {
        const int r = it * 8 + (lane >> 3), c8 = (lane & 7) * 8;
        uint4 v = *(const uint4*)(lh + r * 72 + c8);
        *(uint4*)(dst + (size_t)(rbase + mi * 32 + r) * ld + cc + c8) = v;
      }
    }
  } else if (MODE == EPI_GLU) {
    u16* dst = (u16*)g.d0;
    const int col0 = (tn * 2 + wn) * 32;
    u16* lh = (u16*)wl;
#pragma unroll
    for (int mi = 0; mi < 4; ++mi) {
#pragma unroll
      for (int i = 0; i < 16; ++i) lh[crow(i, h) * 40 + l31] = f2bf(acc[mi][0][i] * sigmoid_f(acc[mi][1][i]));
#pragma unroll
      for (int it = 0; it < 2; ++it) {
        const int r = it * 16 + (lane >> 2), c8 = (lane & 3) * 8;
        uint4 v = *(const uint4*)(lh + r * 40 + c8);
        *(uint4*)(dst + tidx(col0 + c8, rbase + mi * 32 + r, MT)) = v;
      }
    }
  } else {
    u16* T = (u16*)smem;
#pragma unroll
    for (int mi = 0; mi < 4; ++mi)
#pragma unroll
      for (int ni = 0; ni < 2; ++ni)
#pragma unroll
        for (int i = 0; i < 16; ++i)
          T[(wm * 128 + mi * 32 + crow(i, h)) * 136 + wn * 64 + ni * 32 + l31] = f2bf(acc[mi][ni][i]);
    __syncthreads();
    {
      const int cg8 = (tid & 7) * 8, r0 = (tid >> 3) * 8;
      const int fa = tn * 64 + cg8, fg = DFF + fa;
      float wa[3][8], wg[3][8], ba[8], bg[8];
#pragma unroll
      for (int q = 0; q < 3; ++q)
#pragma unroll
        for (int e = 0; e < 8; e += 4) {
          float4 x = *(const float4*)(g.cw + q * 2 * DFF + fa + e); wa[q][e] = x.x; wa[q][e + 1] = x.y; wa[q][e + 2] = x.z; wa[q][e + 3] = x.w;
          float4 y = *(const float4*)(g.cw + q * 2 * DFF + fg + e); wg[q][e] = y.x; wg[q][e + 1] = y.y; wg[q][e + 2] = y.z; wg[q][e + 3] = y.w;
        }
#pragma unroll
      for (int e = 0; e < 8; e += 4) {
        float4 x = *(const float4*)(g.cb + fa + e); ba[e] = x.x; ba[e + 1] = x.y; ba[e + 2] = x.z; ba[e + 3] = x.w;
        float4 y = *(const float4*)(g.cb + fg + e); bg[e] = y.x; bg[e + 1] = y.y; bg[e + 2] = y.z; bg[e + 3] = y.w;
      }
      float ap[8], ac[8], an[8], gp[8], gc[8], gn[8];
      auto ld8 = [&](int r, int coff, float* o) {
        uint4 v = *(const uint4*)(T + r * 136 + coff);
        o[0] = bflo(v.x); o[1] = bfhi(v.x); o[2] = bflo(v.y); o[3] = bfhi(v.y); o[4] = bflo(v.z); o[5] = bfhi(v.z); o[6] = bflo(v.w); o[7] = bfhi(v.w);
      };
      const int rm1 = (r0 > 0) ? r0 - 1 : 0;
      ld8(rm1, cg8, ap); ld8(rm1, 64 + cg8, gp);
      ld8(r0, cg8, ac); ld8(r0, 64 + cg8, gc);
      u16* dst = (u16*)g.d0;
#pragma unroll
      for (int rr = 0; rr < 8; ++rr) {
        const int r = r0 + rr;
        const int rn = (r < 255) ? r + 1 : 255;
        ld8(rn, cg8, an); ld8(rn, 64 + cg8, gn);
        const int v = vrow0 + r;
        if (r >= 1 && r <= 254 && v < seq_len) {
          float o[8];
#pragma unroll
          for (int e = 0; e < 8; ++e) {
            const float av = wa[0][e] * ap[e] + wa[1][e] * ac[e] + wa[2][e] * an[e] + ba[e];
            const float gv = wg[0][e] * gp[e] + wg[1][e] * gc[e] + wg[2][e] * gn[e] + bg[e];
            o[e] = av * silu_f(gv);
          }
          uint4 ov; ov.x = pk2(o[0], o[1]); ov.y = pk2(o[2], o[3]); ov.z = pk2(o[4], o[5]); ov.w = pk2(o[6], o[7]);
          *(uint4*)(dst + tidx(fa, seq_base + v, MT)) = ov;
        }
#pragma unroll
        for (int e = 0; e < 8; ++e) { ap[e] = ac[e]; ac[e] = an[e]; gp[e] = gc[e]; gc[e] = gn[e]; }
      }
    }
  }
  __syncthreads();
}

template <int MODE>
DI void phase_gemm(const GemmDesc& g, char* smem) {
  const int ntiles = g.nM * g.nN;
  const int per = gridDim.x >> 3;
  const int slot = (blockIdx.x & 7) * per + (blockIdx.x >> 3);
  for (int q0 = slot; q0 < ntiles * REP_G; q0 += gridDim.x) {
    const int q = q0 % ntiles;
    const int gm = q / (8 * g.nN);
    const int rows = min(8, g.nM - 8 * gm);
    const int ql = q - gm * 8 * g.nN;
    const int tn = ql / rows, tm = g.tm0 + gm * 8 + ql % rows;
    gemm_tile<MODE>(g, smem, tm, tn);
  }
}

DI void rope_angles(int row, int i, float& cs, float& sn) {
  const int pos = row - CTXN;
  const int rr = pos >> 6, cc = pos & 63;
  const int fi = i & 15;
  const float inv = exp2f(-(float)fi * (13.287712379549449f / 16.f));
  const float ang = (float)((i < 16) ? rr : cc) * inv;
  sincosf(ang, &sn, &cs);
}

DI void qk_prep(const u16* __restrict__ src, int lds, int coff, int nheads, u16* __restrict__ dst, const float* gnorm  ,
                float oscale, int row0) {
  const int lane = threadIdx.x & 63, hh = lane >> 5, i = lane & 31;
  const int wid = blockIdx.x * 4 + (threadIdx.x >> 6), nw = gridDim.x * 4;
  const int npair = nheads >> 1;
  const int nitems = (MT - row0) * npair;
  for (int it = wid; it < nitems; it += nw) {
    const int row = row0 + it / npair, head = (it % npair) * 2 + hh;
    unsigned v = *(const unsigned*)(src + (size_t)row * lds + coff + head * 64 + 2 * i);
    float e = bflo(v), o = bfhi(v);
    if (gnorm) {
      float ss = hsum32(e * e + o * o);
      float rinv = rsqrtf(ss * (1.f / 64.f) + 1e-6f);
      e = e * rinv * gnorm[2 * i]; o = o * rinv * gnorm[2 * i + 1];
    }
    if (row >= CTXN) {
      float cs, sn; rope_angles(row, i, cs, sn);
      float e2 = e * cs - o * sn, o2 = e * sn + o * cs;
      e = e2; o = o2;
    }
    *(unsigned*)(dst + ((size_t)head * MT + row) * 64 + 2 * i) = pk2(e * oscale, o * oscale);
  }
}

DI void v_transpose(const u16* __restrict__ src, int lds, int coff, int ncols, u16* __restrict__ dst, char* smem) {
  u16* sm = (u16*)smem;
  const int tid = threadIdx.x;
  const int ndt = ncols >> 6;
  const int ntasks = NCHUNK * ndt;
  for (int t = blockIdx.x; t < ntasks; t += gridDim.x) {
    const int tt = t / ndt, dt = t % ndt;
    {
      const int tok = tid >> 2, part = tid & 3;
      const u16* sp = src + (size_t)(tt * 64 + tok) * lds + coff + dt * 64 + part * 16;
      uint4 a = *(const uint4*)sp, b = *(const uint4*)(sp + 8);
      unsigned* d = (unsigned*)(sm + tok * 66 + part * 16);
      d[0] = a.x; d[1] = a.y; d[2] = a.z; d[3] = a.w; d[4] = b.x; d[5] = b.y; d[6] = b.z; d[7] = b.w;
    }
    __syncthreads();
    {
      const int d = tid >> 2, part = tid & 3;
      unsigned o[8];
#pragma unroll
      for (int j = 0; j < 8; ++j) {
        unsigned lo = sm[(part * 16 + 2 * j) * 66 + d], hi = sm[(part * 16 + 2 * j + 1) * 66 + d];
        o[j] = lo | (hi << 16);
      }
      u16* dp = dst + (size_t)(dt * 64 + d) * MT + tt * 64 + part * 16;
      *(uint4*)dp = make_uint4(o[0], o[1], o[2], o[3]);
      *(uint4*)(dp + 8) = make_uint4(o[4], o[5], o[6], o[7]);
    }
    __syncthreads();
  }
}

DI void gated_conv(const Params& p, const u16* __restrict__ G, u16* __restrict__ A2) {
  const int lane = threadIdx.x & 63;
  const int wid = blockIdx.x * 4 + (threadIdx.x >> 6), nw = gridDim.x * 4;
  const int nitems = MT * 4;
  for (int it = wid; it < nitems; it += nw) {
    const int row = it >> 2, c = ((it & 3) * 64 + lane) * 2;
    const bool first = (row == 0) || (row == CTXN), last = (row == CTXN - 1) || (row == MT - 1);
    const u16* gr = G + (size_t)row * 1536;
    unsigned gb = *(const unsigned*)(gr + c);
    unsigned c1 = *(const unsigned*)(gr + 512 + c), v1 = *(const unsigned*)(gr + 1024 + c);
    float m1a = bflo(c1) * bflo(v1), m1b = bfhi(c1) * bfhi(v1);
    float m0a = 0.f, m0b = 0.f, m2a = 0.f, m2b = 0.f;
    if (!first) {
      unsigned c0 = *(const unsigned*)(gr - 1536 + 512 + c), v0 = *(const unsigned*)(gr - 1536 + 1024 + c);
      m0a = bflo(c0) * bflo(v0); m0b = bfhi(c0) * bfhi(v0);
    }
    if (!last) {
      unsigned c2 = *(const unsigned*)(gr + 1536 + 512 + c), v2 = *(const unsigned*)(gr + 1536 + 1024 + c);
      m2a = bflo(c2) * bflo(v2); m2b = bfhi(c2) * bfhi(v2);
    }
    const float* cw = p.ev_conv_w;
    float ya = bflo(gb) * (cw[c] * m0a + cw[512 + c] * m1a + cw[1024 + c] * m2a);
    float yb = bfhi(gb) * (cw[c + 1] * m0b + cw[512 + c + 1] * m1b + cw[1024 + c + 1] * m2b);
    *(unsigned*)(A2 + tidx(c, row, MT)) = pk2(ya, yb);
  }
}

DI int kperm(int r) { return (r & 0x13) | ((r & 4) << 1) | ((r & 8) >> 1); }

template <int DV, int NCOMP>
DI void attn_task(char* smem, const u16* __restrict__ Qb, const u16* __restrict__ Kb, const u16* __restrict__ Vt,
                  int qh, int kslot, int q0w, int kh0, int vhead, int nkt, u16* __restrict__ A2, int ocol,
                  float lam, float lam_init, const float* __restrict__ subln) {
  const int tid = threadIdx.x, lane = tid & 63, w = tid >> 6, h = lane >> 5, l31 = lane & 31;
  constexpr int KT = 64 * 144;
  constexpr int STG = NCOMP * KT + DV * 144;
  constexpr int NDB = DV / 32;
  bf16x8 qf[4];
  {
    const u16* qp = Qb + ((size_t)qh * MT + q0w + l31) * 64 + h * 8;
#pragma unroll
    for (int ks = 0; ks < 4; ++ks) qf[ks] = *(const bf16x8*)(qp + ks * 16);
  }
  f32x16 O[NDB];
#pragma unroll
  for (int d = 0; d < NDB; ++d)
#pragma unroll
    for (int i = 0; i < 16; ++i) O[d][i] = 0.f;
  float m = 0.f, lsum = 0.f;
  f32x16 negm, Lacc;
#pragma unroll
  for (int i = 0; i < 16; ++i) { negm[i] = 0.f; Lacc[i] = 0.f; }
  bf16x8 ones;
  {
    const short ov = (l31 == 0) ? (short)0x3F80 : (short)0;
#pragma unroll
    for (int j = 0; j < 8; ++j) ones[j] = ov;
  }
  uint4 kr0, kr1, kr2, kr3, vr0, vr1, vr2, vr3;
  kr2 = kr3 = vr2 = vr3 = make_uint4(0, 0, 0, 0);
  const int skey = (tid & 511) >> 3, spart = tid & 7;
  const u16* kg = Kb + ((size_t)kh0 * MT + skey) * 64 + spart * 8;
  const u16* vg = Vt + ((size_t)vhead * DV + (tid >> 3)) * MT + spart * 8;
  const int ksl = skey * 144 + spart * 16;
  constexpr int vsl_off = NCOMP * KT;
#define vsl (ksl + vsl_off)
#define A_LOAD(kt) { \
    kr0 = *(const uint4*)(kg + (size_t)(kt) * 64 * 64); kr1 = *(const uint4*)(kg + (size_t)(kt) * 64 * 64 + 32 * 64); \
    if (NCOMP == 2) { kr2 = *(const uint4*)(kg + (size_t)MT * 64 + (size_t)(kt) * 64 * 64); kr3 = *(const uint4*)(kg + (size_t)MT * 64 + (size_t)(kt) * 64 * 64 + 32 * 64); } \
    vr0 = *(const uint4*)(vg + (kt) * 64); vr1 = *(const uint4*)(vg + (size_t)32 * MT + (kt) * 64); \
    if (DV == 128) { vr2 = *(const uint4*)(vg + (size_t)64 * MT + (kt) * 64); vr3 = *(const uint4*)(vg + (size_t)96 * MT + (kt) * 64); } }
#define A_WRITE(buf) { char* sb_ = smem + (buf) * STG; \
    *(uint4*)(sb_ + ksl) = kr0; *(uint4*)(sb_ + ksl + 32 * 144) = kr1; \
    if (NCOMP == 2) { *(uint4*)(sb_ + KT + ksl) = kr2; *(uint4*)(sb_ + KT + ksl + 32 * 144) = kr3; } \
    *(uint4*)(sb_ + vsl) = vr0; *(uint4*)(sb_ + vsl + 32 * 144) = vr1; \
    if (DV == 128) { *(uint4*)(sb_ + vsl + 64 * 144) = vr2; *(uint4*)(sb_ + vsl + 96 * 144) = vr3; } }
  A_LOAD(0); A_WRITE(0); __syncthreads();
  for (int kt = 0; kt < nkt; ++kt) {
    const int ktn = (kt + 1 < nkt) ? kt + 1 : kt;
    A_LOAD(ktn);
    __builtin_amdgcn_sched_barrier(0);
    const char* sb = smem + (kt & 1) * STG;
    const char* kp = sb + kslot * KT + kperm(l31) * 144 + h * 16;
    f32x16 S0, S1;
    {
      bf16x8 a0 = *(const bf16x8*)(kp);
      bf16x8 a1 = *(const bf16x8*)(kp + 32 * 144);
      S0 = MFMA32(a0, qf[0], negm); S1 = MFMA32(a1, qf[0], negm);
    }
#pragma unroll
    for (int ks = 1; ks < 4; ++ks) {
      bf16x8 a0 = *(const bf16x8*)(kp + ks * 32);
      bf16x8 a1 = *(const bf16x8*)(kp + 32 * 144 + ks * 32);
      S0 = MFMA32(a0, qf[ks], S0);
      S1 = MFMA32(a1, qf[ks], S1);
    }
    const char* vp = sb + NCOMP * KT + l31 * 144 + h * 16;
    bf16x8 vfr[NDB][4];
    if (NCOMP == 1) {
#pragma unroll
      for (int kk = 0; kk < 4; ++kk)
#pragma unroll
        for (int d = 0; d < NDB; ++d) vfr[d][kk] = *(const bf16x8*)(vp + d * 32 * 144 + kk * 32);
      __builtin_amdgcn_sched_barrier(0);
    }
    float mx = fmaxf(S0[0], S1[0]);
#pragma unroll
    for (int i = 1; i < 16; ++i) mx = fmaxf(mx, fmaxf(S0[i], S1[i]));
    mx = fmaxf(mx, __shfl_xor(mx, 32));
    const bool recentre = (kt == 0) || (mx > 8.f);
    if (__any(recentre)) {
      const float delta = recentre ? mx : 0.f;
      const float alpha = __builtin_amdgcn_exp2f(-delta);
      m += delta;
      lsum *= alpha;
#pragma unroll
      for (int i = 0; i < 16; ++i) { negm[i] = -m; S0[i] -= delta; S1[i] -= delta; }
      if (NCOMP == 1) Lacc[0] *= alpha;
#pragma unroll
      for (int d = 0; d < NDB; ++d)
#pragma unroll
        for (int i = 0; i < 16; ++i) O[d][i] *= alpha;
    }
    if (NCOMP == 1) {
#pragma unroll
      for (int i = 0; i < 16; ++i) { S0[i] = __builtin_amdgcn_exp2f(S0[i]); S1[i] = __builtin_amdgcn_exp2f(S1[i]); }
    } else {
      float ps = 0.f;
#pragma unroll
      for (int i = 0; i < 16; ++i) { S0[i] = __builtin_amdgcn_exp2f(S0[i]); ps += S0[i]; }
#pragma unroll
      for (int i = 0; i < 16; ++i) { S1[i] = __builtin_amdgcn_exp2f(S1[i]); ps += S1[i]; }
      lsum += ps;
    }
    bf16x8 pf[4];
#pragma unroll
    for (int s2 = 0; s2 < 2; ++s2) {
      uint4 a, b;
      a.x = pk2(S0[8 * s2], S0[8 * s2 + 1]); a.y = pk2(S0[8 * s2 + 2], S0[8 * s2 + 3]);
      a.z = pk2(S0[8 * s2 + 4], S0[8 * s2 + 5]); a.w = pk2(S0[8 * s2 + 6], S0[8 * s2 + 7]);
      b.x = pk2(S1[8 * s2], S1[8 * s2 + 1]); b.y = pk2(S1[8 * s2 + 2], S1[8 * s2 + 3]);
      b.z = pk2(S1[8 * s2 + 4], S1[8 * s2 + 5]); b.w = pk2(S1[8 * s2 + 6], S1[8 * s2 + 7]);
      pf[s2] = __builtin_bit_cast(bf16x8, a);
      pf[2 + s2] = __builtin_bit_cast(bf16x8, b);
    }
#pragma unroll
    for (int kk = 0; kk < 4; ++kk)
#pragma unroll
      for (int d = 0; d < NDB; ++d) {
        bf16x8 vf;
        if (NCOMP == 1) vf = vfr[d][kk]; else vf = *(const bf16x8*)(vp + d * 32 * 144 + kk * 32);
        O[d] = MFMA32(vf, pf[kk], O[d]);
      }
    if (NCOMP == 1) {
#pragma unroll
      for (int kk = 0; kk < 4; ++kk) Lacc = MFMA32(ones, pf[kk], Lacc);
    }
    A_WRITE((kt + 1) & 1);
    __syncthreads();
  }
  const float ltot = (NCOMP == 1) ? __shfl(Lacc[0], l31) : lsum + __shfl_xor(lsum, 32);
  const float inv = 1.f / ltot;
  const int row = q0w + l31;
  if (NCOMP == 1) {
#pragma unroll
    for (int d = 0; d < NDB; ++d)
#pragma unroll
      for (int q = 0; q < 4; ++q) {
        const int dd = d * 32 + 8 * q + 4 * h;
        uint2 v; v.x = pk2(O[d][4 * q] * inv, O[d][4 * q + 1] * inv); v.y = pk2(O[d][4 * q + 2] * inv, O[d][4 * q + 3] * inv);
        *(uint2*)(A2 + tidx(ocol + dd, row, MT)) = v;
      }
  } else {
    float* ox = (float*)smem;
    const int ql = (w >> 1) * 32 + l31;
    if (w & 1) {
#pragma unroll
      for (int d = 0; d < NDB; ++d)
#pragma unroll
        for (int q = 0; q < 4; ++q) {
          const int dd = d * 32 + 8 * q + 4 * h;
          float4 v = make_float4(O[d][4 * q] * inv, O[d][4 * q + 1] * inv, O[d][4 * q + 2] * inv, O[d][4 * q + 3] * inv);
          *(float4*)(ox + ql * 132 + dd) = v;
        }
    }
    __syncthreads();
    if (!(w & 1)) {
      float ss = 0.f;
#pragma unroll
      for (int d = 0; d < NDB; ++d)
#pragma unroll
        for (int q = 0; q < 4; ++q) {
          const int dd = d * 32 + 8 * q + 4 * h;
          float4 o2 = *(const float4*)(ox + ql * 132 + dd);
          O[d][4 * q] = O[d][4 * q] * inv - lam * o2.x;
          O[d][4 * q + 1] = O[d][4 * q + 1] * inv - lam * o2.y;
          O[d][4 * q + 2] = O[d][4 * q + 2] * inv - lam * o2.z;
          O[d][4 * q + 3] = O[d][4 * q + 3] * inv - lam * o2.w;
          ss += O[d][4 * q] * O[d][4 * q] + O[d][4 * q + 1] * O[d][4 * q + 1] + O[d][4 * q + 2] * O[d][4 * q + 2] + O[d][4 * q + 3] * O[d][4 * q + 3];
        }
      ss += __shfl_xor(ss, 32);
      const float r = rsqrtf(ss * (1.f / 128.f) + 1e-6f) * (1.f - lam_init);
#pragma unroll
      for (int d = 0; d < NDB; ++d)
#pragma unroll
        for (int q = 0; q < 4; ++q) {
          const int dd = d * 32 + 8 * q + 4 * h;
          float4 gs = *(const float4*)(subln + dd);
          uint2 v; v.x = pk2(O[d][4 * q] * r * gs.x, O[d][4 * q + 1] * r * gs.y); v.y = pk2(O[d][4 * q + 2] * r * gs.z, O[d][4 * q + 3] * r * gs.w);
          *(uint2*)(A2 + tidx(ocol + dd, row, MT)) = v;
        }
    }
    __syncthreads();
  }
}

DI void s5_coeffs(const Params& p, int dir, int g, int pp, float& abr, float& abi, float& cr, float& ci) {
  const int idx = (dir * 32 + g) * 64 + pp;
  const float dt = expf(p.log_dt[dir * 32 + g]);
  const float are = p.a_re[idx], aim = p.a_im[idx];
  const float mag = expf(are * dt);
  float sn, cs; sincosf(aim * dt, &sn, &cs);
  abr = mag * cs; abi = mag * sn;
  const float nr = abr - 1.f, ni = abi;
  const float den = are * are + aim * aim;
  cr = (nr * are + ni * aim) / den;
  ci = (ni * are - nr * aim) / den;
}

template <bool OUT>
DI void s5_task(const Params& p, char* smem, int gp, int c, const u16* __restrict__ U1, u16* __restrict__ Z) {
  float* su = (float*)smem;
  u16* hm = (u16*)(smem + 8192);
  const int tid = threadIdx.x, lane = tid & 63, w = tid >> 6;
  const int gl = w >> 1, dir = w & 1, g = 2 * gp + gl;
  {
    const int t = tid >> 2, part = tid & 3;
    uint4 v = *(const uint4*)(U1 + (size_t)(c * 64 + t) * 512 + gp * 32 + part * 8);
    float* d = su + t * 32 + part * 8;
    d[0] = bflo(v.x); d[1] = bfhi(v.x); d[2] = bflo(v.y); d[3] = bfhi(v.y);
    d[4] = bflo(v.z); d[5] = bfhi(v.z); d[6] = bflo(v.w); d[7] = bfhi(v.w);
  }
  float abr, abi, cr, ci;
  s5_coeffs(p, dir, g, lane, abr, abi, cr, ci);
  float bbr[16], bbi[16];
  {
    const size_t bidx = ((size_t)(dir * 32 + g) * 64 + lane) * 16;
#pragma unroll
    for (int q = 0; q < 4; ++q) {
      float4 br = *(const float4*)(p.b_re + bidx + q * 4), bi = *(const float4*)(p.b_im + bidx + q * 4);
      bbr[4 * q] = cr * br.x - ci * bi.x; bbi[4 * q] = cr * bi.x + ci * br.x;
      bbr[4 * q + 1] = cr * br.y - ci * bi.y; bbi[4 * q + 1] = cr * bi.y + ci * br.y;
      bbr[4 * q + 2] = cr * br.z - ci * bi.z; bbi[4 * q + 2] = cr * bi.z + ci * br.z;
      bbr[4 * q + 3] = cr * br.w - ci * bi.w; bbi[4 * q + 3] = cr * bi.w + ci * br.w;
    }
  }
  float2* sp = (float2*)p.s5s + ((size_t)(dir * 32 + g) * NCHUNK + c) * 64 + lane;
  float hr = 0.f, hi = 0.f;
  if (OUT) { float2 h0 = *sp; hr = h0.x; hi = h0.y; }
  __syncthreads();
  for (int step = 0; step < 64; ++step) {
    const int t = dir ? 63 - step : step;
    const float* ur = su + t * 32 + gl * 16;
    float bur = 0.f, bui = 0.f;
#pragma unroll
    for (int q = 0; q < 4; ++q) {
      float4 u = *(const float4*)(ur + 4 * q);
      bur += bbr[4 * q] * u.x + bbr[4 * q + 1] * u.y + bbr[4 * q + 2] * u.z + bbr[4 * q + 3] * u.w;
      bui += bbi[4 * q] * u.x + bbi[4 * q + 1] * u.y + bbi[4 * q + 2] * u.z + bbi[4 * q + 3] * u.w;
    }
    const float nhr = abr * hr - abi * hi + bur;
    const float nhi = abr * hi + abi * hr + bui;
    hr = nhr; hi = nhi;
    if (OUT) {
      u16* hrow = hm + (gl * 64 + t) * 264 + dir * 128 + lane;
      hrow[0] = f2bf(hr); hrow[64] = f2bf(hi);
    }
  }
  if (!OUT) {
    *sp = make_float2(hr, hi);
    __syncthreads();
  } else {
    __syncthreads();
    const int l15 = lane & 15, lq = lane >> 4;
    f32x4 acc0 = {0.f, 0.f, 0.f, 0.f}, acc1 = {0.f, 0.f, 0.f, 0.f};
    const int tb0 = 2 * (w & 1);
#pragma unroll
    for (int kb = 0; kb < 8; ++kb) {
      const int k0 = kb * 32 + lq * 8;
      const int dk = k0 >> 7, rem = k0 & 127, isim = rem >> 6, pp = rem & 63;
      const float* cs = (isim ? p.c_im : p.c_re) + ((size_t)((dk * 32 + g) * 16 + l15)) * 64 + pp;
      const float sg = isim ? -1.f : 1.f;
      float4 c0 = *(const float4*)cs, c1 = *(const float4*)(cs + 4);
      uint4 bb; bb.x = pk2(sg * c0.x, sg * c0.y); bb.y = pk2(sg * c0.z, sg * c0.w); bb.z = pk2(sg * c1.x, sg * c1.y); bb.w = pk2(sg * c1.z, sg * c1.w);
      bf16x8 bfr = __builtin_bit_cast(bf16x8, bb);
      bf16x8 a0 = *(const bf16x8*)(hm + (gl * 64 + tb0 * 16 + l15) * 264 + k0);
      bf16x8 a1 = *(const bf16x8*)(hm + (gl * 64 + (tb0 + 1) * 16 + l15) * 264 + k0);
      acc0 = MFMA16(a0, bfr, acc0);
      acc1 = MFMA16(a1, bfr, acc1);
    }
    const float dsk = p.d_skip[g * 16 + l15];
#pragma unroll
    for (int j = 0; j < 4; ++j) {
      int t = tb0 * 16 + lq * 4 + j;
      float y = acc0[j] + dsk * su[t * 32 + gl * 16 + l15];
      Z[tidx(g * 16 + l15, c * 64 + t, MT)] = f2bf(gelu_tanh(y));
      t += 16;
      y = acc1[j] + dsk * su[t * 32 + gl * 16 + l15];
      Z[tidx(g * 16 + l15, c * 64 + t, MT)] = f2bf(gelu_tanh(y));
    }
    __syncthreads();
  }
}

DI void s5_carry(const Params& p) {
  if (blockIdx.x >= 16) return;
  const int s = blockIdx.x * 256 + threadIdx.x;
  const int dir = s >> 11, g = (s >> 6) & 31, pp = s & 63;
  float abr, abi, cr, ci;
  s5_coeffs(p, dir, g, pp, abr, abi, cr, ci);
#pragma unroll
  for (int q = 0; q < 6; ++q) { float nr = abr * abr - abi * abi, ni = 2.f * abr * abi; abr = nr; abi = ni; }
  float2* base = (float2*)p.s5s + ((size_t)(dir * 32 + g) * NCHUNK) * 64 + pp;
  float hr = 0.f, hi = 0.f;
  for (int b = 0; b < 10; ++b) {
    float2 tmp[26];
#pragma unroll
    for (int j = 0; j < 26; ++j) {
      const int step = b * 26 + j;
      const int c = dir == 0 ? step : (step < 4 ? 3 - step : 263 - step);
      tmp[j] = base[(size_t)c * 64];
    }
#pragma unroll
    for (int j = 0; j < 26; ++j) {
      const int step = b * 26 + j;
      const int c = dir == 0 ? step : (step < 4 ? 3 - step : 263 - step);
      base[(size_t)c * 64] = make_float2(hr, hi);
      const float nr = abr * hr - abi * hi + tmp[j].x;
      const float ni = abr * hi + abi * hr + tmp[j].y;
      hr = nr; hi = ni;
    }
  }
}

DI unsigned gb_ld(unsigned* p) { return __hip_atomic_load(p, __ATOMIC_RELAXED, __HIP_MEMORY_SCOPE_AGENT); }
DI unsigned gb_add(unsigned* p, unsigned v) { return __hip_atomic_fetch_add(p, v, __ATOMIC_RELAXED, __HIP_MEMORY_SCOPE_AGENT); }
DI void grid_barrier(unsigned* bar, unsigned& epoch) {
  asm volatile("s_waitcnt vmcnt(0)" ::: "memory");
  __syncthreads();
  if (threadIdx.x == 0) {
    __builtin_amdgcn_fence(__ATOMIC_RELEASE, "agent");
    asm volatile("s_waitcnt vmcnt(0)" ::: "memory");
    const unsigned grp = blockIdx.x & 15u;
    const unsigned ngb = (gridDim.x + 15u - grp) >> 4;
    const unsigned old = gb_add(&bar[64 * (1 + grp)], 1u);
    if (old + 1u == (epoch + 1u) * ngb) {
      const unsigned ot = gb_add(&bar[64 * 17], 1u);
      if (ot + 1u == (epoch + 1u) * 16u) __hip_atomic_store(&bar[0], epoch + 1u, __ATOMIC_RELAXED, __HIP_MEMORY_SCOPE_AGENT);
    }
    while (gb_ld(&bar[0]) < epoch + 1u) __builtin_amdgcn_s_sleep(1);
    __builtin_amdgcn_fence(__ATOMIC_ACQUIRE, "agent");
    asm volatile("s_waitcnt vmcnt(0)" ::: "memory");
  }
  epoch++;
  __syncthreads();
}

__global__ void __launch_bounds__(256, 2) fwd_megakernel(Params p) {
  extern __shared__ __attribute__((aligned(16))) char smem[];
  cg::grid_group grid = cg::this_grid();
  const size_t RW = (size_t)MT * DM;
  u16* A2 = p.H;
  u16* Qb = (u16*)p.Y;
  u16* Kb = Qb + RW / 2;
  u16* Vt = Kb + RW / 2;
  const float* mod0 = p.mod;
  const float* mod1 = p.mod + 2 * 6 * DM;

  unsigned epoch = 0;
  if (p.ph_lo < 0) grid.sync();
#define PHASE_BEGIN(k) if ((k) >= p.ph_lo && (k) < p.ph_hi) { if ((k) > p.ph_lo) grid_barrier(p.bar, epoch);
#define PHASE_END }

  PHASE_BEGIN(0) for (int rep = 0; rep < REP_P; ++rep) phase_prep_weights(p, smem); PHASE_END

  PHASE_BEGIN(1)
    for (int rep = 0; rep < REP_O; ++rep) phase_rows<false, true>(p, 0, MT, p.ctx, p.x, nullptr, nullptr, nullptr, nullptr, 0, nullptr, mod0, 0, p.norm_pre, p.H);
  PHASE_END

  PHASE_BEGIN(2) {
    GemmDesc g{}; g.A = p.H; g.Bt = p.wt_in0; g.lda = DM; g.K = DM; g.nN = 18; g.tm0 = 0; g.nM = 65;
    g.d0 = p.big; g.ld0 = 1536; g.d1 = p.big + (size_t)MT * 1536; g.ld1 = 768; g.split = 1536;
    phase_gemm<EPI_SPLIT>(g, smem);
  } PHASE_END

  PHASE_BEGIN(3) {
    const u16* G = p.big; const u16* QKV = p.big + (size_t)MT * 1536;
    for (int rep = 0; rep < REP_O; ++rep) {
    qk_prep(QKV, 768, 0, 8, Qb, p.ev_q_norm, 0.125f * LOG2E, 0);
    qk_prep(QKV, 768, 512, 2, Kb, p.ev_k_norm, 1.f, 0);
    v_transpose(QKV, 768, 640, 128, Vt, smem);
    gated_conv(p, G, A2);
    }
  } PHASE_END

  PHASE_BEGIN(4) {
    const int w = threadIdx.x >> 6;
    const int nlat = 8 * 128, nctx = 8 * 2;
    for (int t0 = blockIdx.x; t0 < (nlat + nctx) * REP_A; t0 += gridDim.x) {
      const int t = t0 % (nlat + nctx);
      int head, q0, nkt;
      if (t < nlat) { head = t & 7; q0 = CTXN + (t >> 3) * 128; nkt = NCHUNK; }
      else { int tt = t - nlat; head = tt & 7; q0 = (tt >> 3) * 128; nkt = CTXN / 64; }
      attn_task<64, 1>(smem, Qb, Kb, Vt, head, 0, q0 + 32 * w, head >> 2, head >> 2, nkt, A2, 512 + head * 64, 0.f, 0.f, nullptr);
    }
  } PHASE_END

  PHASE_BEGIN(5) {
    GemmDesc g{}; g.A = A2; g.Bt = p.wt_out0; g.lda = DM; g.K = DM; g.nN = 8; g.tm0 = 0; g.nM = 65;
    g.d0 = p.Y; g.ld0 = DM;
    phase_gemm<EPI_F32>(g, smem);
  } PHASE_END

  PHASE_BEGIN(6)
    for (int rep = 0; rep < REP_O; ++rep) phase_rows<true, true>(p, 0, MT, p.ctx, p.x, p.xctx, p.out, (const u16*)p.Y, mod0, 2, p.norm_post, mod0, 3, p.norm_pre + DM, p.H);
  PHASE_END

  PHASE_BEGIN(7) {
    GemmDesc g{}; g.A = p.H; g.Bt = p.wt_up0; g.lda = DM; g.K = DM; g.nN = 44; g.tm0 = 0; g.nM = 67;
    g.d0 = p.big; g.cw = p.ffn_conv_w; g.cb = p.ffn_conv_b; g.zrow = (const u16*)(p.bar + 1536);
    phase_gemm<EPI_FFNUP>(g, smem);
  } PHASE_END

  PHASE_BEGIN(8) {
    GemmDesc g{}; g.A = p.big; g.Bt = p.wt_dn0; g.lda = DFF; g.K = DFF; g.nN = 8; g.tm0 = 0; g.nM = 65;
    g.d0 = p.Y; g.ld0 = DM;
    phase_gemm<EPI_F32>(g, smem);
  } PHASE_END

  PHASE_BEGIN(9)
    phase_rows<true, true>(p, 0, MT, p.xctx, p.out, p.xctx, p.out, (const u16*)p.Y, mod0, 5, p.norm_post + DM, mod1, 0, p.norm_pre + 2 * DM, p.H);
  PHASE_END

  u16* U1 = p.big;
  u16* QKV1 = p.big + (size_t)MT * 512;
  u16* Z = p.big + (size_t)MT * 2048;

  PHASE_BEGIN(10) {
    GemmDesc g{}; g.A = p.H; g.Bt = p.wt_in1; g.lda = DM; g.K = DM; g.nN = 16; g.tm0 = 0; g.nM = 65;
    g.d0 = U1; g.ld0 = 512; g.d1 = QKV1; g.ld1 = 1536; g.split = 512;
    phase_gemm<EPI_SPLIT>(g, smem);
  } PHASE_END

  PHASE_BEGIN(11) {
    for (int rep = 0; rep < REP_O; ++rep) {
    qk_prep(QKV1, 1536, 0, 8, Qb, nullptr, 0.125f * LOG2E, CTXN);
    qk_prep(QKV1, 1536, 512, 8, Kb, nullptr, 1.f, 0);
    v_transpose(QKV1, 1536, 1024, 512, Vt, smem);
    }
    for (int t0 = blockIdx.x; t0 < 16 * NCHUNK * REP_S; t0 += gridDim.x) { const int t = t0 % (16 * NCHUNK); s5_task<false>(p, smem, t & 15, t >> 4, U1, Z); }
  } PHASE_END

  PHASE_BEGIN(12) {
    s5_carry(p);
    float lam;
    {
      const int lane = threadIdx.x & 63;
      float s1 = wsum(p.lam_q1[lane] * p.lam_k1[lane]);
      float s2 = wsum(p.lam_q2[lane] * p.lam_k2[lane]);
      lam = expf(s1) - expf(s2) + 0.35550906759f;
    }
    const int w = threadIdx.x >> 6;
    for (int t0 = blockIdx.x; t0 < 4 * 256 * REP_A; t0 += gridDim.x) {
      const int t = t0 & 1023;
      const int head = t & 3, q0 = CTXN + (t >> 2) * 64;
      attn_task<128, 2>(smem, Qb, Kb, Vt, head * 2 + (w & 1), w & 1, q0 + 32 * (w >> 1), head * 2, head, NCHUNK, A2, 512 + head * 128,
                        lam, 0.35550906759f, p.subln);
    }
  } PHASE_END

  PHASE_BEGIN(13) {
    for (int t0 = blockIdx.x; t0 < 16 * (NCHUNK - 4) * REP_S; t0 += gridDim.x) { const int t = t0 % (16 * (NCHUNK - 4)); s5_task<true>(p, smem, t & 15, 4 + (t >> 4), U1, Z); }
  } PHASE_END

  PHASE_BEGIN(14) {
    GemmDesc g{}; g.A = Z; g.Bt = p.wt_glu; g.lda = 512; g.K = 512; g.nN = 8; g.tm0 = 1; g.nM = 64;
    g.d0 = A2; g.ld0 = DM;
    phase_gemm<EPI_GLU>(g, smem);
  } PHASE_END

  PHASE_BEGIN(15) {
    GemmDesc g{}; g.A = A2; g.Bt = p.wt_out1; g.lda = DM; g.K = DM; g.nN = 8; g.tm0 = 1; g.nM = 64;
    g.d0 = p.Y; g.ld0 = DM;
    phase_gemm<EPI_F32>(g, smem);
  } PHASE_END

  PHASE_BEGIN(16)
    phase_rows<true, true>(p, CTXN, MT, p.xctx, p.out, p.xctx, p.out, (const u16*)p.Y, mod1, 2, p.norm_post + 2 * DM, mod1, 3, p.norm_pre + 3 * DM, p.H);
  PHASE_END

  PHASE_BEGIN(17) {
    GemmDesc g{}; g.A = p.H; g.Bt = p.wt_up1; g.lda = DM; g.K = DM; g.nN = 44; g.tm0 = 2; g.nM = 65;
    g.d0 = p.big; g.cw = p.ffn_conv_w + 3 * 2 * DFF; g.cb = p.ffn_conv_b + 2 * DFF; g.zrow = (const u16*)(p.bar + 1536);
    phase_gemm<EPI_FFNUP>(g, smem);
  } PHASE_END

  PHASE_BEGIN(18) {
    GemmDesc g{}; g.A = p.big; g.Bt = p.wt_dn1; g.lda = DFF; g.K = DFF; g.nN = 8; g.tm0 = 1; g.nM = 64;
    g.d0 = p.Y; g.ld0 = DM;
    phase_gemm<EPI_F32>(g, smem);
  } PHASE_END

  PHASE_BEGIN(19)
    phase_rows<true, false>(p, CTXN, MT, p.xctx, p.out, p.xctx, p.out, (const u16*)p.Y, mod1, 5, p.norm_post + 3 * DM, nullptr, 0, nullptr, nullptr);
  PHASE_END
}

extern "C" void kernel_launch(void* const* d_in, const int* in_sizes, int n_in, void* d_out, int out_size, void* d_ws,
                              size_t ws_size, hipStream_t stream) {
  static int grid_blocks = 0;
  if (!grid_blocks) {
    hipFuncSetAttribute((const void*)fwd_megakernel, hipFuncAttributeMaxDynamicSharedMemorySize, LDS_BYTES);
    int dev = 0, cus = 0, per_cu = 0;
    hipGetDevice(&dev);
    hipDeviceGetAttribute(&cus, hipDeviceAttributeMultiprocessorCount, dev);
    hipOccupancyMaxActiveBlocksPerMultiprocessor(&per_cu, fwd_megakernel, 256, LDS_BYTES);
    if (per_cu > 2) per_cu = 2;
    grid_blocks = cus * per_cu;
  }
  Params p{};
  const float* const* in = (const float* const*)d_in;
  p.x = in[0]; p.c = in[1]; p.ctx = in[2]; p.c_ctx = in[3]; p.mod_w = in[4]; p.mod_b = in[5]; p.norm_pre = in[6]; p.norm_post = in[7];
  p.ffn_w_up = in[8]; p.ffn_conv_w = in[9]; p.ffn_conv_b = in[10]; p.ffn_w_down = in[11];
  p.ev_w_in = in[12]; p.ev_conv_w = in[13]; p.ev_q_norm = in[14]; p.ev_k_norm = in[15]; p.ev_w_out = in[16];
  p.od_w_in = in[17]; p.a_re = in[18]; p.a_im = in[19]; p.log_dt = in[20]; p.b_re = in[21]; p.b_im = in[22]; p.c_re = in[23]; p.c_im = in[24];
  p.d_skip = in[25]; p.glu_w = in[26]; p.lam_q1 = in[27]; p.lam_k1 = in[28]; p.lam_q2 = in[29]; p.lam_k2 = in[30]; p.subln = in[31]; p.od_w_out = in[32];
  p.out = (float*)d_out;
  char* ws = (char*)d_ws;
  size_t off = 0;
  auto take = [&](size_t bytes) { char* r = ws + off; off += (bytes + 255) & ~(size_t)255; return r; };
  p.wt_in0 = (u16*)take((size_t)2304 * 1024 * 2);
  p.wt_out0 = (u16*)take((size_t)1024 * 1024 * 2);
  p.wt_up0 = (u16*)take((size_t)2 * DFF * 1024 * 2);
  p.wt_dn0 = (u16*)take((size_t)1024 * DFF * 2);
  p.wt_in1 = (u16*)take((size_t)2048 * 1024 * 2);
  p.wt_glu = (u16*)take((size_t)1024 * 512 * 2);
  p.wt_out1 = (u16*)take((size_t)1024 * 1024 * 2);
  p.wt_up1 = (u16*)take((size_t)2 * DFF * 1024 * 2);
  p.wt_dn1 = (u16*)take((size_t)1024 * DFF * 2);
  p.mod = (float*)take((size_t)2 * 2 * 6 * DM * 4);
  p.xctx = (float*)take((size_t)CTXN * DM * 4);
  p.s5s = (float*)take((size_t)2 * 32 * NCHUNK * 64 * 8);
  p.H = (u16*)take((size_t)MT * DM * 2);
  p.Y = (float*)take((size_t)MT * DM * 4);
  p.big = (u16*)take((size_t)MT * DFF * 2);
  p.bar = (unsigned*)take(8192);
  p.ph_lo = 0; p.ph_hi = 20;
  if (off > ws_size) { fprintf(stderr, "workspace too small: need %zu have %zu\n", off, ws_size); }
  (void)hipMemsetAsync(p.bar, 0, 8192, stream);
  void* args[] = {&p};
  hipError_t e = hipLaunchCooperativeKernel((const void*)fwd_megakernel, dim3(grid_blocks), dim3(256), args, LDS_BYTES, stream);
  if (e != hipSuccess) fprintf(stderr, "cooperative launch failed: %s (grid %d)\n", hipGetErrorString(e), grid_blocks);
}
```

```cpp
#include <hip/hip_runtime.h>
#include <hip/hip_cooperative_groups.h>
#include <stdint.h>
#include <stdio.h>
namespace cg = cooperative_groups;

#define DI __device__ __forceinline__
typedef unsigned short u16;
typedef short bf16x8 __attribute__((ext_vector_type(8)));
typedef float f32x16 __attribute__((ext_vector_type(16)));
typedef float f32x4 __attribute__((ext_vector_type(4)));
typedef __bf16 bf2_t __attribute__((ext_vector_type(2)));
typedef float f2_t __attribute__((ext_vector_type(2)));

constexpr int DM = 1024;
constexpr int LSEQ = 16384;
constexpr int CTXN = 256;
constexpr int MT = LSEQ + CTXN;
constexpr int DFF = 2816;
constexpr int NCHUNK = MT / 64;
constexpr int LDS_BYTES = 77824;
#ifndef REP_A
#define REP_A 1
#endif
#ifndef REP_G
#define REP_G 1
#endif
#ifndef REP_O
#define REP_O 1
#endif
#ifndef REP_P
#define REP_P 1
#endif
#ifndef KREP
#define KREP 1
#endif
#ifndef REP_S
#define REP_S 1
#endif
constexpr float LOG2E = 1.4426950408889634f;

DI unsigned pk2(float a, float b) { f2_t v = {a, b}; bf2_t r = __builtin_convertvector(v, bf2_t); return __builtin_bit_cast(unsigned, r); }
DI u16 f2bf(float a) { return (u16)(pk2(a, 0.f) & 0xffffu); }
DI float bflo(unsigned v) { return __uint_as_float(v << 16); }
DI float bfhi(unsigned v) { return __uint_as_float(v & 0xffff0000u); }
DI float bf2f(u16 v) { return __uint_as_float(((unsigned)v) << 16); }
DI size_t tidx(int col, int row, int nrows) { return ((size_t)(col >> 5) * nrows + row) * 32 + (col & 31); }
DI int crow(int i, int h) { return (i & 3) + 8 * (i >> 2) + 4 * h; }
DI float wsum(float v) {
  v += __shfl_xor(v, 32); v += __shfl_xor(v, 16); v += __shfl_xor(v, 8);
  v += __shfl_xor(v, 4); v += __shfl_xor(v, 2); v += __shfl_xor(v, 1); return v;
}
DI float hsum32(float v) {
  v += __shfl_xor(v, 16); v += __shfl_xor(v, 8); v += __shfl_xor(v, 4); v += __shfl_xor(v, 2); v += __shfl_xor(v, 1); return v;
}
DI float silu_f(float x) { return x / (1.f + __expf(-x)); }
DI float sigmoid_f(float x) { return 1.f / (1.f + __expf(-x)); }
DI float gelu_tanh(float x) {
  float a = 0.7978845608028654f * (x + 0.044715f * x * x * x);
  float t = 1.f - 2.f / (__expf(2.f * a) + 1.f);
  return 0.5f * x * (1.f + t);
}
#define MFMA32(a, b, c) __builtin_amdgcn_mfma_f32_32x32x16_bf16((a), (b), (c), 0, 0, 0)
#define MFMA16(a, b, c) __builtin_amdgcn_mfma_f32_16x16x32_bf16((a), (b), (c), 0, 0, 0)

struct Params {
  const float *x, *c, *ctx, *c_ctx, *mod_w, *mod_b, *norm_pre, *norm_post, *ffn_w_up, *ffn_conv_w, *ffn_conv_b, *ffn_w_down;
  const float *ev_w_in, *ev_conv_w, *ev_q_norm, *ev_k_norm, *ev_w_out;
  const float *od_w_in, *a_re, *a_im, *log_dt, *b_re, *b_im, *c_re, *c_im, *d_skip, *glu_w;
  const float *lam_q1, *lam_k1, *lam_q2, *lam_k2, *subln, *od_w_out;
  float* out;
  u16 *wt_in0, *wt_out0, *wt_up0, *wt_dn0, *wt_in1, *wt_glu, *wt_out1, *wt_up1, *wt_dn1;
  float* mod;
  float* xctx;
  float* s5s;
  u16* H;
  float* Y;
  u16* big;
  unsigned* bar;
  int ph_lo, ph_hi;
};

DI int perm_row(int kind, int n) {
  if (kind == 1) {
    if (n < DFF) return (n >> 6) * 128 + (n & 63);
    int m = n - DFF; return (m >> 6) * 128 + 64 + (m & 63);
  } else if (kind == 2) {
    if (n < 512) return (n >> 5) * 64 + (n & 31);
    int m = n - 512; return (m >> 5) * 64 + 32 + (m & 31);
  }
  return n;
}

DI void transpose_tile(const float* __restrict__ W, int K, int N, u16* __restrict__ Wt, int kind, int tile, float* sm) {
  const int nN = N >> 6;
  const int k0 = (tile / nN) * 64, n0 = (tile % nN) * 64;
  const int tid = threadIdx.x;
  for (int r = tid >> 6; r < 64; r += 4) sm[r * 65 + (tid & 63)] = W[(size_t)(k0 + r) * N + n0 + (tid & 63)];
  __syncthreads();
  const int kk = (tid & 31) * 2;
  for (int n = tid >> 5; n < 64; n += 8) {
    unsigned v = pk2(sm[kk * 65 + n], sm[(kk + 1) * 65 + n]);
    *(unsigned*)(Wt + tidx(k0 + kk, perm_row(kind, n0 + n), N)) = v;
  }
  __syncthreads();
}

DI void phase_prep_weights(const Params& p, char* smem) {
  float* sm = (float*)smem;
  const float* srcs[9] = {p.ev_w_in, p.ev_w_out, p.ffn_w_up, p.ffn_w_down, p.od_w_in, p.glu_w, p.od_w_out,
                          p.ffn_w_up + (size_t)DM * 2 * DFF, p.ffn_w_down + (size_t)DFF * DM};
  u16* dsts[9] = {p.wt_in0, p.wt_out0, p.wt_up0, p.wt_dn0, p.wt_in1, p.wt_glu, p.wt_out1, p.wt_up1, p.wt_dn1};
  const int Ks[9] = {1024, 1024, 1024, DFF, 1024, 512, 1024, 1024, DFF};
  const int Ns[9] = {2304, 1024, 2 * DFF, 1024, 2048, 1024, 1024, 2 * DFF, 1024};
  const int kinds[9] = {0, 0, 1, 0, 0, 2, 0, 1, 0};
  int total = 0;
#pragma unroll
  for (int i = 0; i < 9; ++i) total += (Ks[i] >> 6) * (Ns[i] >> 6);
  const int NMOD = 192;
  for (int t = blockIdx.x; t < NMOD + total; t += gridDim.x) {
    if (t < NMOD) {
      const int layer = t / 96, cgp = t % 96;
      const int tid = threadIdx.x, col = cgp * 64 + (tid & 63), kq = tid >> 6;
      const float* W = p.mod_w + (size_t)layer * DM * 6 * DM;
      float* ssc = sm + 1024;
      for (int k = tid; k < DM; k += 256) { ssc[k] = silu_f(p.c[k]); ssc[DM + k] = silu_f(p.c_ctx[k]); }
      __syncthreads();
      float a0 = 0.f, a1 = 0.f;
      const float* wp = W + (size_t)(kq * 256) * (6 * DM) + col;
#pragma unroll 8
      for (int k = 0; k < 256; ++k) {
        const float w = wp[(size_t)k * (6 * DM)];
        a0 += ssc[kq * 256 + k] * w;
        a1 += ssc[DM + kq * 256 + k] * w;
      }
      sm[(kq * 64 + (tid & 63)) * 2] = a0;
      sm[(kq * 64 + (tid & 63)) * 2 + 1] = a1;
      __syncthreads();
      if (tid < 128) {
        int cc = tid & 63, which = tid >> 6;
        float s = 0.f;
        for (int q = 0; q < 4; ++q) s += sm[(q * 64 + cc) * 2 + which];
        int colo = cgp * 64 + cc;
        p.mod[(size_t)(layer * 2 + which) * 6 * DM + colo] = s + p.mod_b[layer * 6 * DM + colo];
      }
      __syncthreads();
    } else {
      int tt = t - NMOD;
#pragma unroll
      for (int i = 0; i < 9; ++i) {
        int cnt = (Ks[i] >> 6) * (Ns[i] >> 6);
        if (tt >= 0 && tt < cnt) transpose_tile(srcs[i], Ks[i], Ns[i], dsts[i], kinds[i], tt, sm);
        tt -= cnt;
      }
    }
  }
}

template <bool HAS_Y, bool HAS_H>
DI void phase_rows(const Params& p, int row0, int row1, const float* xin_ctx, const float* xin_lat,
                   float* xout_ctx, float* xout_lat, const u16* Y, const float* modl  ,
                   int gate_idx, const float* gpost, const float* modh  , int shift_idx,
                   const float* gpre, u16* Hout) {
  const int lane = threadIdx.x & 63;
  const int wid = blockIdx.x * 4 + (threadIdx.x >> 6), nw = gridDim.x * 4;
#pragma unroll 1
  for (int pass = 0; pass < 2; ++pass) {
    const bool isc = pass == 0;
    const int ra = isc ? row0 : max(row0, CTXN);
    const int rb = isc ? min(row1, CTXN) : row1;
    if (ra + wid >= rb) continue;
    float4 va[4], vb[4], vc[4];
#pragma unroll
    for (int j = 0; j < 4; ++j) {
      const int c = j * 256 + lane * 4;
      if (HAS_Y) {
        float4 g = *(const float4*)(gpost + c);
        float4 gg = *(const float4*)(modl + (size_t)(isc ? 6 : 0) * DM + gate_idx * DM + c);
        va[j] = make_float4(g.x * gg.x, g.y * gg.y, g.z * gg.z, g.w * gg.w);
      }
      if (HAS_H) {
        const float* sh = modh + (size_t)(isc ? 6 : 0) * DM + shift_idx * DM;
        float4 g = *(const float4*)(gpre + c);
        float4 s1 = *(const float4*)(sh + c);
        float4 s2 = *(const float4*)(sh + DM + c);
        vb[j] = make_float4(g.x * (1.f + s2.x), g.y * (1.f + s2.y), g.z * (1.f + s2.z), g.w * (1.f + s2.w));
        vc[j] = s1;
      }
    }
    const float* xin = isc ? xin_ctx : xin_lat - (size_t)CTXN * DM;
    float* xout = isc ? xout_ctx : xout_lat - (size_t)CTXN * DM;
#pragma unroll 1
    for (int row = ra + wid; row < rb; row += 2 * nw) {
      const int rowB = row + nw;
      const bool hasB = rowB < rb;
      const int rB = hasB ? rowB : row;
      float4 xa[4], xb[4], ya[4], yb[4];
#pragma unroll
      for (int j = 0; j < 4; ++j) {
        xa[j] = *(const float4*)(xin + (size_t)row * DM + j * 256 + lane * 4);
        xb[j] = *(const float4*)(xin + (size_t)rB * DM + j * 256 + lane * 4);
        if (HAS_Y) {
          const uint2 ua = *(const uint2*)(Y + (size_t)row * DM + j * 256 + lane * 4);
          const uint2 ub = *(const uint2*)(Y + (size_t)rB * DM + j * 256 + lane * 4);
          ya[j] = make_float4(bflo(ua.x), bfhi(ua.x), bflo(ua.y), bfhi(ua.y));
          yb[j] = make_float4(bflo(ub.x), bfhi(ub.x), bflo(ub.y), bfhi(ub.y));
        }
      }
      if (HAS_Y) {
        float sa = 0.f, sb2 = 0.f;
#pragma unroll
        for (int j = 0; j < 4; ++j) {
          sa += ya[j].x * ya[j].x + ya[j].y * ya[j].y + ya[j].z * ya[j].z + ya[j].w * ya[j].w;
          sb2 += yb[j].x * yb[j].x + yb[j].y * yb[j].y + yb[j].z * yb[j].z + yb[j].w * yb[j].w;
        }
        sa = wsum(sa); sb2 = wsum(sb2);
        const float ia = rsqrtf(sa * (1.f / DM) + 1e-6f), ib = rsqrtf(sb2 * (1.f / DM) + 1e-6f);
#pragma unroll
        for (int j = 0; j < 4; ++j) {
          xa[j].x += va[j].x * (ya[j].x * ia); xa[j].y += va[j].y * (ya[j].y * ia); xa[j].z += va[j].z * (ya[j].z * ia); xa[j].w += va[j].w * (ya[j].w * ia);
          xb[j].x += va[j].x * (yb[j].x * ib); xb[j].y += va[j].y * (yb[j].y * ib); xb[j].z += va[j].z * (yb[j].z * ib); xb[j].w += va[j].w * (yb[j].w * ib);
          *(float4*)(xout + (size_t)row * DM + j * 256 + lane * 4) = xa[j];
          if (hasB) *(float4*)(xout + (size_t)rowB * DM + j * 256 + lane * 4) = xb[j];
        }
      }
      if (HAS_H) {
        float sa = 0.f, sb2 = 0.f;
#pragma unroll
        for (int j = 0; j < 4; ++j) {
          sa += xa[j].x * xa[j].x + xa[j].y * xa[j].y + xa[j].z * xa[j].z + xa[j].w * xa[j].w;
          sb2 += xb[j].x * xb[j].x + xb[j].y * xb[j].y + xb[j].z * xb[j].z + xb[j].w * xb[j].w;
        }
        sa = wsum(sa); sb2 = wsum(sb2);
        const float ia = rsqrtf(sa * (1.f / DM) + 1e-6f), ib = rsqrtf(sb2 * (1.f / DM) + 1e-6f);
#pragma unroll
        for (int j = 0; j < 4; ++j) {
          uint2 o;
          o.x = pk2(xa[j].x * ia * vb[j].x + vc[j].x, xa[j].y * ia * vb[j].y + vc[j].y);
          o.y = pk2(xa[j].z * ia * vb[j].z + vc[j].z, xa[j].w * ia * vb[j].w + vc[j].w);
          *(uint2*)(Hout + tidx(j * 256 + lane * 4, row, MT)) = o;
          if (hasB) {
            o.x = pk2(xb[j].x * ib * vb[j].x + vc[j].x, xb[j].y * ib * vb[j].y + vc[j].y);
            o.y = pk2(xb[j].z * ib * vb[j].z + vc[j].z, xb[j].w * ib * vb[j].w + vc[j].w);
            *(uint2*)(Hout + tidx(j * 256 + lane * 4, rowB, MT)) = o;
          }
        }
      }
    }
  }
}

enum { EPI_SPLIT = 0, EPI_F32 = 1, EPI_GLU = 2, EPI_FFNUP = 3 };
struct GemmDesc {
  const u16* A; const u16* Bt; int lda; int K; int nN; int tm0; int nM;
  void* d0; void* d1; int ld0; int ld1; int split;
  const float* cw; const float* cb;
  const u16* zrow;
};

template <int MODE>
DI void gemm_tile(const GemmDesc& g, char* smem, int tmi, int tn) {
  const int tid = threadIdx.x, lane = tid & 63, w = tid >> 6, h = lane >> 5, l31 = lane & 31;
  const int wm = w >> 1, wn = w & 1;
  constexpr int ASZ = 256 * 64, BSZ = 128 * 64, STG = ASZ + BSZ;
  int seq_base = 0, seq_len = MT, vrow0 = tmi * 256;
  if (MODE == EPI_FFNUP) {
    if (tmi < 2) { seq_base = 0; seq_len = CTXN; vrow0 = 254 * tmi - 1; }
    else { seq_base = CTXN; seq_len = LSEQ; vrow0 = 254 * (tmi - 2) - 1; }
  }
  const int gkc = ((tid & 3) ^ ((tid >> 4) & 3)) * 8;
  const u16* arow[4];
  int astr[4];
#pragma unroll
  for (int j = 0; j < 4; ++j) {
    const int r = (tid >> 2) + 64 * j;
    if (MODE == EPI_FFNUP) {
      const int v = vrow0 + r;
      const bool ok = (v >= 0 && v < seq_len);
      arow[j] = ok ? g.A + (size_t)(seq_base + v) * 32 + gkc : g.zrow + gkc;
      astr[j] = ok ? MT * 32 : 0;
    } else {
      arow[j] = g.A + (size_t)(vrow0 + r) * 32 + gkc;
      astr[j] = MT * 32;
    }
  }
  const u16* brow[2];
#pragma unroll
  for (int j = 0; j < 2; ++j) brow[j] = g.Bt + (size_t)(tn * 128 + (tid >> 2) + 64 * j) * 32 + gkc;
  const int bstr = g.nN * 128 * 32;
  f32x16 acc[4][2];
#pragma unroll
  for (int a = 0; a < 4; ++a)
#pragma unroll
    for (int b = 0; b < 2; ++b)
#pragma unroll
      for (int i = 0; i < 16; ++i) acc[a][b][i] = 0.f;

  const int nk0 = g.K >> 5;
  const int nk = nk0 * KREP;
  char* dma_dst = smem + (w * 64) * 16;
#define G_DMA(kt_, stg) { char* d_ = dma_dst + (stg) * STG; const int kq_ = (KREP == 1) ? (kt_) : ((kt_) % nk0); \
    __builtin_amdgcn_global_load_lds((const unsigned*)(arow[0] + (size_t)(kq_) * astr[0]), (unsigned*)(d_), 16, 0, 0); \
    __builtin_amdgcn_global_load_lds((const unsigned*)(arow[1] + (size_t)(kq_) * astr[1]), (unsigned*)(d_ + 4096), 16, 0, 0); \
    __builtin_amdgcn_global_load_lds((const unsigned*)(arow[2] + (size_t)(kq_) * astr[2]), (unsigned*)(d_ + 8192), 16, 0, 0); \
    __builtin_amdgcn_global_load_lds((const unsigned*)(arow[3] + (size_t)(kq_) * astr[3]), (unsigned*)(d_ + 12288), 16, 0, 0); \
    __builtin_amdgcn_global_load_lds((const unsigned*)(brow[0] + (size_t)(kq_) * bstr), (unsigned*)(d_ + ASZ), 16, 0, 0); \
    __builtin_amdgcn_global_load_lds((const unsigned*)(brow[1] + (size_t)(kq_) * bstr), (unsigned*)(d_ + ASZ + 4096), 16, 0, 0); }
  const int sw = (l31 >> 2) & 3;
  const int aoff0 = (wm * 128 + l31) * 64 + ((h ^ sw) * 16);
  const int aoff1 = (wm * 128 + l31) * 64 + (((2 + h) ^ sw) * 16);
  const int boff0 = ASZ + (wn * 64 + l31) * 64 + ((h ^ sw) * 16);
  const int boff1 = ASZ + (wn * 64 + l31) * 64 + (((2 + h) ^ sw) * 16);
#define G_COMPUTE(stg) { const char* sb_ = smem + (stg) * STG; \
    _Pragma("unroll") for (int ks = 0; ks < 2; ++ks) { \
      bf16x8 af[4], bf[2]; \
      _Pragma("unroll") for (int mi = 0; mi < 4; ++mi) af[mi] = *(const bf16x8*)(sb_ + (ks ? aoff1 : aoff0) + mi * 32 * 64); \
      _Pragma("unroll") for (int ni = 0; ni < 2; ++ni) bf[ni] = *(const bf16x8*)(sb_ + (ks ? boff1 : boff0) + ni * 32 * 64); \
      _Pragma("unroll") for (int mi = 0; mi < 4; ++mi) \
        _Pragma("unroll") for (int ni = 0; ni < 2; ++ni) acc[mi][ni] = MFMA32(af[mi], bf[ni], acc[mi][ni]); \
    } }
#define RAW_BARRIER() { asm volatile("s_waitcnt lgkmcnt(0)" ::: "memory"); __builtin_amdgcn_s_barrier(); }
  G_DMA(0, 0);
  G_DMA(1, 1);
  int stg = 0;
#define SB_ __builtin_amdgcn_sched_barrier(0)
#define DMA1(ptr, off) __builtin_amdgcn_global_load_lds((const unsigned*)(ptr), (unsigned*)(d_ + (off)), 16, 0, 0)
  for (int kt = 0; kt < nk - 1; ++kt) {
    asm volatile("s_waitcnt vmcnt(6)" ::: "memory");
    RAW_BARRIER();
    const int s2 = (stg == 0) ? 2 : stg - 1;
    const int kn_ = (kt + 2 < nk) ? kt + 2 : nk - 1;
    const int kq_ = (KREP == 1) ? kn_ : (kn_ % nk0);
    char* d_ = dma_dst + s2 * STG;
    const char* sb_ = smem + stg * STG;
    bf16x8 af0[4], bf0[2], af1[4], bf1[2];
#pragma unroll
    for (int mi = 0; mi < 4; ++mi) af0[mi] = *(const bf16x8*)(sb_ + aoff0 + mi * 32 * 64);
#pragma unroll
    for (int ni = 0; ni < 2; ++ni) bf0[ni] = *(const bf16x8*)(sb_ + boff0 + ni * 32 * 64);
#pragma unroll
    for (int mi = 0; mi < 4; ++mi) af1[mi] = *(const bf16x8*)(sb_ + aoff1 + mi * 32 * 64);
#pragma unroll
    for (int ni = 0; ni < 2; ++ni) bf1[ni] = *(const bf16x8*)(sb_ + boff1 + ni * 32 * 64);
    SB_;
    acc[0][0] = MFMA32(af0[0], bf0[0], acc[0][0]); acc[0][1] = MFMA32(af0[0], bf0[1], acc[0][1]); SB_;
    DMA1(arow[0] + (size_t)kq_ * astr[0], 0); SB_;
    acc[1][0] = MFMA32(af0[1], bf0[0], acc[1][0]); acc[1][1] = MFMA32(af0[1], bf0[1], acc[1][1]); SB_;
    DMA1(arow[1] + (size_t)kq_ * astr[1], 4096); SB_;
    acc[2][0] = MFMA32(af0[2], bf0[0], acc[2][0]); acc[2][1] = MFMA32(af0[2], bf0[1], acc[2][1]); SB_;
    DMA1(arow[2] + (size_t)kq_ * astr[2], 8192); SB_;
    acc[3][0] = MFMA32(af0[3], bf0[0], acc[3][0]); acc[3][1] = MFMA32(af0[3], bf0[1], acc[3][1]); SB_;
    DMA1(arow[3] + (size_t)kq_ * astr[3], 12288); SB_;
    acc[0][0] = MFMA32(af1[0], bf1[0], acc[0][0]); acc[0][1] = MFMA32(af1[0], bf1[1], acc[0][1]); SB_;
    DMA1(brow[0] + (size_t)kq_ * bstr, ASZ); SB_;
    acc[1][0] = MFMA32(af1[1], bf1[0], acc[1][0]); acc[1][1] = MFMA32(af1[1], bf1[1], acc[1][1]); SB_;
    DMA1(brow[1] + (size_t)kq_ * bstr, ASZ + 4096); SB_;
    acc[2][0] = MFMA32(af1[2], bf1[0], acc[2][0]); acc[2][1] = MFMA32(af1[2], bf1[1], acc[2][1]);
    acc[3][0] = MFMA32(af1[3], bf1[0], acc[3][0]); acc[3][1] = MFMA32(af1[3], bf1[1], acc[3][1]);
    stg = (stg == 2) ? 0 : stg + 1;
  }
  asm volatile("s_waitcnt vmcnt(0)" ::: "memory");
  RAW_BARRIER();
  G_COMPUTE(stg);
  __syncthreads();
  if (KREP == 2) {
#pragma unroll
    for (int a = 0; a < 4; ++a)
#pragma unroll
      for (int b = 0; b < 2; ++b)
#pragma unroll
        for (int i = 0; i < 16; ++i) acc[a][b][i] *= 0.5f;
  }
  const int rbase = tmi * 256 + wm * 128;
  const int cbase = tn * 128 + wn * 64;
  char* wl = smem + w * 19456;
  if (MODE == EPI_F32) {
    u16* dst = (u16*)g.d0;
    u16* lh = (u16*)wl;
#pragma unroll
    for (int mi = 0; mi < 4; ++mi) {
#pragma unroll
      for (int ni = 0; ni < 2; ++ni)
#pragma unroll
        for (int i = 0; i < 16; ++i) lh[crow(i, h) * 72 + ni * 32 + l31] = f2bf(acc[mi][ni][i]);
#pragma unroll
      for (int it = 0; it < 4; ++it) {
        const int r = it * 8 + (lane >> 3), c8 = (lane & 7) * 8;
        uint4 v = *(const uint4*)(lh + r * 72 + c8);
        *(uint4*)(dst + (size_t)(rbase + mi * 32 + r) * g.ld0 + cbase + c8) = v;
      }
    }
  } else if (MODE == EPI_SPLIT) {
    u16* dst; int ld, cc;
    if (cbase < g.split) { dst = (u16*)g.d0; ld = g.ld0; cc = cbase; } else { dst = (u16*)g.d1; ld = g.ld1; cc = cbase - g.split; }
    u16* lh = (u16*)wl;
#pragma unroll
    for (int mi = 0; mi < 4; ++mi) {
#pragma unroll
      for (int ni = 0; ni < 2; ++ni)
#pragma unroll
        for (int i = 0; i < 16; ++i) lh[crow(i, h) * 72 + ni * 32 + l31] = f2bf(acc[mi][ni][i]);
#pragma unroll
      for (int it = 0; it < 4; ++it) {
        const int r = it * 8 + (lane >> 3), c8 = (lane & 7) * 8;
        uint4 v = *(const uint4*)(lh + r * 72 + c8);
        *(uint4*)(dst + (size_t)(rbase + mi * 32 + r) * ld + cc + c8) = v;
      }
    }
  } else if (MODE == EPI_GLU) {
    u16* dst = (u16*)g.d0;
    const int col0 = (tn * 2 + wn) * 32;
    u16* lh = (u16*)wl;
#pragma unroll
    for (int mi = 0; mi < 4; ++mi) {
#pragma unroll
      for (int i = 0; i < 16; ++i) lh[crow(i, h) * 40 + l31] = f2bf(acc[mi][0][i] * sigmoid_f(acc[mi][1][i]));
#pragma unroll
      for (int it = 0; it < 2; ++it) {
        const int r = it * 16 + (lane >> 2), c8 = (lane & 3) * 8;
        uint4 v = *(const uint4*)(lh + r * 40 + c8);
        *(uint4*)(dst + tidx(col0 + c8, rbase + mi * 32 + r, MT)) = v;
      }
    }
  } else {
    u16* T = (u16*)smem;
#pragma unroll
    for (int mi = 0; mi < 4; ++mi)
#pragma unroll
      for (int ni = 0; ni < 2; ++ni)
#pragma unroll
        for (int i = 0; i < 16; ++i)
          T[(wm * 128 + mi * 32 + crow(i, h)) * 136 + wn * 64 + ni * 32 + l31] = f2bf(acc[mi][ni][i]);
    __syncthreads();
    {
      const int cg8 = (tid & 7) * 8, r0 = (tid >> 3) * 8;
      const int fa = tn * 64 + cg8, fg = DFF + fa;
      float wa[3][8], wg[3][8], ba[8], bg[8];
#pragma unroll
      for (int q = 0; q < 3; ++q)
#pragma unroll
        for (int e = 0; e < 8; e += 4) {
          float4 x = *(const float4*)(g.cw + q * 2 * DFF + fa + e); wa[q][e] = x.x; wa[q][e + 1] = x.y; wa[q][e + 2] = x.z; wa[q][e + 3] = x.w;
          float4 y = *(const float4*)(g.cw + q * 2 * DFF + fg + e); wg[q][e] = y.x; wg[q][e + 1] = y.y; wg[q][e + 2] = y.z; wg[q][e + 3] = y.w;
        }
#pragma unroll
      for (int e = 0; e < 8; e += 4) {
        float4 x = *(const float4*)(g.cb + fa + e); ba[e] = x.x; ba[e + 1] = x.y; ba[e + 2] = x.z; ba[e + 3] = x.w;
        float4 y = *(const float4*)(g.cb + fg + e); bg[e] = y.x; bg[e + 1] = y.y; bg[e + 2] = y.z; bg[e + 3] = y.w;
      }
      float ap[8], ac[8], an[8], gp[8], gc[8], gn[8];
      auto ld8 = [&](int r, int coff, float* o) {
        uint4 v = *(const uint4*)(T + r * 136 + coff);
        o[0] = bflo(v.x); o[1] = bfhi(v.x); o[2] = bflo(v.y); o[3] = bfhi(v.y); o[4] = bflo(v.z); o[5] = bfhi(v.z); o[6] = bflo(v.w); o[7] = bfhi(v.w);
      };
      const int rm1 = (r0 > 0) ? r0 - 1 : 0;
      ld8(rm1, cg8, ap); ld8(rm1, 64 + cg8, gp);
      ld8(r0, cg8, ac); ld8(r0, 64 + cg8, gc);
      u16* dst = (u16*)g.d0;
#pragma unroll
      for (int rr = 0; rr < 8; ++rr) {
        const int r = r0 + rr;
        const int rn = (r < 255) ? r + 1 : 255;
        ld8(rn, cg8, an); ld8(rn, 64 + cg8, gn);
        const int v = vrow0 + r;
        if (r >= 1 && r <= 254 && v < seq_len) {
          float o[8];
#pragma unroll
          for (int e = 0; e < 8; ++e) {
            const float av = wa[0][e] * ap[e] + wa[1][e] * ac[e] + wa[2][e] * an[e] + ba[e];
            const float gv = wg[0][e] * gp[e] + wg[1][e] * gc[e] + wg[2][e] * gn[e] + bg[e];
            o[e] = av * silu_f(gv);
          }
          uint4 ov; ov.x = pk2(o[0], o[1]); ov.y = pk2(o[2], o[3]); ov.z = pk2(o[4], o[5]); ov.w = pk2(o[6], o[7]);
          *(uint4*)(dst + tidx(fa, seq_base + v, MT)) = ov;
        }
#pragma unroll
        for (int e = 0; e < 8; ++e) { ap[e] = ac[e]; ac[e] = an[e]; gp[e] = gc[e]; gc[e] = gn[e]; }
      }
    }
  }
  __syncthreads();
}

template <int MODE>
DI void phase_gemm(const GemmDesc& g, char* smem) {
  const int ntiles = g.nM * g.nN;
  const int per = gridDim.x >> 3;
  const int slot = (blockIdx.x & 7) * per + (blockIdx.x >> 3);
  for (int q0 = slot; q0 < ntiles * REP_G; q0 += gridDim.x) {
    const int q = q0 % ntiles;
    const int gm = q / (8 * g.nN);
    const int rows = min(8, g.nM - 8 * gm);
    const int ql = q - gm * 8 * g.nN;
    const int tn = ql / rows, tm = g.tm0 + gm * 8 + ql % rows;
    gemm_tile<MODE>(g, smem, tm, tn);
  }
}

DI void rope_angles(int row, int i, float& cs, float& sn) {
  const int pos = row - CTXN;
  const int rr = pos >> 6, cc = pos & 63;
  const int fi = i & 15;
  const float inv = exp2f(-(float)fi * (13.287712379549449f / 16.f));
  const float ang = (float)((i < 16) ? rr : cc) * inv;
  sincosf(ang, &sn, &cs);
}

DI void qk_prep(const u16* __restrict__ src, int lds, int coff, int nheads, u16* __restrict__ dst, const float* gnorm  ,
                float oscale, int row0) {
  const int lane = threadIdx.x & 63, hh = lane >> 5, i = lane & 31;
  const int wid = blockIdx.x * 4 + (threadIdx.x >> 6), nw = gridDim.x * 4;
  const int npair = nheads >> 1;
  const int nitems = (MT - row0) * npair;
  for (int it = wid; it < nitems; it += nw) {
    const int row = row0 + it / npair, head = (it % npair) * 2 + hh;
    unsigned v = *(const unsigned*)(src + (size_t)row * lds + coff + head * 64 + 2 * i);
    float e = bflo(v), o = bfhi(v);
    if (gnorm) {
      float ss = hsum32(e * e + o * o);
      float rinv = rsqrtf(ss * (1.f / 64.f) + 1e-6f);
      e = e * rinv * gnorm[2 * i]; o = o * rinv * gnorm[2 * i + 1];
    }
    if (row >= CTXN) {
      float cs, sn; rope_angles(row, i, cs, sn);
      float e2 = e * cs - o * sn, o2 = e * sn + o * cs;
      e = e2; o = o2;
    }
    *(unsigned*)(dst + ((size_t)head * MT + row) * 64 + 2 * i) = pk2(e * oscale, o * oscale);
  }
}

DI void v_transpose(const u16* __restrict__ src, int lds, int coff, int ncols, u16* __restrict__ dst, char* smem) {
  u16* sm = (u16*)smem;
  const int tid = threadIdx.x;
  const int ndt = ncols >> 6;
  const int ntasks = NCHUNK * ndt;
  for (int t = blockIdx.x; t < ntasks; t += gridDim.x) {
    const int tt = t / ndt, dt = t % ndt;
    {
      const int tok = tid >> 2, part = tid & 3;
      const u16* sp = src + (size_t)(tt * 64 + tok) * lds + coff + dt * 64 + part * 16;
      uint4 a = *(const uint4*)sp, b = *(const uint4*)(sp + 8);
      unsigned* d = (unsigned*)(sm + tok * 66 + part * 16);
      d[0] = a.x; d[1] = a.y; d[2] = a.z; d[3] = a.w; d[4] = b.x; d[5] = b.y; d[6] = b.z; d[7] = b.w;
    }
    __syncthreads();
    {
      const int d = tid >> 2, part = tid & 3;
      unsigned o[8];
#pragma unroll
      for (int j = 0; j < 8; ++j) {
        unsigned lo = sm[(part * 16 + 2 * j) * 66 + d], hi = sm[(part * 16 + 2 * j + 1) * 66 + d];
        o[j] = lo | (hi << 16);
      }
      u16* dp = dst + (size_t)(dt * 64 + d) * MT + tt * 64 + part * 16;
      *(uint4*)dp = make_uint4(o[0], o[1], o[2], o[3]);
      *(uint4*)(dp + 8) = make_uint4(o[4], o[5], o[6], o[7]);
    }
    __syncthreads();
  }
}

DI void gated_conv(const Params& p, const u16* __restrict__ G, u16* __restrict__ A2) {
  const int lane = threadIdx.x & 63;
  const int wid = blockIdx.x * 4 + (threadIdx.x >> 6), nw = gridDim.x * 4;
  const int nitems = MT * 4;
  for (int it = wid; it < nitems; it += nw) {
    const int row = it >> 2, c = ((it & 3) * 64 + lane) * 2;
    const bool first = (row == 0) || (row == CTXN), last = (row == CTXN - 1) || (row == MT - 1);
    const u16* gr = G + (size_t)row * 1536;
    unsigned gb = *(const unsigned*)(gr + c);
    unsigned c1 = *(const unsigned*)(gr + 512 + c), v1 = *(const unsigned*)(gr + 1024 + c);
    float m1a = bflo(c1) * bflo(v1), m1b = bfhi(c1) * bfhi(v1);
    float m0a = 0.f, m0b = 0.f, m2a = 0.f, m2b = 0.f;
    if (!first) {
      unsigned c0 = *(const unsigned*)(gr - 1536 + 512 + c), v0 = *(const unsigned*)(gr - 1536 + 1024 + c);
      m0a = bflo(c0) * bflo(v0); m0b = bfhi(c0) * bfhi(v0);
    }
    if (!last) {
      unsigned c2 = *(const unsigned*)(gr + 1536 + 512 + c), v2 = *(const unsigned*)(gr + 1536 + 1024 + c);
      m2a = bflo(c2) * bflo(v2); m2b = bfhi(c2) * bfhi(v2);
    }
    const float* cw = p.ev_conv_w;
    float ya = bflo(gb) * (cw[c] * m0a + cw[512 + c] * m1a + cw[1024 + c] * m2a);
    float yb = bfhi(gb) * (cw[c + 1] * m0b + cw[512 + c + 1] * m1b + cw[1024 + c + 1] * m2b);
    *(unsigned*)(A2 + tidx(c, row, MT)) = pk2(ya, yb);
  }
}

DI int kperm(int r) { return (r & 0x13) | ((r & 4) << 1) | ((r & 8) >> 1); }

template <int DV, int NCOMP>
DI void attn_task(char* smem, const u16* __restrict__ Qb, const u16* __restrict__ Kb, const u16* __restrict__ Vt,
                  int qh, int kslot, int q0w, int kh0, int vhead, int nkt, u16* __restrict__ A2, int ocol,
                  float lam, float lam_init, const float* __restrict__ subln) {
  const int tid = threadIdx.x, lane = tid & 63, w = tid >> 6, h = lane >> 5, l31 = lane & 31;
  constexpr int KT = 64 * 144;
  constexpr int STG = NCOMP * KT + DV * 144;
  constexpr int NDB = DV / 32;
  bf16x8 qf[4];
  {
    const u16* qp = Qb + ((size_t)qh * MT + q0w + l31) * 64 + h * 8;
#pragma unroll
    for (int ks = 0; ks < 4; ++ks) qf[ks] = *(const bf16x8*)(qp + ks * 16);
  }
  f32x16 O[NDB];
#pragma unroll
  for (int d = 0; d < NDB; ++d)
#pragma unroll
    for (int i = 0; i < 16; ++i) O[d][i] = 0.f;
  float m = 0.f, lsum = 0.f;
  f32x16 negm, Lacc;
#pragma unroll
  for (int i = 0; i < 16; ++i) { negm[i] = 0.f; Lacc[i] = 0.f; }
  bf16x8 ones;
  {
    const short ov = (l31 == 0) ? (short)0x3F80 : (short)0;
#pragma unroll
    for (int j = 0; j < 8; ++j) ones[j] = ov;
  }
  uint4 kr0, kr1, kr2, kr3, vr0, vr1, vr2, vr3;
  kr2 = kr3 = vr2 = vr3 = make_uint4(0, 0, 0, 0);
  const int skey = (tid & 511) >> 3, spart = tid & 7;
  const u16* kg = Kb + ((size_t)kh0 * MT + skey) * 64 + spart * 8;
  const u16* vg = Vt + ((size_t)vhead * DV + (tid >> 3)) * MT + spart * 8;
  const int ksl = skey * 144 + spart * 16;
  constexpr int vsl_off = NCOMP * KT;
#define vsl (ksl + vsl_off)
#define A_LOAD(kt) { \
    kr0 = *(const uint4*)(kg + (size_t)(kt) * 64 * 64); kr1 = *(const uint4*)(kg + (size_t)(kt) * 64 * 64 + 32 * 64); \
    if (NCOMP == 2) { kr2 = *(const uint4*)(kg + (size_t)MT * 64 + (size_t)(kt) * 64 * 64); kr3 = *(const uint4*)(kg + (size_t)MT * 64 + (size_t)(kt) * 64 * 64 + 32 * 64); } \
    vr0 = *(const uint4*)(vg + (kt) * 64); vr1 = *(const uint4*)(vg + (size_t)32 * MT + (kt) * 64); \
    if (DV == 128) { vr2 = *(const uint4*)(vg + (size_t)64 * MT + (kt) * 64); vr3 = *(const uint4*)(vg + (size_t)96 * MT + (kt) * 64); } }
#define A_WRITE(buf) { char* sb_ = smem + (buf) * STG; \
    *(uint4*)(sb_ + ksl) = kr0; *(uint4*)(sb_ + ksl + 32 * 144) = kr1; \
    if (NCOMP == 2) { *(uint4*)(sb_ + KT + ksl) = kr2; *(uint4*)(sb_ + KT + ksl + 32 * 144) = kr3; } \
    *(uint4*)(sb_ + vsl) = vr0; *(uint4*)(sb_ + vsl + 32 * 144) = vr1; \
    if (DV == 128) { *(uint4*)(sb_ + vsl + 64 * 144) = vr2; *(uint4*)(sb_ + vsl + 96 * 144) = vr3; } }
  A_LOAD(0); A_WRITE(0); __syncthreads();
  for (int kt = 0; kt < nkt; ++kt) {
    const int ktn = (kt + 1 < nkt) ? kt + 1 : kt;
    A_LOAD(ktn);
    __builtin_amdgcn_sched_barrier(0);
    const char* sb = smem + (kt & 1) * STG;
    const char* kp = sb + kslot * KT + kperm(l31) * 144 + h * 16;
    f32x16 S0, S1;
    {
      bf16x8 a0 = *(const bf16x8*)(kp);
      bf16x8 a1 = *(const bf16x8*)(kp + 32 * 144);
      S0 = MFMA32(a0, qf[0], negm); S1 = MFMA32(a1, qf[0], negm);
    }
#pragma unroll
    for (int ks = 1; ks < 4; ++ks) {
      bf16x8 a0 = *(const bf16x8*)(kp + ks * 32);
      bf16x8 a1 = *(const bf16x8*)(kp + 32 * 144 + ks * 32);
      S0 = MFMA32(a0, qf[ks], S0);
      S1 = MFMA32(a1, qf[ks], S1);
    }
    const char* vp = sb + NCOMP * KT + l31 * 144 + h * 16;
    bf16x8 vfr[NDB][4];
    if (NCOMP == 1) {
#pragma unroll
      for (int kk = 0; kk < 4; ++kk)
#pragma unroll
        for (int d = 0; d < NDB; ++d) vfr[d][kk] = *(const bf16x8*)(vp + d * 32 * 144 + kk * 32);
      __builtin_amdgcn_sched_barrier(0);
    }
    float mx = fmaxf(S0[0], S1[0]);
#pragma unroll
    for (int i = 1; i < 16; ++i) mx = fmaxf(mx, fmaxf(S0[i], S1[i]));
    mx = fmaxf(mx, __shfl_xor(mx, 32));
    const bool recentre = (kt == 0) || (mx > 8.f);
    if (__any(recentre)) {
      const float delta = recentre ? mx : 0.f;
      const float alpha = __builtin_amdgcn_exp2f(-delta);
      m += delta;
      lsum *= alpha;
#pragma unroll
      for (int i = 0; i < 16; ++i) { negm[i] = -m; S0[i] -= delta; S1[i] -= delta; }
      if (NCOMP == 1) Lacc[0] *= alpha;
#pragma unroll
      for (int d = 0; d < NDB; ++d)
#pragma unroll
        for (int i = 0; i < 16; ++i) O[d][i] *= alpha;
    }
    if (NCOMP == 1) {
#pragma unroll
      for (int i = 0; i < 16; ++i) { S0[i] = __builtin_amdgcn_exp2f(S0[i]); S1[i] = __builtin_amdgcn_exp2f(S1[i]); }
    } else {
      float ps = 0.f;
#pragma unroll
      for (int i = 0; i < 16; ++i) { S0[i] = __builtin_amdgcn_exp2f(S0[i]); ps += S0[i]; }
#pragma unroll
      for (int i = 0; i < 16; ++i) { S1[i] = __builtin_amdgcn_exp2f(S1[i]); ps += S1[i]; }
      lsum += ps;
    }
    bf16x8 pf[4];
#pragma unroll
    for (int s2 = 0; s2 < 2; ++s2) {
      uint4 a, b;
      a.x = pk2(S0[8 * s2], S0[8 * s2 + 1]); a.y = pk2(S0[8 * s2 + 2], S0[8 * s2 + 3]);
      a.z = pk2(S0[8 * s2 + 4], S0[8 * s2 + 5]); a.w = pk2(S0[8 * s2 + 6], S0[8 * s2 + 7]);
      b.x = pk2(S1[8 * s2], S1[8 * s2 + 1]); b.y = pk2(S1[8 * s2 + 2], S1[8 * s2 + 3]);
      b.z = pk2(S1[8 * s2 + 4], S1[8 * s2 + 5]); b.w = pk2(S1[8 * s2 + 6], S1[8 * s2 + 7]);
      pf[s2] = __builtin_bit_cast(bf16x8, a);
      pf[2 + s2] = __builtin_bit_cast(bf16x8, b);
    }
#pragma unroll
    for (int kk = 0; kk < 4; ++kk)
#pragma unroll
      for (int d = 0; d < NDB; ++d) {
        bf16x8 vf;
        if (NCOMP == 1) vf = vfr[d][kk]; else vf = *(const bf16x8*)(vp + d * 32 * 144 + kk * 32);
        O[d] = MFMA32(vf, pf[kk], O[d]);
      }
    if (NCOMP == 1) {
#pragma unroll
      for (int kk = 0; kk < 4; ++kk) Lacc = MFMA32(ones, pf[kk], Lacc);
    }
    A_WRITE((kt + 1) & 1);
    __syncthreads();
  }
  const float ltot = (NCOMP == 1) ? __shfl(Lacc[0], l31) : lsum + __shfl_xor(lsum, 32);
  const float inv = 1.f / ltot;
  const int row = q0w + l31;
  if (NCOMP == 1) {
#pragma unroll
    for (int d = 0; d < NDB; ++d)
#pragma unroll
      for (int q = 0; q < 4; ++q) {
        const int dd = d * 32 + 8 * q + 4 * h;
        uint2 v; v.x = pk2(O[d][4 * q] * inv, O[d][4 * q + 1] * inv); v.y = pk2(O[d][4 * q + 2] * inv, O[d][4 * q + 3] * inv);
        *(uint2*)(A2 + tidx(ocol + dd, row, MT)) = v;
      }
  } else {
    float* ox = (float*)smem;
    const int ql = (w >> 1) * 32 + l31;
    if (w & 1) {
#pragma unroll
      for (int d = 0; d < NDB; ++d)
#pragma unroll
        for (int q = 0; q < 4; ++q) {
          const int dd = d * 32 + 8 * q + 4 * h;
          float4 v = make_float4(O[d][4 * q] * inv, O[d][4 * q + 1] * inv, O[d][4 * q + 2] * inv, O[d][4 * q + 3] * inv);
          *(float4*)(ox + ql * 132 + dd) = v;
        }
    }
    __syncthreads();
    if (!(w & 1)) {
      float ss = 0.f;
#pragma unroll
      for (int d = 0; d < NDB; ++d)
#pragma unroll
        for (int q = 0; q < 4; ++q) {
          const int dd = d * 32 + 8 * q + 4 * h;
          float4 o2 = *(const float4*)(ox + ql * 132 + dd);
          O[d][4 * q] = O[d][4 * q] * inv - lam * o2.x;
          O[d][4 * q + 1] = O[d][4 * q + 1] * inv - lam * o2.y;
          O[d][4 * q + 2] = O[d][4 * q + 2] * inv - lam * o2.z;
          O[d][4 * q + 3] = O[d][4 * q + 3] * inv - lam * o2.w;
          ss += O[d][4 * q] * O[d][4 * q] + O[d][4 * q + 1] * O[d][4 * q + 1] + O[d][4 * q + 2] * O[d][4 * q + 2] + O[d][4 * q + 3] * O[d][4 * q + 3];
        }
      ss += __shfl_xor(ss, 32);
      const float r = rsqrtf(ss * (1.f / 128.f) + 1e-6f) * (1.f - lam_init);
#pragma unroll
      for (int d = 0; d < NDB; ++d)
#pragma unroll
        for (int q = 0; q < 4; ++q) {
          const int dd = d * 32 + 8 * q + 4 * h;
          float4 gs = *(const float4*)(subln + dd);
          uint2 v; v.x = pk2(O[d][4 * q] * r * gs.x, O[d][4 * q + 1] * r * gs.y); v.y = pk2(O[d][4 * q + 2] * r * gs.z, O[d][4 * q + 3] * r * gs.w);
          *(uint2*)(A2 + tidx(ocol + dd, row, MT)) = v;
        }
    }
    __syncthreads();
  }
}

DI void s5_coeffs(const Params& p, int dir, int g, int pp, float& abr, float& abi, float& cr, float& ci) {
  const int idx = (dir * 32 + g) * 64 + pp;
  const float dt = expf(p.log_dt[dir * 32 + g]);
  const float are = p.a_re[idx], aim = p.a_im[idx];
  const float mag = expf(are * dt);
  float sn, cs; sincosf(aim * dt, &sn, &cs);
  abr = mag * cs; abi = mag * sn;
  const float nr = abr - 1.f, ni = abi;
  const float den = are * are + aim * aim;
  cr = (nr * are + ni * aim) / den;
  ci = (ni * are - nr * aim) / den;
}

template <bool OUT>
DI void s5_task(const Params& p, char* smem, int gp, int c, const u16* __restrict__ U1, u16* __restrict__ Z) {
  float* su = (float*)smem;
  u16* hm = (u16*)(smem + 8192);
  const int tid = threadIdx.x, lane = tid & 63, w = tid >> 6;
  const int gl = w >> 1, dir = w & 1, g = 2 * gp + gl;
  {
    const int t = tid >> 2, part = tid & 3;
    uint4 v = *(const uint4*)(U1 + (size_t)(c * 64 + t) * 512 + gp * 32 + part * 8);
    float* d = su + t * 32 + part * 8;
    d[0] = bflo(v.x); d[1] = bfhi(v.x); d[2] = bflo(v.y); d[3] = bfhi(v.y);
    d[4] = bflo(v.z); d[5] = bfhi(v.z); d[6] = bflo(v.w); d[7] = bfhi(v.w);
  }
  float abr, abi, cr, ci;
  s5_coeffs(p, dir, g, lane, abr, abi, cr, ci);
  float bbr[16], bbi[16];
  {
    const size_t bidx = ((size_t)(dir * 32 + g) * 64 + lane) * 16;
#pragma unroll
    for (int q = 0; q < 4; ++q) {
      float4 br = *(const float4*)(p.b_re + bidx + q * 4), bi = *(const float4*)(p.b_im + bidx + q * 4);
      bbr[4 * q] = cr * br.x - ci * bi.x; bbi[4 * q] = cr * bi.x + ci * br.x;
      bbr[4 * q + 1] = cr * br.y - ci * bi.y; bbi[4 * q + 1] = cr * bi.y + ci * br.y;
      bbr[4 * q + 2] = cr * br.z - ci * bi.z; bbi[4 * q + 2] = cr * bi.z + ci * br.z;
      bbr[4 * q + 3] = cr * br.w - ci * bi.w; bbi[4 * q + 3] = cr * bi.w + ci * br.w;
    }
  }
  float2* sp = (float2*)p.s5s + ((size_t)(dir * 32 + g) * NCHUNK + c) * 64 + lane;
  float hr = 0.f, hi = 0.f;
  if (OUT) { float2 h0 = *sp; hr = h0.x; hi = h0.y; }
  __syncthreads();
  for (int step = 0; step < 64; ++step) {
    const int t = dir ? 63 - step : step;
    const float* ur = su + t * 32 + gl * 16;
    float bur = 0.f, bui = 0.f;
#pragma unroll
    for (int q = 0; q < 4; ++q) {
      float4 u = *(const float4*)(ur + 4 * q);
      bur += bbr[4 * q] * u.x + bbr[4 * q + 1] * u.y + bbr[4 * q + 2] * u.z + bbr[4 * q + 3] * u.w;
      bui += bbi[4 * q] * u.x + bbi[4 * q + 1] * u.y + bbi[4 * q + 2] * u.z + bbi[4 * q + 3] * u.w;
    }
    const float nhr = abr * hr - abi * hi + bur;
    const float nhi = abr * hi + abi * hr + bui;
    hr = nhr; hi = nhi;
    if (OUT) {
      u16* hrow = hm + (gl * 64 + t) * 264 + dir * 128 + lane;
      hrow[0] = f2bf(hr); hrow[64] = f2bf(hi);
    }
  }
  if (!OUT) {
    *sp = make_float2(hr, hi);
    __syncthreads();
  } else {
    __syncthreads();
    const int l15 = lane & 15, lq = lane >> 4;
    f32x4 acc0 = {0.f, 0.f, 0.f, 0.f}, acc1 = {0.f, 0.f, 0.f, 0.f};
    const int tb0 = 2 * (w & 1);
#pragma unroll
    for (int kb = 0; kb < 8; ++kb) {
      const int k0 = kb * 32 + lq * 8;
      const int dk = k0 >> 7, rem = k0 & 127, isim = rem >> 6, pp = rem & 63;
      const float* cs = (isim ? p.c_im : p.c_re) + ((size_t)((dk * 32 + g) * 16 + l15)) * 64 + pp;
      const float sg = isim ? -1.f : 1.f;
      float4 c0 = *(const float4*)cs, c1 = *(const float4*)(cs + 4);
      uint4 bb; bb.x = pk2(sg * c0.x, sg * c0.y); bb.y = pk2(sg * c0.z, sg * c0.w); bb.z = pk2(sg * c1.x, sg * c1.y); bb.w = pk2(sg * c1.z, sg * c1.w);
      bf16x8 bfr = __builtin_bit_cast(bf16x8, bb);
      bf16x8 a0 = *(const bf16x8*)(hm + (gl * 64 + tb0 * 16 + l15) * 264 + k0);
      bf16x8 a1 = *(const bf16x8*)(hm + (gl * 64 + (tb0 + 1) * 16 + l15) * 264 + k0);
      acc0 = MFMA16(a0, bfr, acc0);
      acc1 = MFMA16(a1, bfr, acc1);
    }
    const float dsk = p.d_skip[g * 16 + l15];
#pragma unroll
    for (int j = 0; j < 4; ++j) {
      int t = tb0 * 16 + lq * 4 + j;
      float y = acc0[j] + dsk * su[t * 32 + gl * 16 + l15];
      Z[tidx(g * 16 + l15, c * 64 + t, MT)] = f2bf(gelu_tanh(y));
      t += 16;
      y = acc1[j] + dsk * su[t * 32 + gl * 16 + l15];
      Z[tidx(g * 16 + l15, c * 64 + t, MT)] = f2bf(gelu_tanh(y));
    }
    __syncthreads();
  }
}

DI void s5_carry(const Params& p) {
  if (blockIdx.x >= 16) return;
  const int s = blockIdx.x * 256 + threadIdx.x;
  const int dir = s >> 11, g = (s >> 6) & 31, pp = s & 63;
  float abr, abi, cr, ci;
  s5_coeffs(p, dir, g, pp, abr, abi, cr, ci);
#pragma unroll
  for (int q = 0; q < 6; ++q) { float nr = abr * abr - abi * abi, ni = 2.f * abr * abi; abr = nr; abi = ni; }
  float2* base = (float2*)p.s5s + ((size_t)(dir * 32 + g) * NCHUNK) * 64 + pp;
  float hr = 0.f, hi = 0.f;
  for (int b = 0; b < 10; ++b) {
    float2 tmp[26];
#pragma unroll
    for (int j = 0; j < 26; ++j) {
      const int step = b * 26 + j;
      const int c = dir == 0 ? step : (step < 4 ? 3 - step : 263 - step);
      tmp[j] = base[(size_t)c * 64];
    }
#pragma unroll
    for (int j = 0; j < 26; ++j) {
      const int step = b * 26 + j;
      const int c = dir == 0 ? step : (step < 4 ? 3 - step : 263 - step);
      base[(size_t)c * 64] = make_float2(hr, hi);
      const float nr = abr * hr - abi * hi + tmp[j].x;
      const float ni = abr * hi + abi * hr + tmp[j].y;
      hr = nr; hi = ni;
    }
  }
}

DI unsigned gb_ld(unsigned* p) { return __hip_atomic_load(p, __ATOMIC_RELAXED, __HIP_MEMORY_SCOPE_AGENT); }
DI unsigned gb_add(unsigned* p, unsigned v) { return __hip_atomic_fetch_add(p, v, __ATOMIC_RELAXED, __HIP_MEMORY_SCOPE_AGENT); }
DI void grid_barrier(unsigned* bar, unsigned& epoch) {
  asm volatile("s_waitcnt vmcnt(0)" ::: "memory");
  __syncthreads();
  if (threadIdx.x == 0) {
    __builtin_amdgcn_fence(__ATOMIC_RELEASE, "agent");
    asm volatile("s_waitcnt vmcnt(0)" ::: "memory");
    const unsigned grp = blockIdx.x & 15u;
    const unsigned ngb = (gridDim.x + 15u - grp) >> 4;
    const unsigned old = gb_add(&bar[64 * (1 + grp)], 1u);
    if (old + 1u == (epoch + 1u) * ngb) {
      const unsigned ot = gb_add(&bar[64 * 17], 1u);
      if (ot + 1u == (epoch + 1u) * 16u) __hip_atomic_store(&bar[0], epoch + 1u, __ATOMIC_RELAXED, __HIP_MEMORY_SCOPE_AGENT);
    }
    while (gb_ld(&bar[0]) < epoch + 1u) __builtin_amdgcn_s_sleep(1);
    __builtin_amdgcn_fence(__ATOMIC_ACQUIRE, "agent");
    asm volatile("s_waitcnt vmcnt(0)" ::: "memory");
  }
  epoch++;
  __syncthreads();
}

#define XB_TMO      128
#define XB_XCNT(j)  (256  + 64 * (j))
#define XB_XSUB(j)  (1280 + 64 * (j))
#define XB_XGEN(j)  (2304 + 64 * (j))
#define XB_TOP      3328
#define XB_TOPGEN   3392
#define XCD_BAR_WORDS 3456
#define XB_SPIN_CAP (1u << 18)
#define LAS __attribute__((address_space(3)))

__device__ __forceinline__ unsigned xb_ld(unsigned* p)              { return __hip_atomic_load(p, __ATOMIC_RELAXED, __HIP_MEMORY_SCOPE_AGENT); }
__device__ __forceinline__ unsigned xb_add(unsigned* p, unsigned v) { return __hip_atomic_fetch_add(p, v, __ATOMIC_RELAXED, __HIP_MEMORY_SCOPE_AGENT); }
__device__ __forceinline__ unsigned xb_xcc_id() { return (unsigned)__builtin_amdgcn_s_getreg((3 << 11) | 20) & 0xFu; }
#define XB_SPIN(cond, bar) do { unsigned _sp = 0; while (cond) { __builtin_amdgcn_s_sleep(1); \
    if ((++_sp & 255u) == 0u) { if (xb_ld(&(bar)[XB_TMO])) break; if (_sp > XB_SPIN_CAP) { atomicAdd(&(bar)[XB_TMO], 1u); break; } } } } while (0)

struct XcdBarrier {
    unsigned* bar; unsigned x;
    volatile LAS unsigned* st;
};

__device__ __forceinline__ XcdBarrier xcd_barrier_post(unsigned* bar, volatile LAS unsigned* st) {
    XcdBarrier b; b.bar = bar; b.x = xb_xcc_id(); b.st = st;
    if (threadIdx.x == 0) (void)xb_add(&bar[XB_XCNT(b.x)], 1u);
    return b;
}
__device__ __forceinline__ void xcd_barrier_complete(unsigned* bar, unsigned x, unsigned& nloc, unsigned& nx) {
    const unsigned G = gridDim.x * gridDim.y * gridDim.z;
    unsigned sum, cnt, mine, sp = 0u;
    for (;;) {
        sum = 0u; cnt = 0u; mine = 0u;
#pragma unroll
        for (unsigned j = 0; j < 16; ++j) { const unsigned c = xb_ld(&bar[XB_XCNT(j)]); sum += c; cnt += (c > 0u) ? 1u : 0u; mine = (j == x) ? c : mine; }
        if (sum == G) break;
        __builtin_amdgcn_s_sleep(1);
        if ((++sp & 255u) == 0u) { if (xb_ld(&bar[XB_TMO])) break; if (sp > XB_SPIN_CAP) { atomicAdd(&bar[XB_TMO], 1u); break; } }
    }
    nloc = mine > 0u ? mine : 1u; nx = cnt > 0u ? cnt : 1u;
}

__device__ __forceinline__ void xcd_barrier(const XcdBarrier& b) {
    asm volatile("s_waitcnt vmcnt(0)" ::: "memory");
    __syncthreads();
    if (threadIdx.x == 0) {
        unsigned* bar = b.bar;
        __builtin_amdgcn_s_waitcnt(0);
        unsigned nloc = b.st[0], nx = b.st[1];
        if (nloc == 0u) { xcd_barrier_complete(bar, b.x, nloc, nx); b.st[0] = nloc; b.st[1] = nx; }
        const unsigned old = xb_add(&bar[XB_XSUB(b.x)], 1u);
        const unsigned gen = old / nloc;
        if (old + 1u == (gen + 1u) * nloc) {
            __builtin_amdgcn_fence(__ATOMIC_RELEASE, "agent");
            asm volatile("s_waitcnt vmcnt(0)" ::: "memory");
            const unsigned og = xb_add(&bar[XB_TOP], 1u);
            const unsigned tg = og / nx;
            if (og + 1u == (tg + 1u) * nx) xb_add(&bar[XB_TOPGEN], 1u);
            else XB_SPIN(xb_ld(&bar[XB_TOPGEN]) == tg, bar);
            __builtin_amdgcn_fence(__ATOMIC_ACQUIRE, "agent");
            xb_add(&bar[XB_XGEN(b.x)], 1u);
            asm volatile("s_waitcnt vmcnt(0)" ::: "memory");
        } else {
            XB_SPIN(xb_ld(&bar[XB_XGEN(b.x)]) == gen, bar);
            __builtin_amdgcn_fence(__ATOMIC_ACQUIRE, "agent");
            asm volatile("s_waitcnt vmcnt(0)" ::: "memory");
        }
    }
    __syncthreads();
}


__global__ void __launch_bounds__(256, 2) fwd_megakernel(Params p) {
  extern __shared__ __attribute__((aligned(16))) char smem[];
  cg::grid_group grid = cg::this_grid();
  const size_t RW = (size_t)MT * DM;
  u16* A2 = p.H;
  u16* Qb = (u16*)p.Y;
  u16* Kb = Qb + RW / 2;
  u16* Vt = Kb + RW / 2;
  const float* mod0 = p.mod;
  const float* mod1 = p.mod + 2 * 6 * DM;

  unsigned epoch = 0; (void)epoch;
  __shared__ uint4 xb_words;
  if (threadIdx.x == 0) xb_words = make_uint4(0u, 0u, 0u, 0u);
  __syncthreads();
  const XcdBarrier xb = xcd_barrier_post(p.bar, (volatile LAS unsigned*)&xb_words);
  if (p.ph_lo < 0) grid.sync();
#define PHASE_BEGIN(k) if ((k) >= p.ph_lo && (k) < p.ph_hi) { if ((k) > p.ph_lo) xcd_barrier(xb);
#define PHASE_END }

  PHASE_BEGIN(0) for (int rep = 0; rep < REP_P; ++rep) phase_prep_weights(p, smem); PHASE_END

  PHASE_BEGIN(1)
    for (int rep = 0; rep < REP_O; ++rep) phase_rows<false, true>(p, 0, MT, p.ctx, p.x, nullptr, nullptr, nullptr, nullptr, 0, nullptr, mod0, 0, p.norm_pre, p.H);
  PHASE_END

  PHASE_BEGIN(2) {
    GemmDesc g{}; g.A = p.H; g.Bt = p.wt_in0; g.lda = DM; g.K = DM; g.nN = 18; g.tm0 = 0; g.nM = 65;
    g.d0 = p.big; g.ld0 = 1536; g.d1 = p.big + (size_t)MT * 1536; g.ld1 = 768; g.split = 1536;
    phase_gemm<EPI_SPLIT>(g, smem);
  } PHASE_END

  PHASE_BEGIN(3) {
    const u16* G = p.big; const u16* QKV = p.big + (size_t)MT * 1536;
    for (int rep = 0; rep < REP_O; ++rep) {
    qk_prep(QKV, 768, 0, 8, Qb, p.ev_q_norm, 0.125f * LOG2E, 0);
    qk_prep(QKV, 768, 512, 2, Kb, p.ev_k_norm, 1.f, 0);
    v_transpose(QKV, 768, 640, 128, Vt, smem);
    gated_conv(p, G, A2);
    }
  } PHASE_END

  PHASE_BEGIN(4) {
    const int w = threadIdx.x >> 6;
    const int nlat = 8 * 128, nctx = 8 * 2;
    for (int t0 = blockIdx.x; t0 < (nlat + nctx) * REP_A; t0 += gridDim.x) {
      const int t = t0 % (nlat + nctx);
      int head, q0, nkt;
      if (t < nlat) { head = t & 7; q0 = CTXN + (t >> 3) * 128; nkt = NCHUNK; }
      else { int tt = t - nlat; head = tt & 7; q0 = (tt >> 3) * 128; nkt = CTXN / 64; }
      attn_task<64, 1>(smem, Qb, Kb, Vt, head, 0, q0 + 32 * w, head >> 2, head >> 2, nkt, A2, 512 + head * 64, 0.f, 0.f, nullptr);
    }
  } PHASE_END

  PHASE_BEGIN(5) {
    GemmDesc g{}; g.A = A2; g.Bt = p.wt_out0; g.lda = DM; g.K = DM; g.nN = 8; g.tm0 = 0; g.nM = 65;
    g.d0 = p.Y; g.ld0 = DM;
    phase_gemm<EPI_F32>(g, smem);
  } PHASE_END

  PHASE_BEGIN(6)
    for (int rep = 0; rep < REP_O; ++rep) phase_rows<true, true>(p, 0, MT, p.ctx, p.x, p.xctx, p.out, (const u16*)p.Y, mod0, 2, p.norm_post, mod0, 3, p.norm_pre + DM, p.H);
  PHASE_END

  PHASE_BEGIN(7) {
    GemmDesc g{}; g.A = p.H; g.Bt = p.wt_up0; g.lda = DM; g.K = DM; g.nN = 44; g.tm0 = 0; g.nM = 67;
    g.d0 = p.big; g.cw = p.ffn_conv_w; g.cb = p.ffn_conv_b; g.zrow = (const u16*)(p.bar + 4096);
    phase_gemm<EPI_FFNUP>(g, smem);
  } PHASE_END

  PHASE_BEGIN(8) {
    GemmDesc g{}; g.A = p.big; g.Bt = p.wt_dn0; g.lda = DFF; g.K = DFF; g.nN = 8; g.tm0 = 0; g.nM = 65;
    g.d0 = p.Y; g.ld0 = DM;
    phase_gemm<EPI_F32>(g, smem);
  } PHASE_END

  PHASE_BEGIN(9)
    phase_rows<true, true>(p, 0, MT, p.xctx, p.out, p.xctx, p.out, (const u16*)p.Y, mod0, 5, p.norm_post + DM, mod1, 0, p.norm_pre + 2 * DM, p.H);
  PHASE_END

  u16* U1 = p.big;
  u16* QKV1 = p.big + (size_t)MT * 512;
  u16* Z = p.big + (size_t)MT * 2048;

  PHASE_BEGIN(10) {
    GemmDesc g{}; g.A = p.H; g.Bt = p.wt_in1; g.lda = DM; g.K = DM; g.nN = 16; g.tm0 = 0; g.nM = 65;
    g.d0 = U1; g.ld0 = 512; g.d1 = QKV1; g.ld1 = 1536; g.split = 512;
    phase_gemm<EPI_SPLIT>(g, smem);
  } PHASE_END

  PHASE_BEGIN(11) {
    for (int rep = 0; rep < REP_O; ++rep) {
    qk_prep(QKV1, 1536, 0, 8, Qb, nullptr, 0.125f * LOG2E, CTXN);
    qk_prep(QKV1, 1536, 512, 8, Kb, nullptr, 1.f, 0);
    v_transpose(QKV1, 1536, 1024, 512, Vt, smem);
    }
    for (int t0 = blockIdx.x; t0 < 16 * NCHUNK * REP_S; t0 += gridDim.x) { const int t = t0 % (16 * NCHUNK); s5_task<false>(p, smem, t & 15, t >> 4, U1, Z); }
  } PHASE_END

  PHASE_BEGIN(12) {
    s5_carry(p);
    float lam;
    {
      const int lane = threadIdx.x & 63;
      float s1 = wsum(p.lam_q1[lane] * p.lam_k1[lane]);
      float s2 = wsum(p.lam_q2[lane] * p.lam_k2[lane]);
      lam = expf(s1) - expf(s2) + 0.35550906759f;
    }
    const int w = threadIdx.x >> 6;
    for (int t0 = blockIdx.x; t0 < 4 * 256 * REP_A; t0 += gridDim.x) {
      const int t = t0 & 1023;
      const int head = t & 3, q0 = CTXN + (t >> 2) * 64;
      attn_task<128, 2>(smem, Qb, Kb, Vt, head * 2 + (w & 1), w & 1, q0 + 32 * (w >> 1), head * 2, head, NCHUNK, A2, 512 + head * 128,
                        lam, 0.35550906759f, p.subln);
    }
  } PHASE_END

  PHASE_BEGIN(13) {
    for (int t0 = blockIdx.x; t0 < 16 * (NCHUNK - 4) * REP_S; t0 += gridDim.x) { const int t = t0 % (16 * (NCHUNK - 4)); s5_task<true>(p, smem, t & 15, 4 + (t >> 4), U1, Z); }
  } PHASE_END

  PHASE_BEGIN(14) {
    GemmDesc g{}; g.A = Z; g.Bt = p.wt_glu; g.lda = 512; g.K = 512; g.nN = 8; g.tm0 = 1; g.nM = 64;
    g.d0 = A2; g.ld0 = DM;
    phase_gemm<EPI_GLU>(g, smem);
  } PHASE_END

  PHASE_BEGIN(15) {
    GemmDesc g{}; g.A = A2; g.Bt = p.wt_out1; g.lda = DM; g.K = DM; g.nN = 8; g.tm0 = 1; g.nM = 64;
    g.d0 = p.Y; g.ld0 = DM;
    phase_gemm<EPI_F32>(g, smem);
  } PHASE_END

  PHASE_BEGIN(16)
    phase_rows<true, true>(p, CTXN, MT, p.xctx, p.out, p.xctx, p.out, (const u16*)p.Y, mod1, 2, p.norm_post + 2 * DM, mod1, 3, p.norm_pre + 3 * DM, p.H);
  PHASE_END

  PHASE_BEGIN(17) {
    GemmDesc g{}; g.A = p.H; g.Bt = p.wt_up1; g.lda = DM; g.K = DM; g.nN = 44; g.tm0 = 2; g.nM = 65;
    g.d0 = p.big; g.cw = p.ffn_conv_w + 3 * 2 * DFF; g.cb = p.ffn_conv_b + 2 * DFF; g.zrow = (const u16*)(p.bar + 4096);
    phase_gemm<EPI_FFNUP>(g, smem);
  } PHASE_END

  PHASE_BEGIN(18) {
    GemmDesc g{}; g.A = p.big; g.Bt = p.wt_dn1; g.lda = DFF; g.K = DFF; g.nN = 8; g.tm0 = 1; g.nM = 64;
    g.d0 = p.Y; g.ld0 = DM;
    phase_gemm<EPI_F32>(g, smem);
  } PHASE_END

  PHASE_BEGIN(19)
    phase_rows<true, false>(p, CTXN, MT, p.xctx, p.out, p.xctx, p.out, (const u16*)p.Y, mod1, 5, p.norm_post + 3 * DM, nullptr, 0, nullptr, nullptr);
  PHASE_END
}

extern "C" void kernel_launch(void* const* d_in, const int* in_sizes, int n_in, void* d_out, int out_size, void* d_ws,
                              size_t ws_size, hipStream_t stream) {
  static int grid_blocks = 0;
  if (!grid_blocks) {
    hipFuncSetAttribute((const void*)fwd_megakernel, hipFuncAttributeMaxDynamicSharedMemorySize, LDS_BYTES);
    int dev = 0, cus = 0, per_cu = 0;
    hipGetDevice(&dev);
    hipDeviceGetAttribute(&cus, hipDeviceAttributeMultiprocessorCount, dev);
    hipOccupancyMaxActiveBlocksPerMultiprocessor(&per_cu, fwd_megakernel, 256, LDS_BYTES);
    if (per_cu > 2) per_cu = 2;
    grid_blocks = cus * per_cu;
  }
  Params p{};
  const float* const* in = (const float* const*)d_in;
  p.x = in[0]; p.c = in[1]; p.ctx = in[2]; p.c_ctx = in[3]; p.mod_w = in[4]; p.mod_b = in[5]; p.norm_pre = in[6]; p.norm_post = in[7];
  p.ffn_w_up = in[8]; p.ffn_conv_w = in[9]; p.ffn_conv_b = in[10]; p.ffn_w_down = in[11];
  p.ev_w_in = in[12]; p.ev_conv_w = in[13]; p.ev_q_norm = in[14]; p.ev_k_norm = in[15]; p.ev_w_out = in[16];
  p.od_w_in = in[17]; p.a_re = in[18]; p.a_im = in[19]; p.log_dt = in[20]; p.b_re = in[21]; p.b_im = in[22]; p.c_re = in[23]; p.c_im = in[24];
  p.d_skip = in[25]; p.glu_w = in[26]; p.lam_q1 = in[27]; p.lam_k1 = in[28]; p.lam_q2 = in[29]; p.lam_k2 = in[30]; p.subln = in[31]; p.od_w_out = in[32];
  p.out = (float*)d_out;
  char* ws = (char*)d_ws;
  size_t off = 0;
  auto take = [&](size_t bytes) { char* r = ws + off; off += (bytes + 255) & ~(size_t)255; return r; };
  p.wt_in0 = (u16*)take((size_t)2304 * 1024 * 2);
  p.wt_out0 = (u16*)take((size_t)1024 * 1024 * 2);
  p.wt_up0 = (u16*)take((size_t)2 * DFF * 1024 * 2);
  p.wt_dn0 = (u16*)take((size_t)1024 * DFF * 2);
  p.wt_in1 = (u16*)take((size_t)2048 * 1024 * 2);
  p.wt_glu = (u16*)take((size_t)1024 * 512 * 2);
  p.wt_out1 = (u16*)take((size_t)1024 * 1024 * 2);
  p.wt_up1 = (u16*)take((size_t)2 * DFF * 1024 * 2);
  p.wt_dn1 = (u16*)take((size_t)1024 * DFF * 2);
  p.mod = (float*)take((size_t)2 * 2 * 6 * DM * 4);
  p.xctx = (float*)take((size_t)CTXN * DM * 4);
  p.s5s = (float*)take((size_t)2 * 32 * NCHUNK * 64 * 8);
  p.H = (u16*)take((size_t)MT * DM * 2);
  p.Y = (float*)take((size_t)MT * DM * 4);
  p.big = (u16*)take((size_t)MT * DFF * 2);
  p.bar = (unsigned*)take(20480);
  p.ph_lo = 0; p.ph_hi = 20;
  if (off > ws_size) { fprintf(stderr, "workspace too small: need %zu have %zu\n", off, ws_size); }
  (void)hipMemsetAsync(p.bar, 0, 20480, stream);
  void* args[] = {&p};
  hipError_t e = hipLaunchCooperativeKernel((const void*)fwd_megakernel, dim3(grid_blocks), dim3(256), args, LDS_BYTES, stream);
  if (e != hipSuccess) fprintf(stderr, "cooperative launch failed: %s (grid %d)\n", hipGetErrorString(e), grid_blocks);
}
```

```cpp
#include <hip/hip_runtime.h>
#include <hip/hip_cooperative_groups.h>
#include <stdint.h>
#include <stdio.h>
namespace cg = cooperative_groups;

#define DI __device__ __forceinline__
typedef unsigned short u16;
typedef short bf16x8 __attribute__((ext_vector_type(8)));
typedef float f32x16 __attribute__((ext_vector_type(16)));
typedef float f32x4 __attribute__((ext_vector_type(4)));
typedef __bf16 bf2_t __attribute__((ext_vector_type(2)));
typedef float f2_t __attribute__((ext_vector_type(2)));

constexpr int DM = 1024;
constexpr int LSEQ = 16384;
constexpr int CTXN = 256;
constexpr int MT = LSEQ + CTXN;
constexpr int DFF = 2816;
constexpr int NCHUNK = MT / 64;
constexpr int LDS_BYTES = 77824;
#ifndef REP_A
#define REP_A 1
#endif
#ifndef REP_G
#define REP_G 1
#endif
#ifndef REP_O
#define REP_O 1
#endif
#ifndef REP_P
#define REP_P 1
#endif
#ifndef KREP
#define KREP 1
#endif
#ifndef REP_S
#define REP_S 1
#endif
constexpr float LOG2E = 1.4426950408889634f;

DI unsigned pk2(float a, float b) { f2_t v = {a, b}; bf2_t r = __builtin_convertvector(v, bf2_t); return __builtin_bit_cast(unsigned, r); }
DI u16 f2bf(float a) { return (u16)(pk2(a, 0.f) & 0xffffu); }
DI float bflo(unsigned v) { return __uint_as_float(v << 16); }
DI float bfhi(unsigned v) { return __uint_as_float(v & 0xffff0000u); }
DI float bf2f(u16 v) { return __uint_as_float(((unsigned)v) << 16); }
DI size_t tidx(int col, int row, int nrows) { return ((size_t)(col >> 5) * nrows + row) * 32 + (col & 31); }
DI int crow(int i, int h) { return (i & 3) + 8 * (i >> 2) + 4 * h; }
DI float wsum(float v) {
  v += __shfl_xor(v, 32); v += __shfl_xor(v, 16); v += __shfl_xor(v, 8);
  v += __shfl_xor(v, 4); v += __shfl_xor(v, 2); v += __shfl_xor(v, 1); return v;
}
DI float hsum32(float v) {
  v += __shfl_xor(v, 16); v += __shfl_xor(v, 8); v += __shfl_xor(v, 4); v += __shfl_xor(v, 2); v += __shfl_xor(v, 1); return v;
}
DI float silu_f(float x) { return x / (1.f + __expf(-x)); }
DI float sigmoid_f(float x) { return 1.f / (1.f + __expf(-x)); }
DI float gelu_tanh(float x) {
  float a = 0.7978845608028654f * (x + 0.044715f * x * x * x);
  float t = 1.f - 2.f / (__expf(2.f * a) + 1.f);
  return 0.5f * x * (1.f + t);
}
#define MFMA32(a, b, c) __builtin_amdgcn_mfma_f32_32x32x16_bf16((a), (b), (c), 0, 0, 0)
#define MFMA16(a, b, c) __builtin_amdgcn_mfma_f32_16x16x32_bf16((a), (b), (c), 0, 0, 0)

struct Params {
  const float *x, *c, *ctx, *c_ctx, *mod_w, *mod_b, *norm_pre, *norm_post, *ffn_w_up, *ffn_conv_w, *ffn_conv_b, *ffn_w_down;
  const float *ev_w_in, *ev_conv_w, *ev_q_norm, *ev_k_norm, *ev_w_out;
  const float *od_w_in, *a_re, *a_im, *log_dt, *b_re, *b_im, *c_re, *c_im, *d_skip, *glu_w;
  const float *lam_q1, *lam_k1, *lam_q2, *lam_k2, *subln, *od_w_out;
  float* out;
  u16 *wt_in0, *wt_out0, *wt_up0, *wt_dn0, *wt_in1, *wt_glu, *wt_out1, *wt_up1, *wt_dn1;
  float* mod;
  float* xctx;
  float* s5s;
  u16* H;
  float* Y;
  u16* big;
  unsigned* bar;
  int ph_lo, ph_hi;
};

DI int perm_row(int kind, int n) {
  if (kind == 1) {
    if (n < DFF) return (n >> 6) * 128 + (n & 63);
    int m = n - DFF; return (m >> 6) * 128 + 64 + (m & 63);
  } else if (kind == 2) {
    if (n < 512) return (n >> 5) * 64 + (n & 31);
    int m = n - 512; return (m >> 5) * 64 + 32 + (m & 31);
  }
  return n;
}

DI void transpose_tile(const float* __restrict__ W, int K, int N, u16* __restrict__ Wt, int kind, int tile, float* sm) {
  const int nN = N >> 6;
  const int k0 = (tile / nN) * 64, n0 = (tile % nN) * 64;
  const int tid = threadIdx.x;
  for (int r = tid >> 6; r < 64; r += 4) sm[r * 65 + (tid & 63)] = W[(size_t)(k0 + r) * N + n0 + (tid & 63)];
  __syncthreads();
  const int kk = (tid & 31) * 2;
  for (int n = tid >> 5; n < 64; n += 8) {
    unsigned v = pk2(sm[kk * 65 + n], sm[(kk + 1) * 65 + n]);
    *(unsigned*)(Wt + tidx(k0 + kk, perm_row(kind, n0 + n), N)) = v;
  }
  __syncthreads();
}

DI void phase_prep_weights(const Params& p, char* smem) {
  float* sm = (float*)smem;
  const float* srcs[9] = {p.ev_w_in, p.ev_w_out, p.ffn_w_up, p.ffn_w_down, p.od_w_in, p.glu_w, p.od_w_out,
                          p.ffn_w_up + (size_t)DM * 2 * DFF, p.ffn_w_down + (size_t)DFF * DM};
  u16* dsts[9] = {p.wt_in0, p.wt_out0, p.wt_up0, p.wt_dn0, p.wt_in1, p.wt_glu, p.wt_out1, p.wt_up1, p.wt_dn1};
  const int Ks[9] = {1024, 1024, 1024, DFF, 1024, 512, 1024, 1024, DFF};
  const int Ns[9] = {2304, 1024, 2 * DFF, 1024, 2048, 1024, 1024, 2 * DFF, 1024};
  const int kinds[9] = {0, 0, 1, 0, 0, 2, 0, 1, 0};
  int total = 0;
#pragma unroll
  for (int i = 0; i < 9; ++i) total += (Ks[i] >> 6) * (Ns[i] >> 6);
  const int NMOD = 192;
  for (int t = blockIdx.x; t < NMOD + total; t += gridDim.x) {
    if (t < NMOD) {
      const int layer = t / 96, cgp = t % 96;
      const int tid = threadIdx.x, col = cgp * 64 + (tid & 63), kq = tid >> 6;
      const float* W = p.mod_w + (size_t)layer * DM * 6 * DM;
      float* ssc = sm + 1024;
      for (int k = tid; k < DM; k += 256) { ssc[k] = silu_f(p.c[k]); ssc[DM + k] = silu_f(p.c_ctx[k]); }
      __syncthreads();
      float a0 = 0.f, a1 = 0.f;
      const float* wp = W + (size_t)(kq * 256) * (6 * DM) + col;
#pragma unroll 8
      for (int k = 0; k < 256; ++k) {
        const float w = wp[(size_t)k * (6 * DM)];
        a0 += ssc[kq * 256 + k] * w;
        a1 += ssc[DM + kq * 256 + k] * w;
      }
      sm[(kq * 64 + (tid & 63)) * 2] = a0;
      sm[(kq * 64 + (tid & 63)) * 2 + 1] = a1;
      __syncthreads();
      if (tid < 128) {
        int cc = tid & 63, which = tid >> 6;
        float s = 0.f;
        for (int q = 0; q < 4; ++q) s += sm[(q * 64 + cc) * 2 + which];
        int colo = cgp * 64 + cc;
        p.mod[(size_t)(layer * 2 + which) * 6 * DM + colo] = s + p.mod_b[layer * 6 * DM + colo];
      }
      __syncthreads();
    } else {
      int tt = t - NMOD;
#pragma unroll
      for (int i = 0; i < 9; ++i) {
        int cnt = (Ks[i] >> 6) * (Ns[i] >> 6);
        if (tt >= 0 && tt < cnt) transpose_tile(srcs[i], Ks[i], Ns[i], dsts[i], kinds[i], tt, sm);
        tt -= cnt;
      }
    }
  }
}

template <bool HAS_Y, bool HAS_H>
DI void phase_rows(const Params& p, int row0, int row1, const float* xin_ctx, const float* xin_lat,
                   float* xout_ctx, float* xout_lat, const u16* Y, const float* modl  ,
                   int gate_idx, const float* gpost, const float* modh  , int shift_idx,
                   const float* gpre, u16* Hout) {
  const int lane = threadIdx.x & 63;
  const int wid = blockIdx.x * 4 + (threadIdx.x >> 6), nw = gridDim.x * 4;
#pragma unroll 1
  for (int pass = 0; pass < 2; ++pass) {
    const bool isc = pass == 0;
    const int ra = isc ? row0 : max(row0, CTXN);
    const int rb = isc ? min(row1, CTXN) : row1;
    if (ra + wid >= rb) continue;
    float4 va[4], vb[4], vc[4];
#pragma unroll
    for (int j = 0; j < 4; ++j) {
      const int c = j * 256 + lane * 4;
      if (HAS_Y) {
        float4 g = *(const float4*)(gpost + c);
        float4 gg = *(const float4*)(modl + (size_t)(isc ? 6 : 0) * DM + gate_idx * DM + c);
        va[j] = make_float4(g.x * gg.x, g.y * gg.y, g.z * gg.z, g.w * gg.w);
      }
      if (HAS_H) {
        const float* sh = modh + (size_t)(isc ? 6 : 0) * DM + shift_idx * DM;
        float4 g = *(const float4*)(gpre + c);
        float4 s1 = *(const float4*)(sh + c);
        float4 s2 = *(const float4*)(sh + DM + c);
        vb[j] = make_float4(g.x * (1.f + s2.x), g.y * (1.f + s2.y), g.z * (1.f + s2.z), g.w * (1.f + s2.w));
        vc[j] = s1;
      }
    }
    const float* xin = isc ? xin_ctx : xin_lat - (size_t)CTXN * DM;
    float* xout = isc ? xout_ctx : xout_lat - (size_t)CTXN * DM;
#pragma unroll 1
    for (int row = ra + wid; row < rb; row += 2 * nw) {
      const int rowB = row + nw;
      const bool hasB = rowB < rb;
      const int rB = hasB ? rowB : row;
      float4 xa[4], xb[4], ya[4], yb[4];
#pragma unroll
      for (int j = 0; j < 4; ++j) {
        xa[j] = *(const float4*)(xin + (size_t)row * DM + j * 256 + lane * 4);
        xb[j] = *(const float4*)(xin + (size_t)rB * DM + j * 256 + lane * 4);
        if (HAS_Y) {
          const uint2 ua = *(const uint2*)(Y + (size_t)row * DM + j * 256 + lane * 4);
          const uint2 ub = *(const uint2*)(Y + (size_t)rB * DM + j * 256 + lane * 4);
          ya[j] = make_float4(bflo(ua.x), bfhi(ua.x), bflo(ua.y), bfhi(ua.y));
          yb[j] = make_float4(bflo(ub.x), bfhi(ub.x), bflo(ub.y), bfhi(ub.y));
        }
      }
      if (HAS_Y) {
        float sa = 0.f, sb2 = 0.f;
#pragma unroll
        for (int j = 0; j < 4; ++j) {
          sa += ya[j].x * ya[j].x + ya[j].y * ya[j].y + ya[j].z * ya[j].z + ya[j].w * ya[j].w;
          sb2 += yb[j].x * yb[j].x + yb[j].y * yb[j].y + yb[j].z * yb[j].z + yb[j].w * yb[j].w;
        }
        sa = wsum(sa); sb2 = wsum(sb2);
        const float ia = rsqrtf(sa * (1.f / DM) + 1e-6f), ib = rsqrtf(sb2 * (1.f / DM) + 1e-6f);
#pragma unroll
        for (int j = 0; j < 4; ++j) {
          xa[j].x += va[j].x * (ya[j].x * ia); xa[j].y += va[j].y * (ya[j].y * ia); xa[j].z += va[j].z * (ya[j].z * ia); xa[j].w += va[j].w * (ya[j].w * ia);
          xb[j].x += va[j].x * (yb[j].x * ib); xb[j].y += va[j].y * (yb[j].y * ib); xb[j].z += va[j].z * (yb[j].z * ib); xb[j].w += va[j].w * (yb[j].w * ib);
          *(float4*)(xout + (size_t)row * DM + j * 256 + lane * 4) = xa[j];
          if (hasB) *(float4*)(xout + (size_t)rowB * DM + j * 256 + lane * 4) = xb[j];
        }
      }
      if (HAS_H) {
        float sa = 0.f, sb2 = 0.f;
#pragma unroll
        for (int j = 0; j < 4; ++j) {
          sa += xa[j].x * xa[j].x + xa[j].y * xa[j].y + xa[j].z * xa[j].z + xa[j].w * xa[j].w;
          sb2 += xb[j].x * xb[j].x + xb[j].y * xb[j].y + xb[j].z * xb[j].z + xb[j].w * xb[j].w;
        }
        sa = wsum(sa); sb2 = wsum(sb2);
        const float ia = rsqrtf(sa * (1.f / DM) + 1e-6f), ib = rsqrtf(sb2 * (1.f / DM) + 1e-6f);
#pragma unroll
        for (int j = 0; j < 4; ++j) {
          uint2 o;
          o.x = pk2(xa[j].x * ia * vb[j].x + vc[j].x, xa[j].y * ia * vb[j].y + vc[j].y);
          o.y = pk2(xa[j].z * ia * vb[j].z + vc[j].z, xa[j].w * ia * vb[j].w + vc[j].w);
          *(uint2*)(Hout + tidx(j * 256 + lane * 4, row, MT)) = o;
          if (hasB) {
            o.x = pk2(xb[j].x * ib * vb[j].x + vc[j].x, xb[j].y * ib * vb[j].y + vc[j].y);
            o.y = pk2(xb[j].z * ib * vb[j].z + vc[j].z, xb[j].w * ib * vb[j].w + vc[j].w);
            *(uint2*)(Hout + tidx(j * 256 + lane * 4, rowB, MT)) = o;
          }
        }
      }
    }
  }
}

enum { EPI_SPLIT = 0, EPI_F32 = 1, EPI_GLU = 2, EPI_FFNUP = 3 };
struct GemmDesc {
  const u16* A; const u16* Bt; int lda; int K; int nN; int tm0; int nM;
  void* d0; void* d1; int ld0; int ld1; int split;
  const float* cw; const float* cb;
  const u16* zrow;
};

template <int MODE>
DI void gemm_tile(const GemmDesc& g, char* smem, int tmi, int tn) {
  const int tid = threadIdx.x, lane = tid & 63, w = tid >> 6, h = lane >> 5, l31 = lane & 31;
  const int wm = w >> 1, wn = w & 1;
  constexpr int ASZ = 256 * 64, BSZ = 128 * 64, STG = ASZ + BSZ;
  int seq_base = 0, seq_len = MT, vrow0 = tmi * 256;
  if (MODE == EPI_FFNUP) {
    if (tmi < 2) { seq_base = 0; seq_len = CTXN; vrow0 = 254 * tmi - 1; }
    else { seq_base = CTXN; seq_len = LSEQ; vrow0 = 254 * (tmi - 2) - 1; }
  }
  const int gkc = ((tid & 3) ^ ((tid >> 4) & 3)) * 8;
  const u16* arow[4];
  int astr[4];
#pragma unroll
  for (int j = 0; j < 4; ++j) {
    const int r = (tid >> 2) + 64 * j;
    if (MODE == EPI_FFNUP) {
      const int v = vrow0 + r;
      const bool ok = (v >= 0 && v < seq_len);
      arow[j] = ok ? g.A + (size_t)(seq_base + v) * 32 + gkc : g.zrow + gkc;
      astr[j] = ok ? MT * 32 : 0;
    } else {
      arow[j] = g.A + (size_t)(vrow0 + r) * 32 + gkc;
      astr[j] = MT * 32;
    }
  }
  const u16* brow[2];
#pragma unroll
  for (int j = 0; j < 2; ++j) brow[j] = g.Bt + (size_t)(tn * 128 + (tid >> 2) + 64 * j) * 32 + gkc;
  const int bstr = g.nN * 128 * 32;
  f32x16 acc[4][2];
#pragma unroll
  for (int a = 0; a < 4; ++a)
#pragma unroll
    for (int b = 0; b < 2; ++b)
#pragma unroll
      for (int i = 0; i < 16; ++i) acc[a][b][i] = 0.f;

  const int nk0 = g.K >> 5;
  const int nk = nk0 * KREP;
  char* dma_dst = smem + (w * 64) * 16;
#define G_DMA(kt_, stg) { char* d_ = dma_dst + (stg) * STG; const int kq_ = (KREP == 1) ? (kt_) : ((kt_) % nk0); \
    __builtin_amdgcn_global_load_lds((const unsigned*)(arow[0] + (size_t)(kq_) * astr[0]), (unsigned*)(d_), 16, 0, 0); \
    __builtin_amdgcn_global_load_lds((const unsigned*)(arow[1] + (size_t)(kq_) * astr[1]), (unsigned*)(d_ + 4096), 16, 0, 0); \
    __builtin_amdgcn_global_load_lds((const unsigned*)(arow[2] + (size_t)(kq_) * astr[2]), (unsigned*)(d_ + 8192), 16, 0, 0); \
    __builtin_amdgcn_global_load_lds((const unsigned*)(arow[3] + (size_t)(kq_) * astr[3]), (unsigned*)(d_ + 12288), 16, 0, 0); \
    __builtin_amdgcn_global_load_lds((const unsigned*)(brow[0] + (size_t)(kq_) * bstr), (unsigned*)(d_ + ASZ), 16, 0, 0); \
    __builtin_amdgcn_global_load_lds((const unsigned*)(brow[1] + (size_t)(kq_) * bstr), (unsigned*)(d_ + ASZ + 4096), 16, 0, 0); }
  const int sw = (l31 >> 2) & 3;
  const int aoff0 = (wm * 128 + l31) * 64 + ((h ^ sw) * 16);
  const int aoff1 = (wm * 128 + l31) * 64 + (((2 + h) ^ sw) * 16);
  const int boff0 = ASZ + (wn * 64 + l31) * 64 + ((h ^ sw) * 16);
  const int boff1 = ASZ + (wn * 64 + l31) * 64 + (((2 + h) ^ sw) * 16);
#define G_COMPUTE(stg) { const char* sb_ = smem + (stg) * STG; \
    _Pragma("unroll") for (int ks = 0; ks < 2; ++ks) { \
      bf16x8 af[4], bf[2]; \
      _Pragma("unroll") for (int mi = 0; mi < 4; ++mi) af[mi] = *(const bf16x8*)(sb_ + (ks ? aoff1 : aoff0) + mi * 32 * 64); \
      _Pragma("unroll") for (int ni = 0; ni < 2; ++ni) bf[ni] = *(const bf16x8*)(sb_ + (ks ? boff1 : boff0) + ni * 32 * 64); \
      _Pragma("unroll") for (int mi = 0; mi < 4; ++mi) \
        _Pragma("unroll") for (int ni = 0; ni < 2; ++ni) acc[mi][ni] = MFMA32(af[mi], bf[ni], acc[mi][ni]); \
    } }
#define RAW_BARRIER() { asm volatile("s_waitcnt lgkmcnt(0)" ::: "memory"); __builtin_amdgcn_s_barrier(); }
  G_DMA(0, 0);
  G_DMA(1, 1);
  int stg = 0;
#define SB_ __builtin_amdgcn_sched_barrier(0)
#define DMA1(ptr, off) __builtin_amdgcn_global_load_lds((const unsigned*)(ptr), (unsigned*)(d_ + (off)), 16, 0, 0)
  for (int kt = 0; kt < nk - 1; ++kt) {
    asm volatile("s_waitcnt vmcnt(6)" ::: "memory");
    RAW_BARRIER();
    const int s2 = (stg == 0) ? 2 : stg - 1;
    const int kn_ = (kt + 2 < nk) ? kt + 2 : nk - 1;
    const int kq_ = (KREP == 1) ? kn_ : (kn_ % nk0);
    char* d_ = dma_dst + s2 * STG;
    const char* sb_ = smem + stg * STG;
    bf16x8 af0[4], bf0[2], af1[4], bf1[2];
#pragma unroll
    for (int mi = 0; mi < 4; ++mi) af0[mi] = *(const bf16x8*)(sb_ + aoff0 + mi * 32 * 64);
#pragma unroll
    for (int ni = 0; ni < 2; ++ni) bf0[ni] = *(const bf16x8*)(sb_ + boff0 + ni * 32 * 64);
#pragma unroll
    for (int mi = 0; mi < 4; ++mi) af1[mi] = *(const bf16x8*)(sb_ + aoff1 + mi * 32 * 64);
#pragma unroll
    for (int ni = 0; ni < 2; ++ni) bf1[ni] = *(const bf16x8*)(sb_ + boff1 + ni * 32 * 64);
    SB_;
    acc[0][0] = MFMA32(af0[0], bf0[0], acc[0][0]); acc[0][1] = MFMA32(af0[0], bf0[1], acc[0][1]); SB_;
    DMA1(arow[0] + (size_t)kq_ * astr[0], 0); SB_;
    acc[1][0] = MFMA32(af0[1], bf0[0], acc[1][0]); acc[1][1] = MFMA32(af0[1], bf0[1], acc[1][1]); SB_;
    DMA1(arow[1] + (size_t)kq_ * astr[1], 4096); SB_;
    acc[2][0] = MFMA32(af0[2], bf0[0], acc[2][0]); acc[2][1] = MFMA32(af0[2], bf0[1], acc[2][1]); SB_;
    DMA1(arow[2] + (size_t)kq_ * astr[2], 8192); SB_;
    acc[3][0] = MFMA32(af0[3], bf0[0], acc[3][0]); acc[3][1] = MFMA32(af0[3], bf0[1], acc[3][1]); SB_;
    DMA1(arow[3] + (size_t)kq_ * astr[3], 12288); SB_;
    acc[0][0] = MFMA32(af1[0], bf1[0], acc[0][0]); acc[0][1] = MFMA32(af1[0], bf1[1], acc[0][1]); SB_;
    DMA1(brow[0] + (size_t)kq_ * bstr, ASZ); SB_;
    acc[1][0] = MFMA32(af1[1], bf1[0], acc[1][0]); acc[1][1] = MFMA32(af1[1], bf1[1], acc[1][1]); SB_;
    DMA1(brow[1] + (size_t)kq_ * bstr, ASZ + 4096); SB_;
    acc[2][0] = MFMA32(af1[2], bf1[0], acc[2][0]); acc[2][1] = MFMA32(af1[2], bf1[1], acc[2][1]);
    acc[3][0] = MFMA32(af1[3], bf1[0], acc[3][0]); acc[3][1] = MFMA32(af1[3], bf1[1], acc[3][1]);
    stg = (stg == 2) ? 0 : stg + 1;
  }
  asm volatile("s_waitcnt vmcnt(0)" ::: "memory");
  RAW_BARRIER();
  G_COMPUTE(stg);
  __syncthreads();
  if (KREP == 2) {
#pragma unroll
    for (int a = 0; a < 4; ++a)
#pragma unroll
      for (int b = 0; b < 2; ++b)
#pragma unroll
        for (int i = 0; i < 16; ++i) acc[a][b][i] *= 0.5f;
  }
  const int rbase = tmi * 256 + wm * 128;
  const int cbase = tn * 128 + wn * 64;
  char* wl = smem + w * 19456;
  if (MODE == EPI_F32) {
    u16* dst = (u16*)g.d0;
    u16* lh = (u16*)wl;
#pragma unroll
    for (int mi = 0; mi < 4; ++mi) {
#pragma unroll
      for (int ni = 0; ni < 2; ++ni)
#pragma unroll
        for (int i = 0; i < 16; ++i) lh[crow(i, h) * 72 + ni * 32 + l31] = f2bf(acc[mi][ni][i]);
#pragma unroll
      for (int it = 0; it < 4; ++it) {
        const int r = it * 8 + (lane >> 3), c8 = (lane & 7) * 8;
        uint4 v = *(const uint4*)(lh + r * 72 + c8);
        *(uint4*)(dst + (size_t)(rbase + mi * 32 + r) * g.ld0 + cbase + c8) = v;
      }
    }
  } else if (MODE == EPI_SPLIT) {
    u16* dst; int ld, cc;
    if (cbase < g.split) { dst = (u16*)g.d0; ld = g.ld0; cc = cbase; } else { dst = (u16*)g.d1; ld = g.ld1; cc = cbase - g.split; }
    u16* lh = (u16*)wl;
#pragma unroll
    for (int mi = 0; mi < 4; ++mi) {
#pragma unroll
      for (int ni = 0; ni < 2; ++ni)
#pragma unroll
        for (int i = 0; i < 16; ++i) lh[crow(i, h) * 72 + ni * 32 + l31] = f2bf(acc[mi][ni][i]);
#pragma unroll
      for (int it = 0; it < 4; ++it) {
        const int r = it * 8 + (lane >> 3), c8 = (lane & 7) * 8;
        uint4 v = *(const uint4*)(lh + r * 72 + c8);
        *(uint4*)(dst + (size_t)(rbase + mi * 32 + r) * ld + cc + c8) = v;
      }
    }
  } else if (MODE == EPI_GLU) {
    u16* dst = (u16*)g.d0;
    const int col0 = (tn * 2 + wn) * 32;
    u16* lh = (u16*)wl;
#pragma unroll
    for (int mi = 0; mi < 4; ++mi) {
#pragma unroll
      for (int i = 0; i < 16; ++i) lh[crow(i, h) * 40 + l31] = f2bf(acc[mi][0][i] * sigmoid_f(acc[mi][1][i]));
#pragma unroll
      for (int it = 0; it < 2; ++it) {
        const int r = it * 16 + (lane >> 2), c8 = (lane & 3) * 8;
        uint4 v = *(const uint4*)(lh + r * 40 + c8);
        *(uint4*)(dst + tidx(col0 + c8, rbase + mi * 32 + r, MT)) = v;
      }
    }
  } else {
    u16* T = (u16*)smem;
#pragma unroll
    for (int mi = 0; mi < 4; ++mi)
#pragma unroll
      for (int ni = 0; ni < 2; ++ni)
#pragma unroll
        for (int i = 0; i < 16; ++i)
          T[(wm * 128 + mi * 32 + crow(i, h)) * 136 + wn * 64 + ni * 32 + l31] = f2bf(acc[mi][ni][i]);
    __syncthreads();
    {
      const int cg8 = (tid & 7) * 8, r0 = (tid >> 3) * 8;
      const int fa = tn * 64 + cg8, fg = DFF + fa;
      float wa[3][8], wg[3][8], ba[8], bg[8];
#pragma unroll
      for (int q = 0; q < 3; ++q)
#pragma unroll
        for (int e = 0; e < 8; e += 4) {
          float4 x = *(const float4*)(g.cw + q * 2 * DFF + fa + e); wa[q][e] = x.x; wa[q][e + 1] = x.y; wa[q][e + 2] = x.z; wa[q][e + 3] = x.w;
          float4 y = *(const float4*)(g.cw + q * 2 * DFF + fg + e); wg[q][e] = y.x; wg[q][e + 1] = y.y; wg[q][e + 2] = y.z; wg[q][e + 3] = y.w;
        }
#pragma unroll
      for (int e = 0; e < 8; e += 4) {
        float4 x = *(const float4*)(g.cb + fa + e); ba[e] = x.x; ba[e + 1] = x.y; ba[e + 2] = x.z; ba[e + 3] = x.w;
        float4 y = *(const float4*)(g.cb + fg + e); bg[e] = y.x; bg[e + 1] = y.y; bg[e + 2] = y.z; bg[e + 3] = y.w;
      }
      float ap[8], ac[8], an[8], gp[8], gc[8], gn[8];
      auto ld8 = [&](int r, int coff, float* o) {
        uint4 v = *(const uint4*)(T + r * 136 + coff);
        o[0] = bflo(v.x); o[1] = bfhi(v.x); o[2] = bflo(v.y); o[3] = bfhi(v.y); o[4] = bflo(v.z); o[5] = bfhi(v.z); o[6] = bflo(v.w); o[7] = bfhi(v.w);
      };
      const int rm1 = (r0 > 0) ? r0 - 1 : 0;
      ld8(rm1, cg8, ap); ld8(rm1, 64 + cg8, gp);
      ld8(r0, cg8, ac); ld8(r0, 64 + cg8, gc);
      u16* dst = (u16*)g.d0;
#pragma unroll
      for (int rr = 0; rr < 8; ++rr) {
        const int r = r0 + rr;
        const int rn = (r < 255) ? r + 1 : 255;
        ld8(rn, cg8, an); ld8(rn, 64 + cg8, gn);
        const int v = vrow0 + r;
        if (r >= 1 && r <= 254 && v < seq_len) {
          float o[8];
#pragma unroll
          for (int e = 0; e < 8; ++e) {
            const float av = wa[0][e] * ap[e] + wa[1][e] * ac[e] + wa[2][e] * an[e] + ba[e];
            const float gv = wg[0][e] * gp[e] + wg[1][e] * gc[e] + wg[2][e] * gn[e] + bg[e];
            o[e] = av * silu_f(gv);
          }
          uint4 ov; ov.x = pk2(o[0], o[1]); ov.y = pk2(o[2], o[3]); ov.z = pk2(o[4], o[5]); ov.w = pk2(o[6], o[7]);
          *(uint4*)(dst + tidx(fa, seq_base + v, MT)) = ov;
        }
#pragma unroll
        for (int e = 0; e < 8; ++e) { ap[e] = ac[e]; ac[e] = an[e]; gp[e] = gc[e]; gc[e] = gn[e]; }
      }
    }
  }
  __syncthreads();
}

template <int MODE>
DI void phase_gemm(const GemmDesc& g, char* smem) {
  const int ntiles = g.nM * g.nN;
  const int per = gridDim.x >> 3;
  const int slot = (blockIdx.x & 7) * per + (blockIdx.x >> 3);
  for (int q0 = slot; q0 < ntiles * REP_G; q0 += gridDim.x) {
    const int q = q0 % ntiles;
    const int gm = q / (8 * g.nN);
    const int rows = min(8, g.nM - 8 * gm);
    const int ql = q - gm * 8 * g.nN;
    const int tn = ql / rows, tm = g.tm0 + gm * 8 + ql % rows;
    gemm_tile<MODE>(g, smem, tm, tn);
  }
}

DI void rope_angles(int row, int i, float& cs, float& sn) {
  const int pos = row - CTXN;
  const int rr = pos >> 6, cc = pos & 63;
  const int fi = i & 15;
  const float inv = exp2f(-(float)fi * (13.287712379549449f / 16.f));
  const float ang = (float)((i < 16) ? rr : cc) * inv;
  sincosf(ang, &sn, &cs);
}

DI void qk_prep(const u16* __restrict__ src, int lds, int coff, int nheads, u16* __restrict__ dst, const float* gnorm  ,
                float oscale, int row0) {
  const int lane = threadIdx.x & 63, hh = lane >> 5, i = lane & 31;
  const int wid = blockIdx.x * 4 + (threadIdx.x >> 6), nw = gridDim.x * 4;
  const int npair = nheads >> 1;
  const int nitems = (MT - row0) * npair;
  for (int it = wid; it < nitems; it += nw) {
    const int row = row0 + it / npair, head = (it % npair) * 2 + hh;
    unsigned v = *(const unsigned*)(src + (size_t)row * lds + coff + head * 64 + 2 * i);
    float e = bflo(v), o = bfhi(v);
    if (gnorm) {
      float ss = hsum32(e * e + o * o);
      float rinv = rsqrtf(ss * (1.f / 64.f) + 1e-6f);
      e = e * rinv * gnorm[2 * i]; o = o * rinv * gnorm[2 * i + 1];
    }
    if (row >= CTXN) {
      float cs, sn; rope_angles(row, i, cs, sn);
      float e2 = e * cs - o * sn, o2 = e * sn + o * cs;
      e = e2; o = o2;
    }
    *(unsigned*)(dst + ((size_t)head * MT + row) * 64 + 2 * i) = pk2(e * oscale, o * oscale);
  }
}

DI void v_transpose(const u16* __restrict__ src, int lds, int coff, int ncols, u16* __restrict__ dst, char* smem) {
  u16* sm = (u16*)smem;
  const int tid = threadIdx.x;
  const int ndt = ncols >> 6;
  const int ntasks = NCHUNK * ndt;
  for (int t = blockIdx.x; t < ntasks; t += gridDim.x) {
    const int tt = t / ndt, dt = t % ndt;
    {
      const int tok = tid >> 2, part = tid & 3;
      const u16* sp = src + (size_t)(tt * 64 + tok) * lds + coff + dt * 64 + part * 16;
      uint4 a = *(const uint4*)sp, b = *(const uint4*)(sp + 8);
      unsigned* d = (unsigned*)(sm + tok * 66 + part * 16);
      d[0] = a.x; d[1] = a.y; d[2] = a.z; d[3] = a.w; d[4] = b.x; d[5] = b.y; d[6] = b.z; d[7] = b.w;
    }
    __syncthreads();
    {
      const int d = tid >> 2, part = tid & 3;
      unsigned o[8];
#pragma unroll
      for (int j = 0; j < 8; ++j) {
        unsigned lo = sm[(part * 16 + 2 * j) * 66 + d], hi = sm[(part * 16 + 2 * j + 1) * 66 + d];
        o[j] = lo | (hi << 16);
      }
      u16* dp = dst + (size_t)(dt * 64 + d) * MT + tt * 64 + part * 16;
      *(uint4*)dp = make_uint4(o[0], o[1], o[2], o[3]);
      *(uint4*)(dp + 8) = make_uint4(o[4], o[5], o[6], o[7]);
    }
    __syncthreads();
  }
}

DI void gated_conv(const Params& p, const u16* __restrict__ G, u16* __restrict__ A2) {
  const int lane = threadIdx.x & 63;
  const int wid = blockIdx.x * 4 + (threadIdx.x >> 6), nw = gridDim.x * 4;
  const int nitems = MT * 4;
  for (int it = wid; it < nitems; it += nw) {
    const int row = it >> 2, c = ((it & 3) * 64 + lane) * 2;
    const bool first = (row == 0) || (row == CTXN), last = (row == CTXN - 1) || (row == MT - 1);
    const u16* gr = G + (size_t)row * 1536;
    unsigned gb = *(const unsigned*)(gr + c);
    unsigned c1 = *(const unsigned*)(gr + 512 + c), v1 = *(const unsigned*)(gr + 1024 + c);
    float m1a = bflo(c1) * bflo(v1), m1b = bfhi(c1) * bfhi(v1);
    float m0a = 0.f, m0b = 0.f, m2a = 0.f, m2b = 0.f;
    if (!first) {
      unsigned c0 = *(const unsigned*)(gr - 1536 + 512 + c), v0 = *(const unsigned*)(gr - 1536 + 1024 + c);
      m0a = bflo(c0) * bflo(v0); m0b = bfhi(c0) * bfhi(v0);
    }
    if (!last) {
      unsigned c2 = *(const unsigned*)(gr + 1536 + 512 + c), v2 = *(const unsigned*)(gr + 1536 + 1024 + c);
      m2a = bflo(c2) * bflo(v2); m2b = bfhi(c2) * bfhi(v2);
    }
    const float* cw = p.ev_conv_w;
    float ya = bflo(gb) * (cw[c] * m0a + cw[512 + c] * m1a + cw[1024 + c] * m2a);
    float yb = bfhi(gb) * (cw[c + 1] * m0b + cw[512 + c + 1] * m1b + cw[1024 + c + 1] * m2b);
    *(unsigned*)(A2 + tidx(c, row, MT)) = pk2(ya, yb);
  }
}

DI int kperm(int r) { return (r & 0x13) | ((r & 4) << 1) | ((r & 8) >> 1); }

template <int DV, int NCOMP>
DI void attn_task(char* smem, const u16* __restrict__ Qb, const u16* __restrict__ Kb, const u16* __restrict__ Vt,
                  int qh, int kslot, int q0w, int kh0, int vhead, int nkt, u16* __restrict__ A2, int ocol,
                  float lam, float lam_init, const float* __restrict__ subln) {
  const int tid = threadIdx.x, lane = tid & 63, w = tid >> 6, h = lane >> 5, l31 = lane & 31;
  constexpr int KT = 64 * 144;
  constexpr int STG = NCOMP * KT + DV * 144;
  constexpr int NDB = DV / 32;
  bf16x8 qf[4];
  {
    const u16* qp = Qb + ((size_t)qh * MT + q0w + l31) * 64 + h * 8;
#pragma unroll
    for (int ks = 0; ks < 4; ++ks) qf[ks] = *(const bf16x8*)(qp + ks * 16);
  }
  f32x16 O[NDB];
#pragma unroll
  for (int d = 0; d < NDB; ++d)
#pragma unroll
    for (int i = 0; i < 16; ++i) O[d][i] = 0.f;
  float m = 0.f, lsum = 0.f;
  f32x16 negm, Lacc;
#pragma unroll
  for (int i = 0; i < 16; ++i) { negm[i] = 0.f; Lacc[i] = 0.f; }
  bf16x8 ones;
  {
    const short ov = (l31 == 0) ? (short)0x3F80 : (short)0;
#pragma unroll
    for (int j = 0; j < 8; ++j) ones[j] = ov;
  }
  uint4 kr0, kr1, kr2, kr3, vr0, vr1, vr2, vr3;
  kr2 = kr3 = vr2 = vr3 = make_uint4(0, 0, 0, 0);
  const int skey = (tid & 511) >> 3, spart = tid & 7;
  const u16* kg = Kb + ((size_t)kh0 * MT + skey) * 64 + spart * 8;
  const u16* vg = Vt + ((size_t)vhead * DV + (tid >> 3)) * MT + spart * 8;
  const int ksl = skey * 144 + spart * 16;
  constexpr int vsl_off = NCOMP * KT;
#define vsl (ksl + vsl_off)
#define A_LOAD(kt) { \
    kr0 = *(const uint4*)(kg + (size_t)(kt) * 64 * 64); kr1 = *(const uint4*)(kg + (size_t)(kt) * 64 * 64 + 32 * 64); \
    if (NCOMP == 2) { kr2 = *(const uint4*)(kg + (size_t)MT * 64 + (size_t)(kt) * 64 * 64); kr3 = *(const uint4*)(kg + (size_t)MT * 64 + (size_t)(kt) * 64 * 64 + 32 * 64); } \
    vr0 = *(const uint4*)(vg + (kt) * 64); vr1 = *(const uint4*)(vg + (size_t)32 * MT + (kt) * 64); \
    if (DV == 128) { vr2 = *(const uint4*)(vg + (size_t)64 * MT + (kt) * 64); vr3 = *(const uint4*)(vg + (size_t)96 * MT + (kt) * 64); } }
#define A_WRITE(buf) { char* sb_ = smem + (buf) * STG; \
    *(uint4*)(sb_ + ksl) = kr0; *(uint4*)(sb_ + ksl + 32 * 144) = kr1; \
    if (NCOMP == 2) { *(uint4*)(sb_ + KT + ksl) = kr2; *(uint4*)(sb_ + KT + ksl + 32 * 144) = kr3; } \
    *(uint4*)(sb_ + vsl) = vr0; *(uint4*)(sb_ + vsl + 32 * 144) = vr1; \
    if (DV == 128) { *(uint4*)(sb_ + vsl + 64 * 144) = vr2; *(uint4*)(sb_ + vsl + 96 * 144) = vr3; } }
  A_LOAD(0); A_WRITE(0); __syncthreads();
  for (int kt = 0; kt < nkt; ++kt) {
    const int ktn = (kt + 1 < nkt) ? kt + 1 : kt;
    A_LOAD(ktn);
    __builtin_amdgcn_sched_barrier(0);
    const char* sb = smem + (kt & 1) * STG;
    const char* kp = sb + kslot * KT + kperm(l31) * 144 + h * 16;
    f32x16 S0, S1;
    {
      bf16x8 a0 = *(const bf16x8*)(kp);
      bf16x8 a1 = *(const bf16x8*)(kp + 32 * 144);
      S0 = MFMA32(a0, qf[0], negm); S1 = MFMA32(a1, qf[0], negm);
    }
#pragma unroll
    for (int ks = 1; ks < 4; ++ks) {
      bf16x8 a0 = *(const bf16x8*)(kp + ks * 32);
      bf16x8 a1 = *(const bf16x8*)(kp + 32 * 144 + ks * 32);
      S0 = MFMA32(a0, qf[ks], S0);
      S1 = MFMA32(a1, qf[ks], S1);
    }
    const char* vp = sb + NCOMP * KT + l31 * 144 + h * 16;
    bf16x8 vfr[NDB][4];
    if (NCOMP == 1) {
#pragma unroll
      for (int kk = 0; kk < 4; ++kk)
#pragma unroll
        for (int d = 0; d < NDB; ++d) vfr[d][kk] = *(const bf16x8*)(vp + d * 32 * 144 + kk * 32);
      __builtin_amdgcn_sched_barrier(0);
    }
    float mx = fmaxf(S0[0], S1[0]);
#pragma unroll
    for (int i = 1; i < 16; ++i) mx = fmaxf(mx, fmaxf(S0[i], S1[i]));
    mx = fmaxf(mx, __shfl_xor(mx, 32));
    const bool recentre = (kt == 0) || (mx > 8.f);
    if (__any(recentre)) {
      const float delta = recentre ? mx : 0.f;
      const float alpha = __builtin_amdgcn_exp2f(-delta);
      m += delta;
      lsum *= alpha;
#pragma unroll
      for (int i = 0; i < 16; ++i) { negm[i] = -m; S0[i] -= delta; S1[i] -= delta; }
      if (NCOMP == 1) Lacc[0] *= alpha;
#pragma unroll
      for (int d = 0; d < NDB; ++d)
#pragma unroll
        for (int i = 0; i < 16; ++i) O[d][i] *= alpha;
    }
    if (NCOMP == 1) {
#pragma unroll
      for (int i = 0; i < 16; ++i) { S0[i] = __builtin_amdgcn_exp2f(S0[i]); S1[i] = __builtin_amdgcn_exp2f(S1[i]); }
    } else {
      float ps = 0.f;
#pragma unroll
      for (int i = 0; i < 16; ++i) { S0[i] = __builtin_amdgcn_exp2f(S0[i]); ps += S0[i]; }
#pragma unroll
      for (int i = 0; i < 16; ++i) { S1[i] = __builtin_amdgcn_exp2f(S1[i]); ps += S1[i]; }
      lsum += ps;
    }
    bf16x8 pf[4];
#pragma unroll
    for (int s2 = 0; s2 < 2; ++s2) {
      uint4 a, b;
      a.x = pk2(S0[8 * s2], S0[8 * s2 + 1]); a.y = pk2(S0[8 * s2 + 2], S0[8 * s2 + 3]);
      a.z = pk2(S0[8 * s2 + 4], S0[8 * s2 + 5]); a.w = pk2(S0[8 * s2 + 6], S0[8 * s2 + 7]);
      b.x = pk2(S1[8 * s2], S1[8 * s2 + 1]); b.y = pk2(S1[8 * s2 + 2], S1[8 * s2 + 3]);
      b.z = pk2(S1[8 * s2 + 4], S1[8 * s2 + 5]); b.w = pk2(S1[8 * s2 + 6], S1[8 * s2 + 7]);
      pf[s2] = __builtin_bit_cast(bf16x8, a);
      pf[2 + s2] = __builtin_bit_cast(bf16x8, b);
    }
#pragma unroll
    for (int kk = 0; kk < 4; ++kk)
#pragma unroll
      for (int d = 0; d < NDB; ++d) {
        bf16x8 vf;
        if (NCOMP == 1) vf = vfr[d][kk]; else vf = *(const bf16x8*)(vp + d * 32 * 144 + kk * 32);
        O[d] = MFMA32(vf, pf[kk], O[d]);
      }
    if (NCOMP == 1) {
#pragma unroll
      for (int kk = 0; kk < 4; ++kk) Lacc = MFMA32(ones, pf[kk], Lacc);
    }
    A_WRITE((kt + 1) & 1);
    __syncthreads();
  }
  const float ltot = (NCOMP == 1) ? __shfl(Lacc[0], l31) : lsum + __shfl_xor(lsum, 32);
  const float inv = 1.f / ltot;
  const int row = q0w + l31;
  if (NCOMP == 1) {
#pragma unroll
    for (int d = 0; d < NDB; ++d)
#pragma unroll
      for (int q = 0; q < 4; ++q) {
        const int dd = d * 32 + 8 * q + 4 * h;
        uint2 v; v.x = pk2(O[d][4 * q] * inv, O[d][4 * q + 1] * inv); v.y = pk2(O[d][4 * q + 2] * inv, O[d][4 * q + 3] * inv);
        *(uint2*)(A2 + tidx(ocol + dd, row, MT)) = v;
      }
  } else {
    float* ox = (float*)smem;
    const int ql = (w >> 1) * 32 + l31;
    if (w & 1) {
#pragma unroll
      for (int d = 0; d < NDB; ++d)
#pragma unroll
        for (int q = 0; q < 4; ++q) {
          const int dd = d * 32 + 8 * q + 4 * h;
          float4 v = make_float4(O[d][4 * q] * inv, O[d][4 * q + 1] * inv, O[d][4 * q + 2] * inv, O[d][4 * q + 3] * inv);
          *(float4*)(ox + ql * 132 + dd) = v;
        }
    }
    __syncthreads();
    if (!(w & 1)) {
      float ss = 0.f;
#pragma unroll
      for (int d = 0; d < NDB; ++d)
#pragma unroll
        for (int q = 0; q < 4; ++q) {
          const int dd = d * 32 + 8 * q + 4 * h;
          float4 o2 = *(const float4*)(ox + ql * 132 + dd);
          O[d][4 * q] = O[d][4 * q] * inv - lam * o2.x;
          O[d][4 * q + 1] = O[d][4 * q + 1] * inv - lam * o2.y;
          O[d][4 * q + 2] = O[d][4 * q + 2] * inv - lam * o2.z;
          O[d][4 * q + 3] = O[d][4 * q + 3] * inv - lam * o2.w;
          ss += O[d][4 * q] * O[d][4 * q] + O[d][4 * q + 1] * O[d][4 * q + 1] + O[d][4 * q + 2] * O[d][4 * q + 2] + O[d][4 * q + 3] * O[d][4 * q + 3];
        }
      ss += __shfl_xor(ss, 32);
      const float r = rsqrtf(ss * (1.f / 128.f) + 1e-6f) * (1.f - lam_init);
#pragma unroll
      for (int d = 0; d < NDB; ++d)
#pragma unroll
        for (int q = 0; q < 4; ++q) {
          const int dd = d * 32 + 8 * q + 4 * h;
          float4 gs = *(const float4*)(subln + dd);
          uint2 v; v.x = pk2(O[d][4 * q] * r * gs.x, O[d][4 * q + 1] * r * gs.y); v.y = pk2(O[d][4 * q + 2] * r * gs.z, O[d][4 * q + 3] * r * gs.w);
          *(uint2*)(A2 + tidx(ocol + dd, row, MT)) = v;
        }
    }
    __syncthreads();
  }
}

DI void s5_coeffs(const Params& p, int dir, int g, int pp, float& abr, float& abi, float& cr, float& ci) {
  const int idx = (dir * 32 + g) * 64 + pp;
  const float dt = expf(p.log_dt[dir * 32 + g]);
  const float are = p.a_re[idx], aim = p.a_im[idx];
  const float mag = expf(are * dt);
  const float sn = __sinf(aim * dt), cs = __cosf(aim * dt);
  abr = mag * cs; abi = mag * sn;
  const float nr = abr - 1.f, ni = abi;
  const float den = are * are + aim * aim;
  cr = (nr * are + ni * aim) / den;
  ci = (ni * are - nr * aim) / den;
}

template <bool OUT>
DI void s5_phase(const Params& p, char* smem, const u16* __restrict__ U1, u16* __restrict__ Z, int c0, int nch) {
  float* su = (float*)smem;
  u16* hm = (u16*)(smem + 8192);
  const int tid = threadIdx.x, lane = tid & 63, w = tid >> 6;
  const int gp = blockIdx.x & 15;
  const int gl = w >> 1, dir = w & 1, g = 2 * gp + gl;
  const int ntask = 16 * nch;
  if ((int)blockIdx.x >= ntask) return;
  float abr, abi, cr, ci;
  s5_coeffs(p, dir, g, lane, abr, abi, cr, ci);
  float bbr[16], bbi[16];
  {
    const size_t bidx = ((size_t)(dir * 32 + g) * 64 + lane) * 16;
#pragma unroll
    for (int q = 0; q < 4; ++q) {
      float4 br = *(const float4*)(p.b_re + bidx + q * 4), bi = *(const float4*)(p.b_im + bidx + q * 4);
      bbr[4 * q] = cr * br.x - ci * bi.x; bbi[4 * q] = cr * bi.x + ci * br.x;
      bbr[4 * q + 1] = cr * br.y - ci * bi.y; bbi[4 * q + 1] = cr * bi.y + ci * br.y;
      bbr[4 * q + 2] = cr * br.z - ci * bi.z; bbi[4 * q + 2] = cr * bi.z + ci * br.z;
      bbr[4 * q + 3] = cr * br.w - ci * bi.w; bbi[4 * q + 3] = cr * bi.w + ci * br.w;
    }
  }
  const int l15 = lane & 15, lq = lane >> 4;
  bf16x8 cfr[8];
  float dsk = 0.f;
  if (OUT) {
#pragma unroll
    for (int kb = 0; kb < 8; ++kb) {
      const int k0 = kb * 32 + lq * 8;
      const int dk = k0 >> 7, rem = k0 & 127, isim = rem >> 6, pp = rem & 63;
      const float* cs = (isim ? p.c_im : p.c_re) + ((size_t)((dk * 32 + g) * 16 + l15)) * 64 + pp;
      const float sg = isim ? -1.f : 1.f;
      float4 x0 = *(const float4*)cs, x1 = *(const float4*)(cs + 4);
      uint4 bb; bb.x = pk2(sg * x0.x, sg * x0.y); bb.y = pk2(sg * x0.z, sg * x0.w); bb.z = pk2(sg * x1.x, sg * x1.y); bb.w = pk2(sg * x1.z, sg * x1.w);
      cfr[kb] = __builtin_bit_cast(bf16x8, bb);
    }
    dsk = p.d_skip[g * 16 + l15];
  }
  const int ut = tid >> 2, upart = tid & 3;
  const u16* ubase = U1 + (size_t)ut * 512 + gp * 32 + upart * 8;
  float2* sbase = (float2*)p.s5s + ((size_t)(dir * 32 + g) * NCHUNK) * 64 + lane;
  int c = c0 + ((int)blockIdx.x >> 4);
  uint4 unext = *(const uint4*)(ubase + (size_t)c * 64 * 512);
  float2 hnext = make_float2(0.f, 0.f);
  if (OUT) hnext = sbase[(size_t)c * 64];
  for (int t = blockIdx.x; t < ntask; t += gridDim.x) {
    c = c0 + (t >> 4);
    {
      float* d = su + ut * 32 + upart * 8;
      d[0] = bflo(unext.x); d[1] = bfhi(unext.x); d[2] = bflo(unext.y); d[3] = bfhi(unext.y);
      d[4] = bflo(unext.z); d[5] = bfhi(unext.z); d[6] = bflo(unext.w); d[7] = bfhi(unext.w);
    }
    float hr = hnext.x, hi = hnext.y;
    {
      const int tn = t + gridDim.x;
      const int cn = c0 + (((tn < ntask) ? tn : t) >> 4);
      unext = *(const uint4*)(ubase + (size_t)cn * 64 * 512);
      if (OUT) hnext = sbase[(size_t)cn * 64];
    }
    __syncthreads();
#pragma unroll 1
    for (int step0 = 0; step0 < 64; step0 += 4) {
      float br[4], bi[4];
#pragma unroll
      for (int s2 = 0; s2 < 4; ++s2) { br[s2] = 0.f; bi[s2] = 0.f; }
#pragma unroll
      for (int q = 0; q < 4; ++q) {
#pragma unroll
        for (int s2 = 0; s2 < 4; ++s2) {
          const int tt = dir ? 63 - (step0 + s2) : (step0 + s2);
          const float4 u = *(const float4*)(su + tt * 32 + gl * 16 + 4 * q);
          br[s2] += bbr[4 * q] * u.x + bbr[4 * q + 1] * u.y + bbr[4 * q + 2] * u.z + bbr[4 * q + 3] * u.w;
          bi[s2] += bbi[4 * q] * u.x + bbi[4 * q + 1] * u.y + bbi[4 * q + 2] * u.z + bbi[4 * q + 3] * u.w;
        }
      }
#pragma unroll
      for (int s2 = 0; s2 < 4; ++s2) {
        const int tt = dir ? 63 - (step0 + s2) : (step0 + s2);
        const float nhr = abr * hr - abi * hi + br[s2];
        const float nhi = abr * hi + abi * hr + bi[s2];
        hr = nhr; hi = nhi;
        if (OUT) {
          u16* hrow = hm + (gl * 64 + tt) * 264 + dir * 128 + lane;
          hrow[0] = f2bf(hr); hrow[64] = f2bf(hi);
        }
      }
    }
    if (!OUT) {
      sbase[(size_t)c * 64] = make_float2(hr, hi);
      __syncthreads();
    } else {
      __syncthreads();
      f32x4 acc0 = {0.f, 0.f, 0.f, 0.f}, acc1 = {0.f, 0.f, 0.f, 0.f};
      const int tb0 = 2 * (w & 1);
#pragma unroll
      for (int kb = 0; kb < 8; ++kb) {
        const int k0 = kb * 32 + lq * 8;
        bf16x8 a0 = *(const bf16x8*)(hm + (gl * 64 + tb0 * 16 + l15) * 264 + k0);
        bf16x8 a1 = *(const bf16x8*)(hm + (gl * 64 + (tb0 + 1) * 16 + l15) * 264 + k0);
        acc0 = MFMA16(a0, cfr[kb], acc0);
        acc1 = MFMA16(a1, cfr[kb], acc1);
      }
#pragma unroll
      for (int j = 0; j < 4; ++j) {
        int tt = tb0 * 16 + lq * 4 + j;
        float y = acc0[j] + dsk * su[tt * 32 + gl * 16 + l15];
        Z[tidx(g * 16 + l15, c * 64 + tt, MT)] = f2bf(gelu_tanh(y));
        tt += 16;
        y = acc1[j] + dsk * su[tt * 32 + gl * 16 + l15];
        Z[tidx(g * 16 + l15, c * 64 + tt, MT)] = f2bf(gelu_tanh(y));
      }
      __syncthreads();
    }
  }
}


DI void s5_build_w(const Params& p, u16* __restrict__ Wm, int dirg) {
  const int tid = threadIdx.x, pp = tid & 63, tq = tid >> 6;
  const int dir = dirg >> 5, g = dirg & 31;
  const int idx = dirg * 64 + pp;
  const float dt = expf(p.log_dt[dirg]);
  const float are = p.a_re[idx], aim = p.a_im[idx];
  const float mag = expf(are * dt);
  float sn, cs; sincosf(aim * dt, &sn, &cs);
  const float abr = mag * cs, abi = mag * sn;
  const float nr = abr - 1.f, ni = abi;
  const float den = are * are + aim * aim;
  const float cr = (nr * are + ni * aim) / den, ci = (ni * are - nr * aim) / den;
  float bbr[16], bbi[16];
#pragma unroll
  for (int q = 0; q < 4; ++q) {
    float4 br = *(const float4*)(p.b_re + (size_t)idx * 16 + q * 4), bi = *(const float4*)(p.b_im + (size_t)idx * 16 + q * 4);
    bbr[4 * q] = cr * br.x - ci * bi.x; bbi[4 * q] = cr * bi.x + ci * br.x;
    bbr[4 * q + 1] = cr * br.y - ci * bi.y; bbi[4 * q + 1] = cr * bi.y + ci * br.y;
    bbr[4 * q + 2] = cr * br.z - ci * bi.z; bbi[4 * q + 2] = cr * bi.z + ci * br.z;
    bbr[4 * q + 3] = cr * br.w - ci * bi.w; bbi[4 * q + 3] = cr * bi.w + ci * br.w;
  }
  u16* wre = Wm + ((size_t)dirg * 128 + pp) * 1024;
  u16* wim = wre + (size_t)64 * 1024;
#pragma unroll 1
  for (int tt = 0; tt < 16; ++tt) {
    const int t = tq * 16 + tt;
    const float e = (float)(dir ? t : 63 - t);
    const float mg = expf(e * are * dt);
    float s2, c2; sincosf(e * aim * dt, &s2, &c2);
    const float pr = mg * c2, pi = mg * s2;
    unsigned ore[8], oim[8];
#pragma unroll
    for (int h2 = 0; h2 < 8; ++h2) {
      const float r0 = pr * bbr[2 * h2] - pi * bbi[2 * h2], i0 = pr * bbi[2 * h2] + pi * bbr[2 * h2];
      const float r1 = pr * bbr[2 * h2 + 1] - pi * bbi[2 * h2 + 1], i1 = pr * bbi[2 * h2 + 1] + pi * bbr[2 * h2 + 1];
      ore[h2] = pk2(r0, r1); oim[h2] = pk2(i0, i1);
    }
    *(uint4*)(wre + t * 16) = make_uint4(ore[0], ore[1], ore[2], ore[3]);
    *(uint4*)(wre + t * 16 + 8) = make_uint4(ore[4], ore[5], ore[6], ore[7]);
    *(uint4*)(wim + t * 16) = make_uint4(oim[0], oim[1], oim[2], oim[3]);
    *(uint4*)(wim + t * 16 + 8) = make_uint4(oim[4], oim[5], oim[6], oim[7]);
  }
}

DI void s5_state_gemm(const Params& p, char* smem, const u16* __restrict__ Wm, const u16* __restrict__ U1) {
  const int tid = threadIdx.x, lane = tid & 63, w = tid >> 6, hh = lane >> 5, l31 = lane & 31;
  float* red = (float*)smem;
  for (int task = blockIdx.x; task < 64 * 9; task += gridDim.x) {
    const int dirg = task / 9, nb = task % 9;
    const int g = dirg & 31;
    const int c = nb * 32 + l31;
    const bool cv = c < NCHUNK;
    const u16* ap = Wm + ((size_t)dirg * 128 + l31) * 1024 + hh * 8;
    const u16* bp = U1 + (size_t)(cv ? c : 0) * 64 * 512 + g * 16 + hh * 8;
    f32x16 acc[4];
#pragma unroll
    for (int mb = 0; mb < 4; ++mb)
#pragma unroll
      for (int i = 0; i < 16; ++i) acc[mb][i] = 0.f;
#pragma unroll 1
    for (int k4 = 0; k4 < 4; ++k4) {
      bf16x8 af[4][4], bf[4];
#pragma unroll
      for (int kk = 0; kk < 4; ++kk) {
        const int ks = w * 16 + k4 * 4 + kk;
#pragma unroll
        for (int mb = 0; mb < 4; ++mb) af[kk][mb] = *(const bf16x8*)(ap + (size_t)mb * 32 * 1024 + ks * 16);
        uint4 bv = *(const uint4*)(bp + (size_t)ks * 512);
        if (!cv) bv = make_uint4(0, 0, 0, 0);
        bf[kk] = __builtin_bit_cast(bf16x8, bv);
      }
#pragma unroll
      for (int kk = 0; kk < 4; ++kk)
#pragma unroll
        for (int mb = 0; mb < 4; ++mb) acc[mb] = MFMA32(af[kk][mb], bf[kk], acc[mb]);
    }
#pragma unroll
    for (int mb = 0; mb < 4; ++mb)
#pragma unroll
      for (int i = 0; i < 16; ++i) red[(w * 64 + mb * 16 + i) * 64 + lane] = acc[mb][i];
    __syncthreads();
    if (w < 2 && cv) {
      float2* sp = (float2*)p.s5s + ((size_t)dirg * NCHUNK + c) * 64;
#pragma unroll
      for (int i = 0; i < 16; ++i) {
        float re = 0.f, im = 0.f;
#pragma unroll
        for (int q = 0; q < 4; ++q) { re += red[(q * 64 + w * 16 + i) * 64 + lane]; im += red[(q * 64 + (w + 2) * 16 + i) * 64 + lane]; }
        sp[w * 32 + crow(i, hh)] = make_float2(re, im);
      }
    }
    __syncthreads();
  }
}

DI void s5_carry(const Params& p) {
  if (blockIdx.x >= 16) return;
  const int s = blockIdx.x * 256 + threadIdx.x;
  const int dir = s >> 11, g = (s >> 6) & 31, pp = s & 63;
  float abr, abi, cr, ci;
  s5_coeffs(p, dir, g, pp, abr, abi, cr, ci);
#pragma unroll
  for (int q = 0; q < 6; ++q) { float nr = abr * abr - abi * abi, ni = 2.f * abr * abi; abr = nr; abi = ni; }
  float2* base = (float2*)p.s5s + ((size_t)(dir * 32 + g) * NCHUNK) * 64 + pp;
  float hr = 0.f, hi = 0.f;
  for (int b = 0; b < 10; ++b) {
    float2 tmp[26];
#pragma unroll
    for (int j = 0; j < 26; ++j) {
      const int step = b * 26 + j;
      const int c = dir == 0 ? step : (step < 4 ? 3 - step : 263 - step);
      tmp[j] = base[(size_t)c * 64];
    }
#pragma unroll
    for (int j = 0; j < 26; ++j) {
      const int step = b * 26 + j;
      const int c = dir == 0 ? step : (step < 4 ? 3 - step : 263 - step);
      base[(size_t)c * 64] = make_float2(hr, hi);
      const float nr = abr * hr - abi * hi + tmp[j].x;
      const float ni = abr * hi + abi * hr + tmp[j].y;
      hr = nr; hi = ni;
    }
  }
}

DI unsigned gb_ld(unsigned* p) { return __hip_atomic_load(p, __ATOMIC_RELAXED, __HIP_MEMORY_SCOPE_AGENT); }
DI unsigned gb_add(unsigned* p, unsigned v) { return __hip_atomic_fetch_add(p, v, __ATOMIC_RELAXED, __HIP_MEMORY_SCOPE_AGENT); }
DI void grid_barrier(unsigned* bar, unsigned& epoch) {
  asm volatile("s_waitcnt vmcnt(0)" ::: "memory");
  __syncthreads();
  if (threadIdx.x == 0) {
    __builtin_amdgcn_fence(__ATOMIC_RELEASE, "agent");
    asm volatile("s_waitcnt vmcnt(0)" ::: "memory");
    const unsigned grp = blockIdx.x & 15u;
    const unsigned ngb = (gridDim.x + 15u - grp) >> 4;
    const unsigned old = gb_add(&bar[64 * (1 + grp)], 1u);
    if (old + 1u == (epoch + 1u) * ngb) {
      const unsigned ot = gb_add(&bar[64 * 17], 1u);
      if (ot + 1u == (epoch + 1u) * 16u) __hip_atomic_store(&bar[0], epoch + 1u, __ATOMIC_RELAXED, __HIP_MEMORY_SCOPE_AGENT);
    }
    while (gb_ld(&bar[0]) < epoch + 1u) __builtin_amdgcn_s_sleep(1);
    __builtin_amdgcn_fence(__ATOMIC_ACQUIRE, "agent");
    asm volatile("s_waitcnt vmcnt(0)" ::: "memory");
  }
  epoch++;
  __syncthreads();
}

#define XB_TMO      128
#define XB_XCNT(j)  (256  + 64 * (j))
#define XB_XSUB(j)  (1280 + 64 * (j))
#define XB_XGEN(j)  (2304 + 64 * (j))
#define XB_TOP      3328
#define XB_TOPGEN   3392
#define XCD_BAR_WORDS 3456
#define XB_SPIN_CAP (1u << 18)
#define LAS __attribute__((address_space(3)))

__device__ __forceinline__ unsigned xb_ld(unsigned* p)              { return __hip_atomic_load(p, __ATOMIC_RELAXED, __HIP_MEMORY_SCOPE_AGENT); }
__device__ __forceinline__ unsigned xb_add(unsigned* p, unsigned v) { return __hip_atomic_fetch_add(p, v, __ATOMIC_RELAXED, __HIP_MEMORY_SCOPE_AGENT); }
__device__ __forceinline__ unsigned xb_xcc_id() { return (unsigned)__builtin_amdgcn_s_getreg((3 << 11) | 20) & 0xFu; }
#define XB_SPIN(cond, bar) do { unsigned _sp = 0; while (cond) { __builtin_amdgcn_s_sleep(1); \
    if ((++_sp & 255u) == 0u) { if (xb_ld(&(bar)[XB_TMO])) break; if (_sp > XB_SPIN_CAP) { atomicAdd(&(bar)[XB_TMO], 1u); break; } } } } while (0)

struct XcdBarrier {
    unsigned* bar; unsigned x;
    volatile LAS unsigned* st;
};

__device__ __forceinline__ XcdBarrier xcd_barrier_post(unsigned* bar, volatile LAS unsigned* st) {
    XcdBarrier b; b.bar = bar; b.x = xb_xcc_id(); b.st = st;
    if (threadIdx.x == 0) (void)xb_add(&bar[XB_XCNT(b.x)], 1u);
    return b;
}
__device__ __forceinline__ void xcd_barrier_complete(unsigned* bar, unsigned x, unsigned& nloc, unsigned& nx) {
    const unsigned G = gridDim.x * gridDim.y * gridDim.z;
    unsigned sum, cnt, mine, sp = 0u;
    for (;;) {
        sum = 0u; cnt = 0u; mine = 0u;
#pragma unroll
        for (unsigned j = 0; j < 16; ++j) { const unsigned c = xb_ld(&bar[XB_XCNT(j)]); sum += c; cnt += (c > 0u) ? 1u : 0u; mine = (j == x) ? c : mine; }
        if (sum == G) break;
        __builtin_amdgcn_s_sleep(1);
        if ((++sp & 255u) == 0u) { if (xb_ld(&bar[XB_TMO])) break; if (sp > XB_SPIN_CAP) { atomicAdd(&bar[XB_TMO], 1u); break; } }
    }
    nloc = mine > 0u ? mine : 1u; nx = cnt > 0u ? cnt : 1u;
}

__device__ __forceinline__ void xcd_barrier(const XcdBarrier& b) {
    asm volatile("s_waitcnt vmcnt(0)" ::: "memory");
    __syncthreads();
    if (threadIdx.x == 0) {
        unsigned* bar = b.bar;
        __builtin_amdgcn_s_waitcnt(0);
        unsigned nloc = b.st[0], nx = b.st[1];
        if (nloc == 0u) { xcd_barrier_complete(bar, b.x, nloc, nx); b.st[0] = nloc; b.st[1] = nx; }
        const unsigned old = xb_add(&bar[XB_XSUB(b.x)], 1u);
        const unsigned gen = old / nloc;
        if (old + 1u == (gen + 1u) * nloc) {
            __builtin_amdgcn_fence(__ATOMIC_RELEASE, "agent");
            asm volatile("s_waitcnt vmcnt(0)" ::: "memory");
            const unsigned og = xb_add(&bar[XB_TOP], 1u);
            const unsigned tg = og / nx;
            if (og + 1u == (tg + 1u) * nx) xb_add(&bar[XB_TOPGEN], 1u);
            else XB_SPIN(xb_ld(&bar[XB_TOPGEN]) == tg, bar);
            __builtin_amdgcn_fence(__ATOMIC_ACQUIRE, "agent");
            xb_add(&bar[XB_XGEN(b.x)], 1u);
            asm volatile("s_waitcnt vmcnt(0)" ::: "memory");
        } else {
            XB_SPIN(xb_ld(&bar[XB_XGEN(b.x)]) == gen, bar);
            __builtin_amdgcn_fence(__ATOMIC_ACQUIRE, "agent");
            asm volatile("s_waitcnt vmcnt(0)" ::: "memory");
        }
    }
    __syncthreads();
}


__global__ void __launch_bounds__(256, 2) fwd_megakernel(Params p) {
  extern __shared__ __attribute__((aligned(16))) char smem[];
  cg::grid_group grid = cg::this_grid();
  const size_t RW = (size_t)MT * DM;
  u16* A2 = p.H;
  u16* Qb = (u16*)p.Y;
  u16* Kb = Qb + RW / 2;
  u16* Vt = Kb + RW / 2;
  const float* mod0 = p.mod;
  const float* mod1 = p.mod + 2 * 6 * DM;

  unsigned epoch = 0; (void)epoch;
  __shared__ uint4 xb_words;
  if (threadIdx.x == 0) xb_words = make_uint4(0u, 0u, 0u, 0u);
  __syncthreads();
  const XcdBarrier xb = xcd_barrier_post(p.bar, (volatile LAS unsigned*)&xb_words);
  if (p.ph_lo < 0) grid.sync();
#define PHASE_BEGIN(k) if ((k) >= p.ph_lo && (k) < p.ph_hi) { if ((k) > p.ph_lo) xcd_barrier(xb);
#define PHASE_END }

  u16* Wm = (u16*)((char*)p.Y + (size_t)51118080);
  PHASE_BEGIN(0)
    phase_prep_weights(p, smem);
    for (int t = gridDim.x - 1 - blockIdx.x; t < 64; t += gridDim.x) s5_build_w(p, Wm, t);
  PHASE_END

  PHASE_BEGIN(1)
    for (int rep = 0; rep < REP_O; ++rep) phase_rows<false, true>(p, 0, MT, p.ctx, p.x, nullptr, nullptr, nullptr, nullptr, 0, nullptr, mod0, 0, p.norm_pre, p.H);
  PHASE_END

  PHASE_BEGIN(2) {
    GemmDesc g{}; g.A = p.H; g.Bt = p.wt_in0; g.lda = DM; g.K = DM; g.nN = 18; g.tm0 = 0; g.nM = 65;
    g.d0 = p.big; g.ld0 = 1536; g.d1 = p.big + (size_t)MT * 1536; g.ld1 = 768; g.split = 1536;
    phase_gemm<EPI_SPLIT>(g, smem);
  } PHASE_END

  PHASE_BEGIN(3) {
    const u16* G = p.big; const u16* QKV = p.big + (size_t)MT * 1536;
    for (int rep = 0; rep < REP_O; ++rep) {
    qk_prep(QKV, 768, 0, 8, Qb, p.ev_q_norm, 0.125f * LOG2E, 0);
    qk_prep(QKV, 768, 512, 2, Kb, p.ev_k_norm, 1.f, 0);
    v_transpose(QKV, 768, 640, 128, Vt, smem);
    gated_conv(p, G, A2);
    }
  } PHASE_END

  PHASE_BEGIN(4) {
    const int w = threadIdx.x >> 6;
    const int nlat = 8 * 128, nctx = 8 * 2;
    for (int t0 = blockIdx.x; t0 < (nlat + nctx) * REP_A; t0 += gridDim.x) {
      const int t = t0 % (nlat + nctx);
      int head, q0, nkt;
      if (t < nlat) { head = t & 7; q0 = CTXN + (t >> 3) * 128; nkt = NCHUNK; }
      else { int tt = t - nlat; head = tt & 7; q0 = (tt >> 3) * 128; nkt = CTXN / 64; }
      attn_task<64, 1>(smem, Qb, Kb, Vt, head, 0, q0 + 32 * w, head >> 2, head >> 2, nkt, A2, 512 + head * 64, 0.f, 0.f, nullptr);
    }
  } PHASE_END

  PHASE_BEGIN(5) {
    GemmDesc g{}; g.A = A2; g.Bt = p.wt_out0; g.lda = DM; g.K = DM; g.nN = 8; g.tm0 = 0; g.nM = 65;
    g.d0 = p.Y; g.ld0 = DM;
    phase_gemm<EPI_F32>(g, smem);
  } PHASE_END

  PHASE_BEGIN(6)
    for (int rep = 0; rep < REP_O; ++rep) phase_rows<true, true>(p, 0, MT, p.ctx, p.x, p.xctx, p.out, (const u16*)p.Y, mod0, 2, p.norm_post, mod0, 3, p.norm_pre + DM, p.H);
  PHASE_END

  PHASE_BEGIN(7) {
    GemmDesc g{}; g.A = p.H; g.Bt = p.wt_up0; g.lda = DM; g.K = DM; g.nN = 44; g.tm0 = 0; g.nM = 67;
    g.d0 = p.big; g.cw = p.ffn_conv_w; g.cb = p.ffn_conv_b; g.zrow = (const u16*)(p.bar + 4096);
    phase_gemm<EPI_FFNUP>(g, smem);
  } PHASE_END

  PHASE_BEGIN(8) {
    GemmDesc g{}; g.A = p.big; g.Bt = p.wt_dn0; g.lda = DFF; g.K = DFF; g.nN = 8; g.tm0 = 0; g.nM = 65;
    g.d0 = p.Y; g.ld0 = DM;
    phase_gemm<EPI_F32>(g, smem);
  } PHASE_END

  PHASE_BEGIN(9)
    phase_rows<true, true>(p, 0, MT, p.xctx, p.out, p.xctx, p.out, (const u16*)p.Y, mod0, 5, p.norm_post + DM, mod1, 0, p.norm_pre + 2 * DM, p.H);
  PHASE_END

  u16* U1 = p.big;
  u16* QKV1 = p.big + (size_t)MT * 512;
  u16* Z = p.big + (size_t)MT * 2048;

  PHASE_BEGIN(10) {
    GemmDesc g{}; g.A = p.H; g.Bt = p.wt_in1; g.lda = DM; g.K = DM; g.nN = 16; g.tm0 = 0; g.nM = 65;
    g.d0 = U1; g.ld0 = 512; g.d1 = QKV1; g.ld1 = 1536; g.split = 512;
    phase_gemm<EPI_SPLIT>(g, smem);
  } PHASE_END

  PHASE_BEGIN(11) {
    for (int rep = 0; rep < REP_O; ++rep) {
    qk_prep(QKV1, 1536, 0, 8, Qb, nullptr, 0.125f * LOG2E, CTXN);
    qk_prep(QKV1, 1536, 512, 8, Kb, nullptr, 1.f, 0);
    v_transpose(QKV1, 1536, 1024, 512, Vt, smem);
    }
    s5_state_gemm(p, smem, Wm, U1);
  } PHASE_END

  PHASE_BEGIN(12) {
    s5_carry(p);
    float lam;
    {
      const int lane = threadIdx.x & 63;
      float s1 = wsum(p.lam_q1[lane] * p.lam_k1[lane]);
      float s2 = wsum(p.lam_q2[lane] * p.lam_k2[lane]);
      lam = expf(s1) - expf(s2) + 0.35550906759f;
    }
    const int w = threadIdx.x >> 6;
    for (int t0 = blockIdx.x; t0 < 4 * 256 * REP_A; t0 += gridDim.x) {
      const int t = t0 & 1023;
      const int head = t & 3, q0 = CTXN + (t >> 2) * 64;
      attn_task<128, 2>(smem, Qb, Kb, Vt, head * 2 + (w & 1), w & 1, q0 + 32 * (w >> 1), head * 2, head, NCHUNK, A2, 512 + head * 128,
                        lam, 0.35550906759f, p.subln);
    }
  } PHASE_END

  PHASE_BEGIN(13) {
    s5_phase<true>(p, smem, U1, Z, 4, NCHUNK - 4);
  } PHASE_END

  PHASE_BEGIN(14) {
    GemmDesc g{}; g.A = Z; g.Bt = p.wt_glu; g.lda = 512; g.K = 512; g.nN = 8; g.tm0 = 1; g.nM = 64;
    g.d0 = A2; g.ld0 = DM;
    phase_gemm<EPI_GLU>(g, smem);
  } PHASE_END

  PHASE_BEGIN(15) {
    GemmDesc g{}; g.A = A2; g.Bt = p.wt_out1; g.lda = DM; g.K = DM; g.nN = 8; g.tm0 = 1; g.nM = 64;
    g.d0 = p.Y; g.ld0 = DM;
    phase_gemm<EPI_F32>(g, smem);
  } PHASE_END

  PHASE_BEGIN(16)
    phase_rows<true, true>(p, CTXN, MT, p.xctx, p.out, p.xctx, p.out, (const u16*)p.Y, mod1, 2, p.norm_post + 2 * DM, mod1, 3, p.norm_pre + 3 * DM, p.H);
  PHASE_END

  PHASE_BEGIN(17) {
    GemmDesc g{}; g.A = p.H; g.Bt = p.wt_up1; g.lda = DM; g.K = DM; g.nN = 44; g.tm0 = 2; g.nM = 65;
    g.d0 = p.big; g.cw = p.ffn_conv_w + 3 * 2 * DFF; g.cb = p.ffn_conv_b + 2 * DFF; g.zrow = (const u16*)(p.bar + 4096);
    phase_gemm<EPI_FFNUP>(g, smem);
  } PHASE_END

  PHASE_BEGIN(18) {
    GemmDesc g{}; g.A = p.big; g.Bt = p.wt_dn1; g.lda = DFF; g.K = DFF; g.nN = 8; g.tm0 = 1; g.nM = 64;
    g.d0 = p.Y; g.ld0 = DM;
    phase_gemm<EPI_F32>(g, smem);
  } PHASE_END

  PHASE_BEGIN(19)
    phase_rows<true, false>(p, CTXN, MT, p.xctx, p.out, p.xctx, p.out, (const u16*)p.Y, mod1, 5, p.norm_post + 3 * DM, nullptr, 0, nullptr, nullptr);
  PHASE_END
}

extern "C" void kernel_launch(void* const* d_in, const int* in_sizes, int n_in, void* d_out, int out_size, void* d_ws,
                              size_t ws_size, hipStream_t stream) {
  static int grid_blocks = 0;
  if (!grid_blocks) {
    hipFuncSetAttribute((const void*)fwd_megakernel, hipFuncAttributeMaxDynamicSharedMemorySize, LDS_BYTES);
    int dev = 0, cus = 0, per_cu = 0;
    hipGetDevice(&dev);
    hipDeviceGetAttribute(&cus, hipDeviceAttributeMultiprocessorCount, dev);
    hipOccupancyMaxActiveBlocksPerMultiprocessor(&per_cu, fwd_megakernel, 256, LDS_BYTES);
    if (per_cu > 2) per_cu = 2;
    grid_blocks = cus * per_cu;
  }
  Params p{};
  const float* const* in = (const float* const*)d_in;
  p.x = in[0]; p.c = in[1]; p.ctx = in[2]; p.c_ctx = in[3]; p.mod_w = in[4]; p.mod_b = in[5]; p.norm_pre = in[6]; p.norm_post = in[7];
  p.ffn_w_up = in[8]; p.ffn_conv_w = in[9]; p.ffn_conv_b = in[10]; p.ffn_w_down = in[11];
  p.ev_w_in = in[12]; p.ev_conv_w = in[13]; p.ev_q_norm = in[14]; p.ev_k_norm = in[15]; p.ev_w_out = in[16];
  p.od_w_in = in[17]; p.a_re = in[18]; p.a_im = in[19]; p.log_dt = in[20]; p.b_re = in[21]; p.b_im = in[22]; p.c_re = in[23]; p.c_im = in[24];
  p.d_skip = in[25]; p.glu_w = in[26]; p.lam_q1 = in[27]; p.lam_k1 = in[28]; p.lam_q2 = in[29]; p.lam_k2 = in[30]; p.subln = in[31]; p.od_w_out = in[32];
  p.out = (float*)d_out;
  char* ws = (char*)d_ws;
  size_t off = 0;
  auto take = [&](size_t bytes) { char* r = ws + off; off += (bytes + 255) & ~(size_t)255; return r; };
  p.wt_in0 = (u16*)take((size_t)2304 * 1024 * 2);
  p.wt_out0 = (u16*)take((size_t)1024 * 1024 * 2);
  p.wt_up0 = (u16*)take((size_t)2 * DFF * 1024 * 2);
  p.wt_dn0 = (u16*)take((size_t)1024 * DFF * 2);
  p.wt_in1 = (u16*)take((size_t)2048 * 1024 * 2);
  p.wt_glu = (u16*)take((size_t)1024 * 512 * 2);
  p.wt_out1 = (u16*)take((size_t)1024 * 1024 * 2);
  p.wt_up1 = (u16*)take((size_t)2 * DFF * 1024 * 2);
  p.wt_dn1 = (u16*)take((size_t)1024 * DFF * 2);
  p.mod = (float*)take((size_t)2 * 2 * 6 * DM * 4);
  p.xctx = (float*)take((size_t)CTXN * DM * 4);
  p.s5s = (float*)take((size_t)2 * 32 * NCHUNK * 64 * 8);
  p.H = (u16*)take((size_t)MT * DM * 2);
  p.Y = (float*)take((size_t)MT * DM * 4);
  p.big = (u16*)take((size_t)MT * DFF * 2);
  p.bar = (unsigned*)take(20480);
  p.ph_lo = 0; p.ph_hi = 20;
  if (off > ws_size) { fprintf(stderr, "workspace too small: need %zu have %zu\n", off, ws_size); }
  (void)hipMemsetAsync(p.bar, 0, 20480, stream);
  void* args[] = {&p};
  hipError_t e = hipLaunchCooperativeKernel((const void*)fwd_megakernel, dim3(grid_blocks), dim3(256), args, LDS_BYTES, stream);
  if (e != hipSuccess) fprintf(stderr, "cooperative launch failed: %s (grid %d)\n", hipGetErrorString(e), grid_blocks);
}
```
